# Optimizing an MI355X kernel written in HIP

```python
import math
import jax, jax.numpy as jnp
from jax import lax
import numpy as np

D_MODEL = 1024
BATCH = 1
SEQ = 16384
DEPTH = 2

CHUNK = 64
MEM_LEN = 256
NORM_EPS = 1e-6
GN_EPS = 1e-5

LRU_W = 512
LRU_BLOCKS = 8
LRU_BW = LRU_W // LRU_BLOCKS
CONV_W = 4
LRU_C = 8.0
CA_HEADS = 8
CA_HD = 64
CA_PREV = 8
CA_BAND = (CA_PREV + 1) * CHUNK
REL_CLIP = 128
RET_HEADS = 8
RET_HD = 64
RET_VD = 64
DIFF_HEADS = 4
DIFF_HD = 64
DIFF_VD = 2 * DIFF_HD
Q_BLOCK = 128
MX_HEADS = 4
MX_HD = 128
N_GROUPS = 4
EXP_PER_GROUP = 8
N_EXPERTS = N_GROUPS * EXP_PER_GROUP
TOP_K = 2
D_EXPERT = 512
MOE_BLOCK = 256
N_BRANCH = 4
BRANCH_W = 512

SPLIT_WIDTHS = (
    LRU_W, LRU_W,
    CA_HEADS * CA_HD, CA_HEADS * CA_HD, CA_HEADS * CA_HD,
    RET_HEADS * RET_HD, RET_HEADS * RET_HD, RET_HEADS * RET_VD, RET_HEADS * RET_VD,
    DIFF_HEADS * 2 * DIFF_HD, DIFF_HEADS * 2 * DIFF_HD, DIFF_HEADS * DIFF_VD,
    N_BRANCH * D_MODEL,
)
IN_COLS = sum(SPLIT_WIDTHS)

kernel_name = "hybrid_lru_chunkattn_retention_diffattn_hmoe"


def _rmsnorm(x, g, eps=NORM_EPS):
    xf = x.astype(jnp.float32)
    y = xf * lax.rsqrt(jnp.mean(xf * xf, axis=-1, keepdims=True) + eps)
    return (y * g.astype(jnp.float32)).astype(x.dtype)


def _split_columns(z):
    parts, off = [], 0
    for w in SPLIT_WIDTHS:
        parts.append(z[..., off:off + w])
        off += w
    return parts


def _rg_lru_branch(xr, xg, conv_w, conv_b, wa, ba, wx, bx, lam):
    b, n, _ = xr.shape
    f32 = jnp.float32
    xp = jnp.pad(xr, ((0, 0), (CONV_W - 1, 0), (0, 0)))
    xc = conv_b + sum(xp[:, j:j + n] * conv_w[j] for j in range(CONV_W))
    xc32 = xc.astype(f32)
    xblk = xc32.reshape(b, n, LRU_BLOCKS, LRU_BW)
    r = jax.nn.sigmoid(jnp.einsum("bnkc,kcd->bnkd", xblk, wa.astype(f32)).reshape(b, n, LRU_W) + ba.astype(f32))
    i = jax.nn.sigmoid(jnp.einsum("bnkc,kcd->bnkd", xblk, wx.astype(f32)).reshape(b, n, LRU_W) + bx.astype(f32))
    log_a = -LRU_C * r * jax.nn.softplus(-lam.astype(f32))
    a = jnp.exp(log_a)
    u = jnp.sqrt(-jnp.expm1(2.0 * log_a)) * (i * xc32)

    def combine(left, right):
        a1, b1 = left
        a2, b2 = right
        return a1 * a2, a2 * b1 + b2

    _, hseq = lax.associative_scan(combine, (a, u), axis=1)
    return (hseq * jax.nn.gelu(xg.astype(f32))).astype(xr.dtype)


def _chunk_attention(q, k, v, rel_table):
    b, n, _ = q.shape
    nc = n // CHUNK
    q = q.reshape(b, nc, CHUNK, CA_HEADS, CA_HD)
    k = k.reshape(b, nc, CHUNK, CA_HEADS, CA_HD)
    v = v.reshape(b, nc, CHUNK, CA_HEADS, CA_HD)
    pad = ((0, 0), (CA_PREV, 0), (0, 0), (0, 0), (0, 0))
    kp, vp = jnp.pad(k, pad), jnp.pad(v, pad)
    k_band = jnp.concatenate([kp[:, j:j + nc] for j in range(CA_PREV + 1)], axis=2)
    v_band = jnp.concatenate([vp[:, j:j + nc] for j in range(CA_PREV + 1)], axis=2)
    s = jnp.einsum("bcqhd,bckhd->bhcqk", q, k_band).astype(jnp.float32) * (CA_HD ** -0.5)
    qi = np.arange(CHUNK)[:, None]
    kj = np.arange(CA_BAND)[None, :]
    dist = qi + CA_PREV * CHUNK - kj
    idx = np.clip(dist, -REL_CLIP, REL_CLIP) + REL_CLIP
    bias = rel_table[:, idx].astype(jnp.float32)
    key_chunk = np.arange(nc)[:, None] - CA_PREV + (np.arange(CA_BAND) // CHUNK)[None, :]
    valid = key_chunk >= 0
    s = jnp.where(valid[None, None, :, None, :], s + bias[None, :, None], -jnp.inf)
    p = jax.nn.softmax(s, axis=-1).astype(v.dtype)
    o = jnp.einsum("bhcqk,bckhd->bcqhd", p, v_band)
    return o.reshape(b, n, CA_HEADS * CA_HD)


def _retention(q, k, v, g):
    b, n, _ = q.shape
    nc = n // CHUNK
    f32 = jnp.float32
    q = q.reshape(b, nc, CHUNK, RET_HEADS, RET_HD).astype(f32)
    k = k.reshape(b, nc, CHUNK, RET_HEADS, RET_HD).astype(f32) * (RET_HD ** -0.5)
    v = v.reshape(b, nc, CHUNK, RET_HEADS, RET_VD).astype(f32)
    log_g = np.log(1.0 - 2.0 ** (-5.0 - np.arange(RET_HEADS))).astype(np.float32)
    pos = np.arange(CHUNK)
    diff = pos[:, None] - pos[None, :]
    decay = np.where(diff[None] >= 0, np.exp(log_g[:, None, None] * np.maximum(diff, 0)[None]), 0.0).astype(np.float32)
    inner = jnp.einsum("bcihd,bcjhd->bchij", q, k) * decay[None, None]
    o_inner = jnp.einsum("bchij,bcjhe->bcihe", inner, v)
    zeta = np.exp(log_g[None, :] * (CHUNK - 1 - pos)[:, None]).astype(np.float32)
    kv = jnp.einsum("bcjhd,jh,bcjhe->bchde", k, zeta, v)
    g_chunk = np.exp(log_g * CHUNK).astype(np.float32)

    def step(state, kv_c):
        return g_chunk[:, None, None] * state + kv_c, state

    init = jnp.zeros((b, RET_HEADS, RET_HD, RET_VD), f32)
    _, r_prev = lax.scan(step, init, jnp.moveaxis(kv, 1, 0))
    r_prev = jnp.moveaxis(r_prev, 0, 1)
    xi = np.exp(log_g[None, :] * (pos + 1)[:, None]).astype(np.float32)
    o_cross = jnp.einsum("bcihd,bchde->bcihe", q, r_prev) * xi[None, None, :, :, None]
    o = o_inner + o_cross
    mu = jnp.mean(o, axis=-1, keepdims=True)
    var = jnp.mean(jnp.square(o - mu), axis=-1, keepdims=True)
    o = ((o - mu) * lax.rsqrt(var + GN_EPS)).reshape(b, n, RET_HEADS * RET_VD)
    return (jax.nn.silu(g.astype(f32)) * o).astype(g.dtype)


def _diff_attention(q, k, v, lam_vecs, subln_g, lam_init):
    b, n, _ = q.shape
    f32 = jnp.float32
    q = q.reshape(b, n, DIFF_HEADS, 2, DIFF_HD)
    k = k.reshape(b, n, DIFF_HEADS, 2, DIFF_HD)
    v = v.reshape(b, n, DIFF_HEADS, DIFF_VD)
    lv = lam_vecs.astype(f32)
    lam = jnp.exp(jnp.sum(lv[0] * lv[1])) - jnp.exp(jnp.sum(lv[2] * lv[3])) + lam_init
    slopes = (2.0 ** (-8.0 * np.arange(1, DIFF_HEADS + 1) / DIFF_HEADS)).astype(np.float32)
    nb = n // Q_BLOCK
    qb = jnp.moveaxis(q.reshape(b, nb, Q_BLOCK, DIFF_HEADS, 2, DIFF_HD), 1, 0)
    kpos = jnp.arange(n)

    def block(args):
        q_blk, blk = args
        qpos = blk * Q_BLOCK + jnp.arange(Q_BLOCK)
        s = jnp.einsum("bqhmd,bkhmd->bmhqk", q_blk, k).astype(f32) * (DIFF_HD ** -0.5)
        dist = jnp.abs(qpos[:, None] - kpos[None, :]).astype(f32)
        alibi = -slopes[:, None, None] * dist[None]
        allowed = (kpos[None, :] // CHUNK) <= (qpos[:, None] // CHUNK)
        s = jnp.where(allowed, s + alibi, -jnp.inf)
        p = jax.nn.softmax(s, axis=-1)
        attn = p[:, 0] - lam * p[:, 1]
        return jnp.einsum("bhqk,bkhe->bqhe", attn.astype(v.dtype), v)

    o = lax.map(block, (qb, jnp.arange(nb)))
    o = jnp.moveaxis(o, 0, 1).reshape(b, n, DIFF_HEADS, DIFF_VD).astype(f32)
    o = o * lax.rsqrt(jnp.mean(o * o, axis=-1, keepdims=True) + GN_EPS) * subln_g.astype(f32)
    o = o * (1.0 - lam_init)
    return o.reshape(b, n, DIFF_HEADS * DIFF_VD).astype(v.dtype)


def _memory_cross_attention(h, mem_n, wq, wk, wv, wo):
    b, n, _ = h.shape
    m = mem_n.shape[1]
    q = (h @ wq).reshape(b, n, MX_HEADS, MX_HD)
    k = (mem_n @ wk).reshape(b, m, MX_HEADS, MX_HD)
    v = (mem_n @ wv).reshape(b, m, MX_HEADS, MX_HD)
    s = jnp.einsum("bnhd,bmhd->bhnm", q, k).astype(jnp.float32) * (MX_HD ** -0.5)
    p = jax.nn.softmax(s, axis=-1).astype(v.dtype)
    o = jnp.einsum("bhnm,bmhd->bnhd", p, v).reshape(b, n, MX_HEADS * MX_HD)
    return o @ wo


def _hier_moe(h, w_group, b_group, w_router, b_router, w1, w3, w2):
    b, n, d = h.shape
    t = h.reshape(b * n, d)
    n_tok = b * n
    f32 = jnp.float32
    rows = jnp.arange(n_tok)
    g_logits = (t @ w_group).astype(f32) + b_group.astype(f32)
    g_prob = jax.nn.softmax(g_logits, axis=-1)
    g_sel = jnp.argmax(g_logits, axis=-1)
    e_logits = ((t @ w_router).astype(f32) + b_router.astype(f32)).reshape(n_tok, N_GROUPS, EXP_PER_GROUP)
    e_prob = jax.nn.softmax(e_logits[rows, g_sel], axis=-1)
    top_p, top_i = lax.top_k(e_prob, TOP_K)
    top_p = top_p / jnp.sum(top_p, axis=-1, keepdims=True) * g_prob[rows, g_sel][:, None]
    expert = g_sel[:, None] * EXP_PER_GROUP + top_i
    flat_e = expert.reshape(-1).astype(jnp.int32)
    flat_w = top_p.reshape(-1)
    n_asg = n_tok * TOP_K
    order = jnp.argsort(flat_e)
    sorted_e = flat_e[order]
    counts = jnp.bincount(flat_e, length=N_EXPERTS)
    padded = (counts + MOE_BLOCK - 1) // MOE_BLOCK * MOE_BLOCK
    pad_end = jnp.cumsum(padded)
    pad_start = pad_end - padded
    start = jnp.cumsum(counts) - counts
    dest = pad_start[sorted_e] + jnp.arange(n_asg) - start[sorted_e]
    n_blocks = -(-(n_asg + N_EXPERTS * (MOE_BLOCK - 1)) // MOE_BLOCK)
    n_slots = n_blocks * MOE_BLOCK
    slot_tok = jnp.full((n_slots,), n_tok, jnp.int32).at[dest].set((order // TOP_K).astype(jnp.int32))
    slot_w = jnp.zeros((n_slots,), f32).at[dest].set(flat_w[order])
    block_e = jnp.minimum(jnp.searchsorted(pad_end, jnp.arange(n_blocks) * MOE_BLOCK, side="right"), N_EXPERTS - 1)
    t_pad = jnp.concatenate([t, jnp.zeros((1, d), t.dtype)], axis=0)
    xs = t_pad[slot_tok].reshape(n_blocks, MOE_BLOCK, d)

    def expert_block(args):
        xb, e = args
        hid = jax.nn.silu(xb @ w1[e]) * (xb @ w3[e])
        return hid @ w2[e]

    ys = lax.map(expert_block, (xs, block_e)).reshape(n_slots, d)
    out = jax.ops.segment_sum(ys * slot_w[:, None].astype(ys.dtype), slot_tok, num_segments=n_tok + 1)[:n_tok]
    return out.reshape(b, n, d).astype(h.dtype)


def setup_inputs(seed: int = 0) -> dict:
    key = jax.random.key(seed)
    ks = iter(jax.random.split(key, 40))
    L, D = DEPTH, D_MODEL

    def normal(shape, scale):
        return jax.random.normal(next(ks), shape, jnp.float32) * scale

    def gain(shape):
        return 1.0 + 0.05 * jax.random.normal(next(ks), shape, jnp.float32)

    a0 = jax.random.uniform(next(ks), (L, LRU_W), jnp.float32, 0.9, 0.999)
    a_root = a0 ** (1.0 / LRU_C)
    lru_lambda = jnp.log(a_root) - jnp.log1p(-a_root)
    return {
        "x": normal((BATCH, SEQ, D), 1.0),
        "mem": normal((BATCH, MEM_LEN, D), 1.0),
        "norm_mix": gain((L, D)),
        "w_in": normal((L, D, IN_COLS), D ** -0.5),
        "conv_w": normal((L, CONV_W, LRU_W), CONV_W ** -0.5),
        "conv_b": normal((L, LRU_W), 0.01),
        "lru_wa": normal((L, LRU_BLOCKS, LRU_BW, LRU_BW), LRU_BW ** -0.5),
        "lru_ba": normal((L, LRU_W), 0.01),
        "lru_wx": normal((L, LRU_BLOCKS, LRU_BW, LRU_BW), LRU_BW ** -0.5),
        "lru_bx": normal((L, LRU_W), 0.01),
        "lru_lambda": lru_lambda,
        "ca_rel_bias": normal((L, CA_HEADS, 2 * REL_CLIP + 1), 0.1),
        "diff_lambda": normal((L, 4, DIFF_HD), 0.1),
        "diff_subln": gain((L, DIFF_VD)),
        "w_branch": normal((L, N_BRANCH, BRANCH_W, D), BRANCH_W ** -0.5),
        "w_out": normal((L, D, D), D ** -0.5),
        "norm_mem": gain((L, D)),
        "mem_norm": gain((D,)),
        "w_mq": normal((L, D, MX_HEADS * MX_HD), D ** -0.5),
        "w_mk": normal((L, D, MX_HEADS * MX_HD), D ** -0.5),
        "w_mv": normal((L, D, MX_HEADS * MX_HD), D ** -0.5),
        "w_mo": normal((L, MX_HEADS * MX_HD, D), (MX_HEADS * MX_HD) ** -0.5),
        "norm_ffn": gain((L, D)),
        "w_group": normal((L, D, N_GROUPS), D ** -0.5),
        "b_group": normal((L, N_GROUPS), 0.01),
        "w_router": normal((L, D, N_EXPERTS), D ** -0.5),
        "b_router": normal((L, N_EXPERTS), 0.01),
        "w1": normal((L, N_EXPERTS, D, D_EXPERT), D ** -0.5),
        "w3": normal((L, N_EXPERTS, D, D_EXPERT), D ** -0.5),
        "w2": normal((L, N_EXPERTS, D_EXPERT, D), D_EXPERT ** -0.5),
        "final_norm": gain((D,)),
    }


def reference(x, mem, norm_mix, w_in, conv_w, conv_b, lru_wa, lru_ba, lru_wx, lru_bx, lru_lambda,
              ca_rel_bias, diff_lambda, diff_subln, w_branch, w_out, norm_mem, mem_norm,
              w_mq, w_mk, w_mv, w_mo, norm_ffn, w_group, b_group, w_router, b_router,
              w1, w3, w2, final_norm):
    b, n, d = x.shape
    mem_n = _rmsnorm(mem, mem_norm)
    for l in range(DEPTH):
        lam_init = 0.8 - 0.6 * math.exp(-0.3 * l)
        h = _rmsnorm(x, norm_mix[l])
        z = h @ w_in[l]
        (a_x, a_g, b_q, b_k, b_v, c_q, c_k, c_v, c_g, d_q, d_k, d_v, gates) = _split_columns(z)
        y_a = _rg_lru_branch(a_x, a_g, conv_w[l], conv_b[l], lru_wa[l], lru_ba[l], lru_wx[l], lru_bx[l], lru_lambda[l])
        y_b = _chunk_attention(b_q, b_k, b_v, ca_rel_bias[l])
        y_c = _retention(c_q, c_k, c_v, c_g)
        y_d = _diff_attention(d_q, d_k, d_v, diff_lambda[l], diff_subln[l], lam_init)
        ys = jnp.stack([y_a, y_b, y_c, y_d], axis=2)
        proj = jnp.einsum("bnkc,kcd->bnkd", ys, w_branch[l])
        g = jax.nn.sigmoid(gates.reshape(b, n, N_BRANCH, d))
        x = x + jnp.sum(g * proj, axis=2) @ w_out[l]
        x = x + _memory_cross_attention(_rmsnorm(x, norm_mem[l]), mem_n, w_mq[l], w_mk[l], w_mv[l], w_mo[l])
        x = x + _hier_moe(_rmsnorm(x, norm_ffn[l]), w_group[l], b_group[l], w_router[l], b_router[l], w1[l], w3[l], w2[l])
    return _rmsnorm(x, final_norm)
```

```cpp
#include <hip/hip_runtime.h>
#include <cstdio>
#include <cstdint>
#include <cmath>

#ifndef MK_N_LAUNCHES
#define MK_N_LAUNCHES 0
#endif

#define LAS __attribute__((address_space(3)))
#define GAS __attribute__((address_space(1)))
typedef unsigned short bf16;
typedef short bf16x8 __attribute__((ext_vector_type(8)));
typedef short s16x4 __attribute__((ext_vector_type(4)));
typedef float f32x4 __attribute__((ext_vector_type(4)));
typedef float f32x2 __attribute__((ext_vector_type(2)));
typedef float f32x16 __attribute__((ext_vector_type(16)));
typedef unsigned u32x4 __attribute__((ext_vector_type(4)));
typedef unsigned u32x2 __attribute__((ext_vector_type(2)));

constexpr int M = 16384, D = 1024, DEPTH = 2, CHUNK = 64, NCHUNK = M / CHUNK, MEM_LEN = 256;
constexpr int ZC = 6144, INC = 10240, YC = 2048;
constexpr int Z_AX = 0, Z_AG = 512, Z_BQ = 1024, Z_BK = 1536, Z_BV = 2048, Z_CQ = 2560, Z_CK = 3072, Z_CV = 3584, Z_CG = 4096, Z_DQ = 4608, Z_DK = 5120, Z_DV = 5632;
constexpr int NEXP = 32, DEXP = 512;
constexpr int HROWS = M + 256;
constexpr int MAXSLOT = 41216;
constexpr float NORM_EPS = 1e-6f, GN_EPS = 1e-5f;
constexpr float LOG2E = 1.4426950408889634f;

constexpr size_t MiB = 1u << 20;
constexpr size_t WS_CTL = 0, CTL_ZERO_BYTES = 1 * MiB;
constexpr size_t WS_MEMN = 1 * MiB;
constexpr size_t WS_KMEM = 2 * MiB;
constexpr size_t WS_VMEM = 2 * MiB + 512 * 1024;
constexpr size_t WS_WTR = 3 * MiB;
constexpr size_t WS_CARA = 4 * MiB;
constexpr size_t WS_CARH = 4 * MiB + 512 * 1024;
constexpr size_t WS_CARI = 5 * MiB;
constexpr size_t WS_TOKE = 6 * MiB;
constexpr size_t WS_TOKP = 6 * MiB + 128 * 1024;
constexpr size_t WS_TOKW = 6 * MiB + 256 * 1024;
constexpr size_t WS_ELIST = 8 * MiB;
constexpr size_t WS_WIN = 10 * MiB;
constexpr size_t WS_WBR = 50 * MiB;
constexpr size_t WS_WOUT = 58 * MiB;
constexpr size_t WS_WMQ = 62 * MiB;
constexpr size_t WS_WMK = 64 * MiB;
constexpr size_t WS_WMV = 66 * MiB;
constexpr size_t WS_WMO = 68 * MiB;
constexpr size_t WS_W13 = 70 * MiB;
constexpr size_t WS_W2 = 134 * MiB;
constexpr size_t WS_H = 166 * MiB;
constexpr size_t WS_Y = 200 * MiB;
constexpr size_t WS_KVT = 264 * MiB;
constexpr size_t WS_RT = 296 * MiB;
constexpr size_t WS_OD = 312 * MiB;
constexpr size_t WS_Z = 344 * MiB;
constexpr size_t WS_G = 344 * MiB;
constexpr size_t WS_MRG = 472 * MiB;
constexpr size_t WS_QB = 504 * MiB;
constexpr size_t WS_OB = 520 * MiB;
constexpr size_t WS_HID = 344 * MiB;
constexpr size_t WS_YMOE = 386 * MiB;
constexpr size_t WS_END = 536 * MiB;
static_assert(WS_HID + (size_t)MAXSLOT * 512 * 2 <= WS_YMOE && WS_YMOE + (size_t)MAXSLOT * 1024 * 2 <= WS_MRG, "moe overlay");
constexpr int CW_TMO = 0, CW_CODE = 1;
constexpr int CW_BAR = 4096;
constexpr int CW_ECNT = 16384;

constexpr int LDS_BYTES = 147456;
constexpr int LDS_MISC = 131072;
constexpr int NWAVES = 8, NTHREADS = 512;

__device__ __forceinline__ unsigned f2bf(float f) { unsigned u = __builtin_bit_cast(unsigned, f); return (u + 0x7fffu + ((u >> 16) & 1u)) >> 16; }
__device__ __forceinline__ unsigned pk2(float lo, float hi) { return f2bf(lo) | (f2bf(hi) << 16); }
__device__ __forceinline__ float bf2f(unsigned short b) { return __builtin_bit_cast(float, ((unsigned)b) << 16); }
__device__ __forceinline__ float bflo(unsigned w) { return __builtin_bit_cast(float, w << 16); }
__device__ __forceinline__ float bfhi(unsigned w) { return __builtin_bit_cast(float, w & 0xffff0000u); }
typedef __bf16 bf16x2_t __attribute__((ext_vector_type(2)));
__device__ __forceinline__ unsigned cvt_pk_bf16(float lo, float hi) { const f32x2 v = {lo, hi}; const bf16x2_t b = __builtin_convertvector(v, bf16x2_t); return __builtin_bit_cast(unsigned, b); }
__device__ __forceinline__ float fexp2(float x) { return __builtin_amdgcn_exp2f(x); }
__device__ __forceinline__ float frcp(float x) { return __builtin_amdgcn_rcpf(x); }
__device__ __forceinline__ float sigmoidf_(float x) { return frcp(1.0f + fexp2(-x * LOG2E)); }
__device__ __forceinline__ float wave_sum(float v) {
#pragma unroll
    for (int o = 1; o < 64; o <<= 1) v += __shfl_xor(v, o);
    return v;
}
#define LDS_WAIT() asm volatile("s_waitcnt lgkmcnt(0)" ::: "memory")
#define VM_WAIT() asm volatile("s_waitcnt vmcnt(0)" ::: "memory")

namespace pg8 {
constexpr int BM = 256, BK = 64, HALF = 128, HTB = HALF * BK * 2, STAGE_BYTES = 8 * HTB, NXCD = 8, WGM = 8;
__host__ __device__ __forceinline__ int lds_byte(int r, int c) { const int st = (r >> 4) * 2 + (c >> 5), rr = r & 15, cc = c & 31, ob = rr * 64 + cc * 2; return st * 1024 + (ob ^ (((ob >> 9) & 1) << 5)); }
__host__ __device__ __forceinline__ void stage_rc(int b, int& R, int& C) { const int st = b / 1024, sb = b % 1024, swz = sb ^ (((sb >> 9) & 1) << 5); R = (st >> 1) * 16 + swz / 64; C = (st & 1) * 32 + (swz % 64) / 2; }
__host__ __device__ __forceinline__ int perm32(int rho) { const int n = rho >> 4, i = rho & 15; return 8 * (i >> 2) + 4 * n + (i & 3); }

struct Unit { int arow, acol, brow, pm, pn, aux, gcnt; const int* gl; };
struct Gemm { const bf16* A; const bf16* Bt; int lda, ldb, K, zrow; };

template <class Epi, class Sched, bool GATHER>
__device__ __forceinline__ void gemm_phase(LAS unsigned char* lds, const Gemm g, const Sched& S, const Epi& E, const int tid) {
    const int wid = __builtin_amdgcn_readfirstlane(tid >> 6), lane = tid & 63, wr = wid >> 2, wc = wid & 3, fr = lane & 15, fq = lane >> 4;
    const int K = g.K, nt = K / BK;
    unsigned voffA[2][2], voffB[2];
#pragma unroll
    for (int i = 0; i < 2; ++i) { int R, C; stage_rc(tid * 16 + i * 8192, R, C); const int Rb = Epi::PERM ? ((R & ~31) + perm32(R & 31)) : R;
        voffA[0][i] = (unsigned)(R * g.lda + C) * 2u; voffA[1][i] = voffA[0][i]; voffB[i] = (unsigned)(Rb * g.ldb + C) * 2u; }
    const size_t kstep = (size_t)(BK * 2);
    const size_t hstepA = GATHER ? (size_t)0 : (size_t)HALF * g.lda * 2;
    const size_t hstepB = (size_t)HALF * g.ldb * 2;
    const unsigned ldsw = (unsigned)wid * 1024u;
    const int aoff = lds_byte(wr * 64 + fr, fq * 8), boff = lds_byte(wc * 32 + fr, fq * 8);
#define PG8_SA(b, h) (((b) * 2 + (h)) * HTB)
#define PG8_SB(b, h) ((4 + (b) * 2 + (h)) * HTB)
#define PG8_STAGE(bufoff, gbase, voff) do { _Pragma("unroll") for (int _i = 0; _i < 2; ++_i) \
        __builtin_amdgcn_global_load_lds((const unsigned*)((const char*)(gbase) + (voff)[_i]), (LAS unsigned*)(lds + (bufoff) + ldsw + _i * 8192), 16, 0, 0); } while (0)
#define PG8_LDA(dst, b, h) do { _Pragma("unroll") for (int m = 0; m < 4; ++m) _Pragma("unroll") for (int k = 0; k < 2; ++k) dst[m][k] = *(const LAS bf16x8*)(lds + PG8_SA(b, h) + aoff + m * 2048 + k * 1024); } while (0)
#define PG8_LDB(dst, b, h) do { _Pragma("unroll") for (int n = 0; n < 2; ++n) _Pragma("unroll") for (int k = 0; k < 2; ++k) dst[n][k] = *(const LAS bf16x8*)(lds + PG8_SB(b, h) + boff + n * 2048 + k * 1024); } while (0)
#define PG8_MMA(ai, bj, At, Bt) do { __builtin_amdgcn_s_setprio(1); _Pragma("unroll") for (int m = 0; m < 4; ++m) _Pragma("unroll") for (int n = 0; n < 2; ++n) _Pragma("unroll") for (int k = 0; k < 2; ++k) \
        acc[ai][bj][m][n] = __builtin_amdgcn_mfma_f32_16x16x32_bf16(Bt[n][k], At[m][k], acc[ai][bj][m][n], 0, 0, 0); __builtin_amdgcn_s_setprio(0); } while (0)
#define PG8_WAIT_V(n) asm volatile("s_waitcnt vmcnt(" #n ")" ::: "memory")
#define PG8_WAIT_L(n) asm volatile("s_waitcnt lgkmcnt(" #n ")" ::: "memory")
#define PG8_BAR __builtin_amdgcn_s_barrier()
#define PG8_SCHED __builtin_amdgcn_sched_barrier(0)
#define PG8_SETA(u) do { if constexpr (GATHER) { _Pragma("unroll") for (int _h = 0; _h < 2; ++_h) _Pragma("unroll") for (int _i = 0; _i < 2; ++_i) { \
        int _R, _C; stage_rc(tid * 16 + _i * 8192, _R, _C); const int _r = _h * HALF + _R; const int _row = (_r < (u).gcnt) ? (u).gl[_r] : g.zrow; \
        voffA[_h][_i] = ((unsigned)_row * (unsigned)g.lda + (unsigned)_C) * 2u; } } } while (0)
#define PG8_ABASE(u) (GATHER ? (const char*)g.A : (const char*)g.A + ((size_t)(u).arow * g.lda + (u).acol) * 2)
    Unit cur, nxt; int ui = 0;
    if (!S.next(0, cur)) return;
    f32x4 acc[2][2][4][2];
#pragma unroll
    for (int a = 0; a < 2; ++a)
#pragma unroll
        for (int b = 0; b < 2; ++b)
#pragma unroll
            for (int m = 0; m < 4; ++m)
#pragma unroll
                for (int n = 0; n < 2; ++n) acc[a][b][m][n] = (f32x4){0.f, 0.f, 0.f, 0.f};
    bf16x8 At[4][2], B0[2][2], B1[2][2];
    PG8_SETA(cur);
    const char* cA = PG8_ABASE(cur);
    const char* cB = (const char*)g.Bt + (size_t)cur.brow * g.ldb * 2;
    PG8_STAGE(PG8_SB(0, 0), cB, voffB); PG8_STAGE(PG8_SB(0, 1), cB + hstepB, voffB); PG8_STAGE(PG8_SA(0, 0), cA, voffA[0]); PG8_STAGE(PG8_SA(0, 1), cA + hstepA, voffA[1]);
    if (wr == 1) PG8_BAR;
    PG8_WAIT_V(2); PG8_BAR;
    PG8_STAGE(PG8_SB(1, 0), cB + kstep, voffB); PG8_STAGE(PG8_SA(1, 0), cA + kstep, voffA[0]); PG8_STAGE(PG8_SB(1, 1), cB + hstepB + kstep, voffB);
    PG8_WAIT_V(6); PG8_BAR;
    for (;;) {
        const bool has_next = S.next(ui + 1, nxt);
        const char* nA = has_next ? PG8_ABASE(nxt) : cA; const char* nB = has_next ? (const char*)g.Bt + (size_t)nxt.brow * g.ldb * 2 : cB;
        for (int t = 0; t < nt; t += 2) {
            const bool last = (t == nt - 2);
            const char* a1 = cA + (size_t)(t + 1) * kstep;
            const char* a2 = last ? nA : cA + (size_t)(t + 2) * kstep; const char* b2 = last ? nB : cB + (size_t)(t + 2) * kstep;
            const char* a3 = a2 + kstep; const char* b3 = b2 + kstep;
            PG8_LDB(B0, 0, 0); PG8_LDB(B1, 0, 1); PG8_SCHED; PG8_LDA(At, 0, 0); PG8_STAGE(PG8_SA(1, 1), a1 + hstepA, voffA[1]);
            if (last && has_next) { PG8_SETA(nxt); }
            PG8_WAIT_V(8); PG8_WAIT_L(0); PG8_BAR; PG8_MMA(0, 0, At, B0); PG8_MMA(0, 1, At, B1); PG8_BAR; PG8_SCHED;
            PG8_LDA(At, 0, 1); PG8_STAGE(PG8_SB(0, 0), b2, voffB); PG8_STAGE(PG8_SB(0, 1), b2 + hstepB, voffB); PG8_STAGE(PG8_SA(0, 0), a2, voffA[0]);
            PG8_WAIT_V(8); PG8_WAIT_L(0); PG8_BAR; PG8_MMA(1, 0, At, B0); PG8_MMA(1, 1, At, B1); PG8_BAR; PG8_SCHED;
            PG8_LDB(B0, 1, 0); PG8_LDB(B1, 1, 1); PG8_SCHED; PG8_LDA(At, 1, 0); PG8_STAGE(PG8_SA(0, 1), a2 + hstepA, voffA[1]);
            PG8_WAIT_V(8); PG8_WAIT_L(0); PG8_BAR; PG8_MMA(0, 0, At, B0); PG8_MMA(0, 1, At, B1); PG8_BAR; PG8_SCHED;
            PG8_LDA(At, 1, 1); PG8_STAGE(PG8_SB(1, 0), b3, voffB); PG8_STAGE(PG8_SB(1, 1), b3 + hstepB, voffB); PG8_STAGE(PG8_SA(1, 0), a3, voffA[0]);
            PG8_WAIT_V(8); PG8_WAIT_L(0); PG8_BAR; PG8_MMA(1, 0, At, B0); PG8_MMA(1, 1, At, B1); PG8_BAR; PG8_SCHED;
        }
        if (wr == 0) PG8_BAR;
        E(acc, cur, wr, wc, fr, fq);
        if (!has_next) break;
#pragma unroll
        for (int a = 0; a < 2; ++a)
#pragma unroll
            for (int b = 0; b < 2; ++b)
#pragma unroll
                for (int m = 0; m < 4; ++m)
#pragma unroll
                    for (int n = 0; n < 2; ++n) acc[a][b][m][n] = (f32x4){0.f, 0.f, 0.f, 0.f};
        cur = nxt; cA = nA; cB = nB; ++ui;
        if (wr == 1) PG8_BAR;
    }
    PG8_WAIT_V(0);
    PG8_BAR;
#undef PG8_SA
#undef PG8_SB
#undef PG8_STAGE
#undef PG8_LDA
#undef PG8_LDB
#undef PG8_MMA
#undef PG8_WAIT_V
#undef PG8_WAIT_L
#undef PG8_BAR
#undef PG8_SCHED
#undef PG8_SETA
#undef PG8_ABASE
}

struct GridOrder {
    int nM, nN, nwg, G, c, arow0, acol, brow0;
    __device__ void init(int nM_, int nN_, int G_, int c_, int arow0_ = 0, int acol_ = 0, int brow0_ = 0) { nM = nM_; nN = nN_; nwg = nM * nN; G = G_; c = c_; arow0 = arow0_; acol = acol_; brow0 = brow0_; }
    __device__ __forceinline__ bool next(int i, Unit& u) const {
        const long L = (long)i * G + c; if (L >= nwg) return false;
        int wgid = (int)L; { const int q = nwg / NXCD, r = nwg % NXCD, xcd = wgid % NXCD, off = wgid / NXCD; wgid = (xcd < r ? xcd * (q + 1) : r * (q + 1) + (xcd - r) * q) + off; }
        const int nig = WGM * nN, gid = wgid / nig, fm = gid * WGM, gsz = (nM - fm) < WGM ? (nM - fm) : WGM;
        u.pm = fm + ((wgid % nig) % gsz); u.pn = (wgid % nig) / gsz;
        u.arow = arow0 + u.pm * BM; u.acol = acol; u.brow = brow0 + u.pn * BM; u.aux = 0; u.gcnt = 0; u.gl = nullptr; return true;
    }
};
struct BranchOrder {
    int G, c;
    __device__ __forceinline__ bool next(int i, Unit& u) const {
        const int tile = (i >> 2) * G + c, b = i & 3; if (tile >= 256) return false;
        u.pm = tile >> 2; u.pn = tile & 3; u.arow = u.pm * BM; u.acol = b * 512; u.brow = b * 1024 + u.pn * BM; u.aux = b; u.gcnt = 0; u.gl = nullptr; return true;
    }
};
struct MoeOrder {
    const LAS int* tab; int G, c, nct, brows; const int* elist; const unsigned* ecnt;
    __device__ __forceinline__ bool next(int i, Unit& u) const {
        const int L = i * G + c, nrt = tab[0]; if (L >= nrt * nct) return false;
        const int j = L / nct, ct = L % nct; const int e = tab[16 + 4 * j], rt = tab[16 + 4 * j + 1], st = tab[16 + 4 * j + 2];
        u.pm = st; u.pn = ct; u.arow = st * BM; u.acol = 0; u.brow = e * brows + ct * BM; u.aux = e;
        const int cnt = (int)ecnt[64 * e]; u.gcnt = cnt - rt * BM; u.gl = elist + e * 16384 + rt * BM; return true;
    }
};

template <int ACT  > struct EpiBf16 {
    static constexpr bool PERM = true;
    bf16* O; int ldc;
    __device__ __forceinline__ void operator()(const f32x4 (&acc)[2][2][4][2], const Unit& u, int wr, int wc, int fr, int fq) const {
        const int row0 = u.pm * BM + wr * 64 + fr, col0 = u.pn * BM + wc * 32 + 8 * fq;
#pragma unroll
        for (int ai = 0; ai < 2; ++ai)
#pragma unroll
            for (int m = 0; m < 4; ++m) { bf16* rowp = O + (size_t)(row0 + ai * HALF + m * 16) * ldc + col0;
#pragma unroll
                for (int bj = 0; bj < 2; ++bj) { f32x4 v0 = acc[ai][bj][m][0], v1 = acc[ai][bj][m][1];
                    if (ACT == 1) {
#pragma unroll
                        for (int j = 0; j < 4; ++j) { v0[j] = sigmoidf_(v0[j]); v1[j] = sigmoidf_(v1[j]); } }
                    u32x4 w; w.x = cvt_pk_bf16(v0[0], v0[1]); w.y = cvt_pk_bf16(v0[2], v0[3]); w.z = cvt_pk_bf16(v1[0], v1[1]); w.w = cvt_pk_bf16(v1[2], v1[3]);
                    *(u32x4*)(rowp + bj * HALF) = w; } }
    }
};
struct EpiGateAcc {
    static constexpr bool PERM = true;
    const bf16* Gt; bf16* Mg;
    __device__ __forceinline__ void operator()(const f32x4 (&acc)[2][2][4][2], const Unit& u, int wr, int wc, int fr, int fq) const {
        const int row0 = u.pm * BM + wr * 64 + fr, col0 = u.pn * BM + wc * 32 + 8 * fq, b = u.aux;
#pragma unroll
        for (int ai = 0; ai < 2; ++ai)
#pragma unroll
            for (int m = 0; m < 4; ++m) { const size_t r = (size_t)(row0 + ai * HALF + m * 16);
#pragma unroll
                for (int bj = 0; bj < 2; ++bj) {
                    const u32x4 gw = *(const u32x4*)(Gt + r * 4096 + b * 1024 + col0 + bj * HALF);
                    bf16* mp = Mg + r * 1024 + col0 + bj * HALF;
                    u32x4 ow = (u32x4){0u, 0u, 0u, 0u}; if (b != 0) ow = *(const u32x4*)mp;
                    const f32x4 v0 = acc[ai][bj][m][0], v1 = acc[ai][bj][m][1];
                    u32x4 w;
                    w.x = cvt_pk_bf16(bflo(ow.x) + bflo(gw.x) * v0[0], bfhi(ow.x) + bfhi(gw.x) * v0[1]);
                    w.y = cvt_pk_bf16(bflo(ow.y) + bflo(gw.y) * v0[2], bfhi(ow.y) + bfhi(gw.y) * v0[3]);
                    w.z = cvt_pk_bf16(bflo(ow.z) + bflo(gw.z) * v1[0], bfhi(ow.z) + bfhi(gw.z) * v1[1]);
                    w.w = cvt_pk_bf16(bflo(ow.w) + bflo(gw.w) * v1[2], bfhi(ow.w) + bfhi(gw.w) * v1[3]);
                    *(u32x4*)mp = w; }
                asm volatile("" ::: "memory"); }
    }
};
struct EpiResF32 {
    static constexpr bool PERM = false;
    const float* base; float* out; int ldc;
    __device__ __forceinline__ void operator()(const f32x4 (&acc)[2][2][4][2], const Unit& u, int wr, int wc, int fr, int fq) const {
        const int row0 = u.pm * BM + wr * 64 + fr, col0 = u.pn * BM + wc * 32 + 4 * fq;
#pragma unroll
        for (int ai = 0; ai < 2; ++ai)
#pragma unroll
            for (int m = 0; m < 4; ++m) { const size_t off = (size_t)(row0 + ai * HALF + m * 16) * ldc + col0;
#pragma unroll
                for (int bj = 0; bj < 2; ++bj)
#pragma unroll
                    for (int n = 0; n < 2; ++n) { const f32x4 bs = *(const f32x4*)(base + off + bj * HALF + n * 16); *(f32x4*)(out + off + bj * HALF + n * 16) = bs + acc[ai][bj][m][n]; }
                if (m & 1) asm volatile("" ::: "memory"); }
    }
};
struct EpiSwiGlu {
    static constexpr bool PERM = true;
    bf16* Hd;
    __device__ __forceinline__ void operator()(const f32x4 (&acc)[2][2][4][2], const Unit& u, int wr, int wc, int fr, int fq) const {
        const int row0 = u.pm * BM + wr * 64 + fr, col0 = u.pn * HALF + wc * 32 + 8 * fq;
#pragma unroll
        for (int ai = 0; ai < 2; ++ai)
#pragma unroll
            for (int m = 0; m < 4; ++m) { bf16* rowp = Hd + (size_t)(row0 + ai * HALF + m * 16) * DEXP + col0;
                f32x4 o0, o1;
#pragma unroll
                for (int j = 0; j < 4; ++j) { const float a0 = acc[ai][0][m][0][j], a1 = acc[ai][0][m][1][j];
                    o0[j] = a0 * sigmoidf_(a0) * acc[ai][1][m][0][j]; o1[j] = a1 * sigmoidf_(a1) * acc[ai][1][m][1][j]; }
                u32x4 w; w.x = cvt_pk_bf16(o0[0], o0[1]); w.y = cvt_pk_bf16(o0[2], o0[3]); w.z = cvt_pk_bf16(o1[0], o1[1]); w.w = cvt_pk_bf16(o1[2], o1[3]);
                *(u32x4*)rowp = w; }
    }
};
}

#define XB_TMO      128
#define XB_XCNT(j)  (256  + 64 * (j))
#define XB_XSUB(j)  (1280 + 64 * (j))
#define XB_XGEN(j)  (2304 + 64 * (j))
#define XB_TOP      3328
#define XB_TOPGEN   3392
#define XCD_BAR_WORDS 3456
#define XB_SPIN_CAP (1u << 20)
__device__ __forceinline__ unsigned xb_ld(unsigned* p)              { return __hip_atomic_load(p, __ATOMIC_RELAXED, __HIP_MEMORY_SCOPE_AGENT); }
__device__ __forceinline__ unsigned xb_add(unsigned* p, unsigned v) { return __hip_atomic_fetch_add(p, v, __ATOMIC_RELAXED, __HIP_MEMORY_SCOPE_AGENT); }
__device__ __forceinline__ unsigned xb_xcc_id() { return (unsigned)__builtin_amdgcn_s_getreg((3 << 11) | 20) & 0xFu; }
#define XB_SPIN(cond, bar) do { unsigned _sp = 0; while (cond) { __builtin_amdgcn_s_sleep(1); \
    if ((++_sp & 255u) == 0u) { if (xb_ld(&(bar)[XB_TMO])) break; if (_sp > XB_SPIN_CAP) { atomicAdd(&(bar)[XB_TMO], 1u); break; } } } } while (0)
struct XcdBarrier { unsigned* bar; unsigned x; volatile LAS unsigned* st; };
__device__ __forceinline__ XcdBarrier xcd_barrier_post(unsigned* bar, volatile LAS unsigned* st) {
    XcdBarrier b; b.bar = bar; b.x = xb_xcc_id(); b.st = st;
    if (threadIdx.x == 0) (void)xb_add(&bar[XB_XCNT(b.x)], 1u);
    return b;
}
__device__ __forceinline__ void xcd_barrier_complete(unsigned* bar, unsigned x, unsigned& nloc, unsigned& nx) {
    const unsigned G = gridDim.x * gridDim.y * gridDim.z;
    unsigned sum, cnt, mine, sp = 0u;
    for (;;) {
        sum = 0u; cnt = 0u; mine = 0u;
#pragma unroll
        for (unsigned j = 0; j < 16; ++j) { const unsigned c = xb_ld(&bar[XB_XCNT(j)]); sum += c; cnt += (c > 0u) ? 1u : 0u; mine = (j == x) ? c : mine; }
        if (sum == G) break;
        __builtin_amdgcn_s_sleep(1);
        if ((++sp & 255u) == 0u) { if (xb_ld(&bar[XB_TMO])) break; if (sp > XB_SPIN_CAP) { atomicAdd(&bar[XB_TMO], 1u); break; } }
    }
    nloc = mine > 0u ? mine : 1u; nx = cnt > 0u ? cnt : 1u;
}
__device__ __forceinline__ void xcd_barrier(const XcdBarrier& b) {
    asm volatile("s_waitcnt vmcnt(0)" ::: "memory");
    __syncthreads();
    if (threadIdx.x == 0) {
        unsigned* bar = b.bar;
        __builtin_amdgcn_s_waitcnt(0);
        unsigned nloc = b.st[0], nx = b.st[1];
        if (nloc == 0u) { xcd_barrier_complete(bar, b.x, nloc, nx); b.st[0] = nloc; b.st[1] = nx; }
        const unsigned old = xb_add(&bar[XB_XSUB(b.x)], 1u);
        const unsigned gen = old / nloc;
        if (old + 1u == (gen + 1u) * nloc) {
            __builtin_amdgcn_fence(__ATOMIC_RELEASE, "agent");
            asm volatile("s_waitcnt vmcnt(0)" ::: "memory");
            const unsigned og = xb_add(&bar[XB_TOP], 1u);
            const unsigned tg = og / nx;
            if (og + 1u == (tg + 1u) * nx) xb_add(&bar[XB_TOPGEN], 1u);
            else XB_SPIN(xb_ld(&bar[XB_TOPGEN]) == tg, bar);
            __builtin_amdgcn_fence(__ATOMIC_ACQUIRE, "agent");
            xb_add(&bar[XB_XGEN(b.x)], 1u);
            asm volatile("s_waitcnt vmcnt(0)" ::: "memory");
        } else {
            XB_SPIN(xb_ld(&bar[XB_XGEN(b.x)]) == gen, bar);
            __builtin_amdgcn_fence(__ATOMIC_ACQUIRE, "agent");
            asm volatile("s_waitcnt vmcnt(0)" ::: "memory");
        }
    }
    __syncthreads();
}

struct Args {
    const float* in[31]; float* out; unsigned char* ws; int ph_lo, ph_hi;
};
enum InIdx { I_X = 0, I_MEM, I_NORM_MIX, I_W_IN, I_CONV_W, I_CONV_B, I_LRU_WA, I_LRU_BA, I_LRU_WX, I_LRU_BX, I_LRU_LAMBDA, I_CA_REL, I_DIFF_LAMBDA, I_DIFF_SUBLN,
             I_W_BRANCH, I_W_OUT, I_NORM_MEM, I_MEM_NORM, I_W_MQ, I_W_MK, I_W_MV, I_W_MO, I_NORM_FFN, I_W_GROUP, I_B_GROUP, I_W_ROUTER, I_B_ROUTER, I_W1, I_W3, I_W2, I_FINAL_NORM };

__device__ __forceinline__ void transpose_item(const float* W, int K, int N, bf16* WT, int row_off, LAS float* scr, int item, int lane) {
    const int nblk = N / 32, kb = item / nblk, nb = item % nblk, k0 = 64 * kb, n0 = 32 * nb;
#pragma unroll 8
    for (int i = 0; i < 32; ++i) { const int kk = 2 * i + (lane >> 5); scr[kk * 33 + (lane & 31)] = W[(size_t)(k0 + kk) * N + n0 + (lane & 31)]; }
    LDS_WAIT(); asm volatile("" ::: "memory");
    const int c = lane & 7;
#pragma unroll
    for (int j = 0; j < 4; ++j) { const int n = (lane >> 3) + 8 * j; const LAS float* s = scr + (8 * c) * 33 + n;
        u32x4 o; o.x = pk2(s[0 * 33], s[1 * 33]); o.y = pk2(s[2 * 33], s[3 * 33]); o.z = pk2(s[4 * 33], s[5 * 33]); o.w = pk2(s[6 * 33], s[7 * 33]);
        *(u32x4*)(WT + (size_t)(row_off + n0 + n) * K + k0 + 8 * c) = o; }
    LDS_WAIT(); asm volatile("" ::: "memory");
}
__device__ __forceinline__ void rms_row_to_bf16(const float* xrow, const float* g, bf16* orow, int lane) {
    const f32x4* xr = (const f32x4*)xrow + lane; const f32x4* gr = (const f32x4*)g + lane;
    f32x4 v[4]; float s = 0.f;
#pragma unroll
    for (int j = 0; j < 4; ++j) { v[j] = xr[64 * j]; s += (v[j].x * v[j].x + v[j].y * v[j].y) + (v[j].z * v[j].z + v[j].w * v[j].w); }
    const float rstd = 1.f / sqrtf(wave_sum(s) * (1.f / D) + NORM_EPS);
    unsigned long long* o8 = (unsigned long long*)orow + lane;
#pragma unroll
    for (int j = 0; j < 4; ++j) { const f32x4 gg = gr[64 * j];
        o8[64 * j] = (unsigned long long)pk2(v[j].x * rstd * gg.x, v[j].y * rstd * gg.y) | ((unsigned long long)pk2(v[j].z * rstd * gg.z, v[j].w * rstd * gg.w) << 32); }
}
__device__ __forceinline__ void convert_experts(const float* w1, const float* w3, const float* w2, bf16* W13, bf16* W2T, LAS float* scr, int gw, int NGW, int lane) {
    constexpr int I_13 = (D / 64) * (DEXP / 32);
    constexpr int I_2 = (DEXP / 64) * (D / 32);
    for (int it = gw; it < NEXP * (2 * I_13 + I_2); it += NGW) {
        const int e = it / (2 * I_13 + I_2); int r = it % (2 * I_13 + I_2);
        if (r < 2 * I_13) { const int which = r / I_13; r %= I_13; const int nb = r % (DEXP / 32), n0 = nb * 32;
            const int row_off = (n0 / 128) * 256 + which * 128 + (n0 % 128) - n0;
            transpose_item((which ? w3 : w1) + (size_t)e * D * DEXP, D, DEXP, W13 + (size_t)e * 1024 * 1024, row_off, scr, r, lane); }
        else { r -= 2 * I_13; transpose_item(w2 + (size_t)e * DEXP * D, DEXP, D, W2T + (size_t)e * 1024 * 512, 0, scr, r, lane); }
    }
}

namespace att {
typedef short v4i16_t __attribute__((ext_vector_type(4)));
__device__ __forceinline__ s16x4 vtr(const LAS char* p) { return __builtin_bit_cast(s16x4, __builtin_amdgcn_ds_read_tr16_b64_v4i16((LAS v4i16_t*)p)); }
__device__ __forceinline__ int crow(int r, int hi) { return (r & 3) + 8 * (r >> 2) + 4 * hi; }
__device__ __forceinline__ float xmax(float v) { auto rr = __builtin_amdgcn_permlane32_swap(__float_as_uint(v), __float_as_uint(v), false, false); return fmaxf(__uint_as_float(rr[0]), __uint_as_float(rr[1])); }
__device__ __forceinline__ float xsum(float v) { auto rr = __builtin_amdgcn_permlane32_swap(__float_as_uint(v), __float_as_uint(v), false, false); return __uint_as_float(rr[0]) + __uint_as_float(rr[1]); }
__device__ __forceinline__ bf16x8 vfrag(const LAS char* p) { const s16x4 lo = vtr(p), hi = vtr(p + 512); return (bf16x8){lo[0], lo[1], lo[2], lo[3], hi[0], hi[1], hi[2], hi[3]}; }
__device__ __forceinline__ int vbase(int lane) { const int hi = lane >> 5; return ((lane >> 4) & 1) * 32 + (lane & 3) * 8 + (4 * hi + ((lane & 15) >> 2)) * 64; }
__device__ __forceinline__ bf16x8 pack8(const f32x16& p, int r0) {
    u32x4 w; w.x = cvt_pk_bf16(p[r0], p[r0 + 1]); w.y = cvt_pk_bf16(p[r0 + 2], p[r0 + 3]); w.z = cvt_pk_bf16(p[r0 + 4], p[r0 + 5]); w.w = cvt_pk_bf16(p[r0 + 6], p[r0 + 7]);
    return __builtin_bit_cast(bf16x8, w);
}

struct AttnP {
    const bf16* Q; const bf16* K; const bf16* V; bf16* O; int ldq, ldk, ldv, ldo;
    int q0;
    int t_begin, t_end;
    float c;
    float slope;
    const LAS float* tab;
};
template <int DQK, int DV> struct Lay { static constexpr int KB = DQK * 128, VB = DV * 128, K0 = 0, V0 = 2 * KB, WSF = V0 + 2 * VB, END = WSF + 8 * 64 * 4; };

template <int DQK, int DV, int MODE>
__device__ __forceinline__ void attn_unit(LAS char* lds, const AttnP& P, const int tid) {
    typedef Lay<DQK, DV> L;
    constexpr int NKP = DQK / 64, NVP = DV / 64, ND0 = DQK / 16, NDB = DV / 32;
    const int lane = tid & 63, r32 = lane & 31, hi = lane >> 5; const int wid = __builtin_amdgcn_readfirstlane(tid >> 6);
    const int qrow0 = P.q0 + 32 * wid;
    const int cq = qrow0 >> 6;
    int wlo = P.t_begin, whi = P.t_end - 1;
    if (MODE == 1) { wlo = cq - 8 < 0 ? 0 : cq - 8; whi = cq; }
    if (MODE == 2) { whi = cq; }
    LAS float* wsf = (LAS float*)(lds + L::WSF) + wid * 64;
    bf16x8 qr[ND0];
#pragma unroll
    for (int d0 = 0; d0 < ND0; ++d0) qr[d0] = *(const bf16x8*)(P.Q + (size_t)(qrow0 + r32) * P.ldq + d0 * 16 + hi * 8);
    f32x16 o[NDB];
#pragma unroll
    for (int db = 0; db < NDB; ++db) o[db] = (f32x16){};
    float mrun = -1e30f, lrun = 0.f;
    const int qpos = qrow0 + r32;
    u32x4 kreg[NKP], vreg[NVP];
#define ATT_LOAD(t) do { _Pragma("unroll") for (int i_ = 0; i_ < NKP; ++i_) kreg[i_] = *(const u32x4*)(P.K + (size_t)(64 * (t) + lane) * P.ldk + (wid + 8 * i_) * 8); \
        _Pragma("unroll") for (int i_ = 0; i_ < NVP; ++i_) { const int p_ = wid + 8 * i_, db_ = p_ >> 2, rg_ = p_ & 3; \
            vreg[i_] = *(const u32x4*)(P.V + (size_t)(64 * (t) + 16 * rg_ + (lane >> 2)) * P.ldv + 32 * db_ + (lane & 3) * 8); } } while (0)
#define ATT_STORE(buf) do { _Pragma("unroll") for (int i_ = 0; i_ < NKP; ++i_) *(LAS u32x4*)(lds + L::K0 + (buf) * L::KB + (wid + 8 * i_) * 1024 + lane * 16) = kreg[i_]; \
        _Pragma("unroll") for (int i_ = 0; i_ < NVP; ++i_) *(LAS u32x4*)(lds + L::V0 + (buf) * L::VB + (wid + 8 * i_) * 1024 + lane * 16) = vreg[i_]; } while (0)
    ATT_LOAD(P.t_begin); ATT_STORE(0);
    __syncthreads();
    const int vb = vbase(lane);
    for (int t = P.t_begin; t < P.t_end; ++t) {
        const int buf = (t - P.t_begin) & 1;
        if (t + 1 < P.t_end) ATT_LOAD(t + 1);
        if (t >= wlo && t <= whi) {
            const LAS char* kp = lds + L::K0 + buf * L::KB + hi * 1024 + r32 * 16;
            f32x16 p0 = (f32x16){}, p1 = (f32x16){};
#pragma unroll
            for (int d0 = 0; d0 < ND0; ++d0) {
                const bf16x8 b0 = *(const LAS bf16x8*)(kp + d0 * 2048), b1 = *(const LAS bf16x8*)(kp + d0 * 2048 + 512);
                p0 = __builtin_amdgcn_mfma_f32_32x32x16_bf16(b0, qr[d0], p0, 0, 0, 0);
                p1 = __builtin_amdgcn_mfma_f32_32x32x16_bf16(b1, qr[d0], p1, 0, 0, 0);
            }
            if (MODE == 0) {
#pragma unroll
                for (int r = 0; r < 16; ++r) { p0[r] *= P.c; p1[r] *= P.c; }
            } else if (MODE == 1) {
                const int jrel = t - (cq - 8);
                if (jrel <= 5) { const float bc = P.tab[256];
#pragma unroll
                    for (int r = 0; r < 16; ++r) { p0[r] = fmaf(p0[r], P.c, bc); p1[r] = fmaf(p1[r], P.c, bc); }
                } else {
                    const int dbase = qpos - 64 * t - 4 * hi;
#pragma unroll
                    for (int r = 0; r < 16; ++r) { const int d0_ = dbase - ((r & 3) + 8 * (r >> 2)), d1_ = d0_ - 32;
                        const int i0 = (d0_ < -128 ? -128 : (d0_ > 128 ? 128 : d0_)) + 128, i1 = (d1_ < -128 ? -128 : (d1_ > 128 ? 128 : d1_)) + 128;
                        p0[r] = fmaf(p0[r], P.c, P.tab[i0]); p1[r] = fmaf(p1[r], P.c, P.tab[i1]); }
                }
            } else {
                const float xb = (float)(qpos - 64 * t - 4 * hi);
#pragma unroll
                for (int r = 0; r < 16; ++r) { const float x0 = xb - (float)((r & 3) + 8 * (r >> 2)), x1 = x0 - 32.f;
                    p0[r] = fmaf(-P.slope, fabsf(x0), p0[r] * P.c); p1[r] = fmaf(-P.slope, fabsf(x1), p1[r] * P.c); }
            }
            float rm = fmaxf(p0[0], p1[0]);
#pragma unroll
            for (int r = 1; r < 16; ++r) rm = fmaxf(rm, fmaxf(p0[r], p1[r]));
            rm = xmax(rm);
            if (__any(rm > mrun + 8.f)) {
                const float mn = fmaxf(mrun, rm), al = fexp2(mrun - mn); mrun = mn; lrun *= al;
                if (hi == 0) wsf[r32] = al;
                LDS_WAIT();
#pragma unroll
                for (int r = 0; r < 16; ++r) { const float a = wsf[crow(r, hi)];
#pragma unroll
                    for (int db = 0; db < NDB; ++db) o[db][r] *= a; }
            }
            float ls = 0.f;
#pragma unroll
            for (int r = 0; r < 16; ++r) { p0[r] = fexp2(p0[r] - mrun); p1[r] = fexp2(p1[r] - mrun); ls += p0[r] + p1[r]; }
            lrun += ls;
            const bf16x8 pw0 = pack8(p0, 0), pw1 = pack8(p0, 8), pw2 = pack8(p1, 0), pw3 = pack8(p1, 8);
            const LAS char* vp = lds + L::V0 + buf * L::VB + vb;
#pragma unroll
            for (int db = 0; db < NDB; ++db) {
                o[db] = __builtin_amdgcn_mfma_f32_32x32x16_bf16(pw0, vfrag(vp + db * 4096 + 0 * 1024), o[db], 0, 0, 0);
                o[db] = __builtin_amdgcn_mfma_f32_32x32x16_bf16(pw1, vfrag(vp + db * 4096 + 1 * 1024), o[db], 0, 0, 0);
                o[db] = __builtin_amdgcn_mfma_f32_32x32x16_bf16(pw2, vfrag(vp + db * 4096 + 2 * 1024), o[db], 0, 0, 0);
                o[db] = __builtin_amdgcn_mfma_f32_32x32x16_bf16(pw3, vfrag(vp + db * 4096 + 3 * 1024), o[db], 0, 0, 0);
            }
        }
        if (t + 1 < P.t_end) ATT_STORE(buf ^ 1);
        __syncthreads();
    }
#undef ATT_LOAD
#undef ATT_STORE
    const float lt = xsum(lrun);
    if (hi == 0) wsf[r32] = 1.0f / lt;
    LDS_WAIT();
#pragma unroll
    for (int r = 0; r < 16; ++r) { const int qr_ = crow(r, hi); const float inv = wsf[qr_];
        bf16* orow = P.O + (size_t)(qrow0 + qr_) * P.ldo + r32;
#pragma unroll
        for (int db = 0; db < NDB; ++db) orow[db * 32] = (bf16)f2bf(o[db][r] * inv); }
    LDS_WAIT();
}
}

namespace ret {
using att::crow; using att::vfrag; using att::vbase; using att::pack8; using att::xsum;
__device__ __forceinline__ float gamma_log2(int h) { return log2f(1.0f - exp2f(-5.0f - (float)h)); }
template <bool SCALE>
__device__ __forceinline__ void stage_tile(LAS char* dst, const bf16* src, int ld, int lane, float lg2, float mul) {
#pragma unroll
    for (int p = 0; p < 8; ++p) { const int db = p >> 2, rg = p & 3, row = 16 * rg + (lane >> 2), col = 32 * db + (lane & 3) * 8;
        u32x4 v = *(const u32x4*)(src + (size_t)row * ld + col);
        if (SCALE) { const float s = fexp2(lg2 * (float)(63 - row)) * mul;
            v.x = cvt_pk_bf16(bflo(v.x) * s, bfhi(v.x) * s); v.y = cvt_pk_bf16(bflo(v.y) * s, bfhi(v.y) * s); v.z = cvt_pk_bf16(bflo(v.z) * s, bfhi(v.z) * s); v.w = cvt_pk_bf16(bflo(v.w) * s, bfhi(v.w) * s); }
        *(LAS u32x4*)(dst + p * 1024 + lane * 16) = v; }
}
__device__ __forceinline__ void kv_unit(LAS char* wl, const bf16* z, float* kvT, int c, int h, int lane) {
    const int hi = lane >> 5, r32 = lane & 31;
    const bf16* kp = z + (size_t)(c * CHUNK) * ZC + Z_CK + h * 64; const bf16* vp = z + (size_t)(c * CHUNK) * ZC + Z_CV + h * 64;
    stage_tile<true>(wl, kp, ZC, lane, gamma_log2(h), 0.125f);
    stage_tile<false>(wl + 8192, vp, ZC, lane, 0.f, 1.f);
    LDS_WAIT();
    const int vb = vbase(lane);
    f32x16 acc[2][2];
#pragma unroll
    for (int dt = 0; dt < 2; ++dt)
#pragma unroll
        for (int et = 0; et < 2; ++et) { acc[dt][et] = (f32x16){};
#pragma unroll
            for (int ks = 0; ks < 4; ++ks) acc[dt][et] = __builtin_amdgcn_mfma_f32_32x32x16_bf16(vfrag(wl + vb + dt * 4096 + ks * 1024), vfrag(wl + 8192 + vb + et * 4096 + ks * 1024), acc[dt][et], 0, 0, 0); }
    float* ob = kvT + ((size_t)(c * 8 + h) * 64) * 64;
#pragma unroll
    for (int dt = 0; dt < 2; ++dt)
#pragma unroll
        for (int et = 0; et < 2; ++et)
#pragma unroll
            for (int g4 = 0; g4 < 4; ++g4)
                *(f32x4*)(ob + (size_t)(32 * et + r32) * 64 + 32 * dt + 8 * g4 + 4 * hi) = (f32x4){acc[dt][et][4 * g4], acc[dt][et][4 * g4 + 1], acc[dt][et][4 * g4 + 2], acc[dt][et][4 * g4 + 3]};
    LDS_WAIT();
}
__device__ __forceinline__ void out_unit(LAS char* wl, const bf16* z, const bf16* rT, bf16* y, int c, int h, int lane) {
    const int hi = lane >> 5, r32 = lane & 31;
    const size_t row0 = (size_t)c * CHUNK;
    const bf16* qp = z + row0 * ZC + Z_CQ + h * 64; const bf16* kp = z + row0 * ZC + Z_CK + h * 64; const bf16* vp = z + row0 * ZC + Z_CV + h * 64; const bf16* gp = z + row0 * ZC + Z_CG + h * 64;
    const bf16* rp = rT + ((size_t)(c * 8 + h) * 64) * 64;
    stage_tile<false>(wl, vp, ZC, lane, 0.f, 1.f);
    const float lg2 = gamma_log2(h);
    LDS_WAIT();
    const int vb = vbase(lane);
    bf16* yo = y + row0 * YC + 1024 + h * 64;
#pragma unroll 1
    for (int nt = 0; nt < 2; ++nt) {
        const int i = 32 * nt + r32;
        bf16x8 qf[4];
#pragma unroll
        for (int s = 0; s < 4; ++s) qf[s] = *(const bf16x8*)(qp + (size_t)i * ZC + 16 * s + 8 * hi);
        f32x16 oT[2], cr[2];
#pragma unroll
        for (int et = 0; et < 2; ++et) { oT[et] = (f32x16){}; cr[et] = (f32x16){};
#pragma unroll
            for (int s = 0; s < 4; ++s) cr[et] = __builtin_amdgcn_mfma_f32_32x32x16_bf16(*(const bf16x8*)(rp + (size_t)(32 * et + r32) * 64 + 16 * s + 8 * hi), qf[s], cr[et], 0, 0, 0); }
#pragma unroll
        for (int mt = 0; mt < 2; ++mt) {
            f32x16 st = (f32x16){};
#pragma unroll
            for (int s = 0; s < 4; ++s) st = __builtin_amdgcn_mfma_f32_32x32x16_bf16(*(const bf16x8*)(kp + (size_t)(32 * mt + r32) * ZC + 16 * s + 8 * hi), qf[s], st, 0, 0, 0);
#pragma unroll
            for (int r = 0; r < 16; ++r) { const int j = 32 * mt + crow(r, hi); const float w = (i >= j) ? fexp2(lg2 * (float)(i - j)) * 0.125f : 0.f; st[r] *= w; }
            const bf16x8 pA = pack8(st, 0), pB = pack8(st, 8);
#pragma unroll
            for (int et = 0; et < 2; ++et) {
                oT[et] = __builtin_amdgcn_mfma_f32_32x32x16_bf16(vfrag(wl + vb + et * 4096 + (2 * mt) * 1024), pA, oT[et], 0, 0, 0);
                oT[et] = __builtin_amdgcn_mfma_f32_32x32x16_bf16(vfrag(wl + vb + et * 4096 + (2 * mt + 1) * 1024), pB, oT[et], 0, 0, 0); }
        }
        const float xi = fexp2(lg2 * (float)(i + 1));
        float s1 = 0.f;
#pragma unroll
        for (int et = 0; et < 2; ++et)
#pragma unroll
            for (int r = 0; r < 16; ++r) { oT[et][r] = fmaf(xi, cr[et][r], oT[et][r]); s1 += oT[et][r]; }
        const float mean = xsum(s1) * (1.f / 64.f);
        float s2 = 0.f;
#pragma unroll
        for (int et = 0; et < 2; ++et)
#pragma unroll
            for (int r = 0; r < 16; ++r) { oT[et][r] -= mean; s2 += oT[et][r] * oT[et][r]; }
        const float rstd = 1.0f / sqrtf(xsum(s2) * (1.f / 64.f) + GN_EPS);
#pragma unroll
        for (int et = 0; et < 2; ++et)
#pragma unroll
            for (int g4 = 0; g4 < 4; ++g4) { const int e = 32 * et + 8 * g4 + 4 * hi;
                const u32x2 gw = *(const u32x2*)(gp + (size_t)i * ZC + e);
                const float g0 = bflo(gw.x), g1 = bfhi(gw.x), g2 = bflo(gw.y), g3 = bfhi(gw.y);
                u32x2 w; w.x = cvt_pk_bf16(g0 * sigmoidf_(g0) * oT[et][4 * g4] * rstd, g1 * sigmoidf_(g1) * oT[et][4 * g4 + 1] * rstd);
                w.y = cvt_pk_bf16(g2 * sigmoidf_(g2) * oT[et][4 * g4 + 2] * rstd, g3 * sigmoidf_(g3) * oT[et][4 * g4 + 3] * rstd);
                *(u32x2*)(yo + (size_t)i * YC + e) = w; }
    }
    LDS_WAIT();
}
}

namespace lru {
struct LruP { const bf16* z; const float *conv_w, *conv_b, *wa, *ba, *wx, *bx, *lam; float *carA, *carH; const float* carI; bf16* y; };
constexpr int XS = 144;
template <bool FINAL>
__device__ __forceinline__ void unit(LAS char* wl, const LruP& P, int seg, int k, int lane) {
    const int r32 = lane & 31, hi = lane >> 5;
    LAS float* tb = (LAS float*)(wl + 5120);
    { const int ch = k * 64 + lane;
      tb[0 * 64 + lane] = P.conv_w[ch]; tb[1 * 64 + lane] = P.conv_w[512 + ch]; tb[2 * 64 + lane] = P.conv_w[1024 + ch]; tb[3 * 64 + lane] = P.conv_w[1536 + ch];
      tb[4 * 64 + lane] = P.conv_b[ch]; tb[5 * 64 + lane] = P.ba[ch]; tb[6 * 64 + lane] = P.bx[ch]; tb[7 * 64 + lane] = 8.0f * log1pf(expf(-P.lam[ch])); }
#pragma unroll 1
    for (int mt = 0; mt < 2; ++mt) {
        bf16x8 WA[4], WX[4];
#pragma unroll
        for (int s = 0; s < 4; ++s) { u32x4 wa_, wx_; float fa[8], fx[8];
#pragma unroll
            for (int j = 0; j < 8; ++j) { const size_t o = (size_t)(k * 64 + 16 * s + 8 * hi + j) * 64 + 32 * mt + r32; fa[j] = P.wa[o]; fx[j] = P.wx[o]; }
            wa_.x = pk2(fa[0], fa[1]); wa_.y = pk2(fa[2], fa[3]); wa_.z = pk2(fa[4], fa[5]); wa_.w = pk2(fa[6], fa[7]);
            wx_.x = pk2(fx[0], fx[1]); wx_.y = pk2(fx[2], fx[3]); wx_.z = pk2(fx[4], fx[5]); wx_.w = pk2(fx[6], fx[7]);
            WA[s] = __builtin_bit_cast(bf16x8, wa_); WX[s] = __builtin_bit_cast(bf16x8, wx_); }
        f32x16 hin, apr;
#pragma unroll
        for (int g4 = 0; g4 < 4; ++g4) { f32x4 c4 = (f32x4){0.f, 0.f, 0.f, 0.f};
            if (FINAL) c4 = *(const f32x4*)(P.carI + (size_t)seg * 512 + k * 64 + 32 * mt + 8 * g4 + 4 * hi);
#pragma unroll
            for (int j = 0; j < 4; ++j) { hin[4 * g4 + j] = c4[j]; apr[4 * g4 + j] = 1.f; } }
#pragma unroll 1
        for (int half = 0; half < 2; ++half) {
            const int t0 = seg * 64 + half * 32;
#pragma unroll
            for (int i = 0; i < 5; ++i) { const int rr = i * 8 + (lane >> 3); if (rr < 35) { const int t = t0 - 3 + rr; u32x4 v = (u32x4){0u, 0u, 0u, 0u};
                    if (t >= 0) v = *(const u32x4*)(P.z + (size_t)t * ZC + Z_AX + k * 64 + (lane & 7) * 8);
                    *(LAS u32x4*)(wl + rr * XS + (lane & 7) * 16) = v; } }
            LDS_WAIT();
            f32x16 aA = (f32x16){}, aX = (f32x16){}, aI = (f32x16){};
#pragma unroll
            for (int s = 0; s < 4; ++s) {
                const int c0 = 16 * s + 8 * hi; float xc[8];
                { const f32x4 b0 = *(const LAS f32x4*)(tb + 4 * 64 + c0), b1 = *(const LAS f32x4*)(tb + 4 * 64 + c0 + 4);
                  xc[0] = b0[0]; xc[1] = b0[1]; xc[2] = b0[2]; xc[3] = b0[3]; xc[4] = b1[0]; xc[5] = b1[1]; xc[6] = b1[2]; xc[7] = b1[3]; }
#pragma unroll
                for (int jr = 0; jr < 4; ++jr) { const u32x4 xv = *(const LAS u32x4*)(wl + (r32 + jr) * XS + (2 * s + hi) * 16);
                    const f32x4 w0 = *(const LAS f32x4*)(tb + jr * 64 + c0), w1 = *(const LAS f32x4*)(tb + jr * 64 + c0 + 4);
                    xc[0] = fmaf(w0[0], bflo(xv.x), xc[0]); xc[1] = fmaf(w0[1], bfhi(xv.x), xc[1]); xc[2] = fmaf(w0[2], bflo(xv.y), xc[2]); xc[3] = fmaf(w0[3], bfhi(xv.y), xc[3]);
                    xc[4] = fmaf(w1[0], bflo(xv.z), xc[4]); xc[5] = fmaf(w1[1], bfhi(xv.z), xc[5]); xc[6] = fmaf(w1[2], bflo(xv.w), xc[6]); xc[7] = fmaf(w1[3], bfhi(xv.w), xc[7]); }
                u32x4 pw; pw.x = pk2(xc[0], xc[1]); pw.y = pk2(xc[2], xc[3]); pw.z = pk2(xc[4], xc[5]); pw.w = pk2(xc[6], xc[7]);
                const bf16x8 xb = __builtin_bit_cast(bf16x8, pw);
                aA = __builtin_amdgcn_mfma_f32_32x32x16_bf16(WA[s], xb, aA, 0, 0, 0);
                aX = __builtin_amdgcn_mfma_f32_32x32x16_bf16(WX[s], xb, aX, 0, 0, 0);
                u32x4 idw;
                { const int d = 32 * mt + r32 - 16 * s - 8 * hi;
                  idw.x = (d == 0 ? 0x3f80u : 0u) | (d == 1 ? 0x3f800000u : 0u); idw.y = (d == 2 ? 0x3f80u : 0u) | (d == 3 ? 0x3f800000u : 0u);
                  idw.z = (d == 4 ? 0x3f80u : 0u) | (d == 5 ? 0x3f800000u : 0u); idw.w = (d == 6 ? 0x3f80u : 0u) | (d == 7 ? 0x3f800000u : 0u); }
                aI = __builtin_amdgcn_mfma_f32_32x32x16_bf16(__builtin_bit_cast(bf16x8, idw), xb, aI, 0, 0, 0);
            }
#pragma unroll
            for (int g4 = 0; g4 < 4; ++g4) { const int cb_ = 32 * mt + 8 * g4 + 4 * hi;
                const f32x4 vba = *(const LAS f32x4*)(tb + 5 * 64 + cb_), vbx = *(const LAS f32x4*)(tb + 6 * 64 + cb_), vsp = *(const LAS f32x4*)(tb + 7 * 64 + cb_);
#pragma unroll
                for (int j = 0; j < 4; ++j) { const int r = 4 * g4 + j;
                    const float rg = sigmoidf_(aA[r] + vba[j]), ig = sigmoidf_(aX[r] + vbx[j]);
                    const float la = -rg * vsp[j];
                    aA[r] = fexp2(la * LOG2E);
                    aX[r] = sqrtf(-expm1f(2.0f * la)) * (ig * aI[r]); } }
#pragma unroll
            for (int r = 0; r < 16; ++r) { float a = aA[r], u = aX[r];
#pragma unroll
                for (int d = 1; d < 32; d <<= 1) { const float a2 = __shfl_up(a, d, 32), u2 = __shfl_up(u, d, 32); if (r32 >= d) { u = fmaf(a, u2, u); a *= a2; } }
                aA[r] = a; aX[r] = u; }
            if (FINAL) {
#pragma unroll
                for (int r = 0; r < 16; ++r) { const float h = fmaf(aA[r], hin[r], aX[r]); aX[r] = h; hin[r] = __shfl(h, 31, 32); }
#pragma unroll
                for (int g4 = 0; g4 < 4; ++g4) { const int cb_ = k * 64 + 32 * mt + 8 * g4 + 4 * hi;
                    const u32x2 gw = *(const u32x2*)(P.z + (size_t)(t0 + r32) * ZC + Z_AG + cb_);
                    float gv[4] = {bflo(gw.x), bfhi(gw.x), bflo(gw.y), bfhi(gw.y)}, o4[4];
#pragma unroll
                    for (int j = 0; j < 4; ++j) { const float g = gv[j]; o4[j] = aX[4 * g4 + j] * g * frcp(1.0f + fexp2(-1.5957691216f * LOG2E * (g + 0.044715f * g * g * g))); }
                    u32x2 w; w.x = pk2(o4[0], o4[1]); w.y = pk2(o4[2], o4[3]);
                    *(u32x2*)(P.y + (size_t)(t0 + r32) * YC + cb_) = w; }
            } else {
#pragma unroll
                for (int r = 0; r < 16; ++r) { const float a31 = __shfl(aA[r], 31, 32), u31 = __shfl(aX[r], 31, 32); hin[r] = fmaf(a31, hin[r], u31); apr[r] *= a31; }
            }
            LDS_WAIT();
        }
        if (!FINAL) { if (r32 == 0) {
#pragma unroll
            for (int g4 = 0; g4 < 4; ++g4) { const size_t o = (size_t)seg * 512 + k * 64 + 32 * mt + 8 * g4 + 4 * hi;
                *(f32x4*)(P.carA + o) = (f32x4){apr[4 * g4], apr[4 * g4 + 1], apr[4 * g4 + 2], apr[4 * g4 + 3]};
                *(f32x4*)(P.carH + o) = (f32x4){hin[4 * g4], hin[4 * g4 + 1], hin[4 * g4 + 2], hin[4 * g4 + 3]}; } } }
    }
}
}

constexpr int NPH_LAYER = 19, NPHASE = 2 + DEPTH * NPH_LAYER;

__global__ void __launch_bounds__(NTHREADS, 2) fwd_kernel(Args args) {
    extern __shared__ __attribute__((aligned(16))) unsigned char lds_raw[];
    LAS unsigned char* lds = (LAS unsigned char*)lds_raw;
    const int G = gridDim.x; const int bx = blockIdx.x;
    const int vcu = (G % 8 == 0) ? (bx % 8) * (G / 8) + bx / 8 : bx;
    const int NGW = G * NWAVES;
    typedef const __attribute__((address_space(4))) Args* KArgs;
#define PH_PTRS KArgs KA = (KArgs)__builtin_amdgcn_kernarg_segment_ptr(); asm volatile("" : "+s"(KA)); unsigned char* const ws = KA->ws; (void)ws; \
    int tid = threadIdx.x; asm volatile("" : "+v"(tid)); const int lane = tid & 63; const int wid = __builtin_amdgcn_readfirstlane(tid >> 6); const int gw = vcu * NWAVES + wid; (void)lane; (void)gw
#define ctl ((unsigned*)(ws + WS_CTL))
#define memn ((bf16*)(ws + WS_MEMN))
#define kvmem ((bf16*)(ws + WS_KMEM))
#define wtr ((bf16*)(ws + WS_WTR))
#define carA ((float*)(ws + WS_CARA))
#define carH ((float*)(ws + WS_CARH))
#define carI ((float*)(ws + WS_CARI))
#define tokE ((int*)(ws + WS_TOKE))
#define tokP ((int*)(ws + WS_TOKP))
#define tokW ((float*)(ws + WS_TOKW))
#define elist ((int*)(ws + WS_ELIST))
#define wt_in ((bf16*)(ws + WS_WIN))
#define wt_br ((bf16*)(ws + WS_WBR))
#define wt_out ((bf16*)(ws + WS_WOUT))
#define wt_mq ((bf16*)(ws + WS_WMQ))
#define wt_mk ((bf16*)(ws + WS_WMK))
#define wt_mv ((bf16*)(ws + WS_WMV))
#define wt_mo ((bf16*)(ws + WS_WMO))
#define w13 ((bf16*)(ws + WS_W13))
#define w2t ((bf16*)(ws + WS_W2))
#define hb ((bf16*)(ws + WS_H))
#define yb ((bf16*)(ws + WS_Y))
#define kvT ((float*)(ws + WS_KVT))
#define rT ((bf16*)(ws + WS_RT))
#define odb ((bf16*)(ws + WS_OD))
#define zb ((bf16*)(ws + WS_Z))
#define gtb ((bf16*)(ws + WS_G))
#define mrg ((bf16*)(ws + WS_MRG))
#define qb ((bf16*)(ws + WS_QB))
#define obf ((bf16*)(ws + WS_OB))
#define hid ((bf16*)(ws + WS_HID))
#define ymoe ((bf16*)(ws + WS_YMOE))
#define xin (KA->in[I_X])
#define xout (KA->out)
    volatile LAS unsigned* MISC = (volatile LAS unsigned*)(lds + LDS_MISC);
    if (threadIdx.x < 64) MISC[threadIdx.x] = 0u;
    __syncthreads();
    const int lo = args.ph_lo, hi_ph = args.ph_hi;
    XcdBarrier bar; bar.x = 0; bar.st = nullptr; bar.bar = nullptr;
    { PH_PTRS; bar.bar = ctl + CW_BAR; if (hi_ph - lo > 1) bar = xcd_barrier_post(ctl + CW_BAR, MISC + 8); }
#ifndef PH_EN
#define PH_EN 0xFFFFFFFFu
#endif
#define EN(p) (((PH_EN) >> (p)) & 1u)
#define IN(k) (lo <= (k) && (k) < hi_ph)
#define SEAM(k) do { if (IN(k) && IN((k) + 1)) xcd_barrier(bar); } while (0)

    if (EN(19) && IN(0)) { PH_PTRS;
        LAS float* scr = (LAS float*)(lds + wid * 16384);
        for (int l = 0; l < DEPTH; ++l) {
            constexpr int I_IN = (D / 64) * (INC / 32), I_BR = (512 / 64) * (D / 32), I_OUT = (D / 64) * (D / 32), I_MQ = (D / 64) * (512 / 32), I_MO = (512 / 64) * (D / 32);
            constexpr int NIT = I_IN + 4 * I_BR + I_OUT + 3 * I_MQ + I_MO;
            for (int it = gw; it < NIT; it += NGW) {
                int r = it;
                if (r < I_IN) { transpose_item(KA->in[I_W_IN] + (size_t)l * D * INC, D, INC, wt_in + (size_t)l * INC * D, 0, scr, r, lane); continue; } r -= I_IN;
                if (r < 4 * I_BR) { const int b = r / I_BR; transpose_item(KA->in[I_W_BRANCH] + (size_t)(l * 4 + b) * 512 * D, 512, D, wt_br + (size_t)(l * 4 + b) * D * 512, 0, scr, r % I_BR, lane); continue; } r -= 4 * I_BR;
                if (r < I_OUT) { transpose_item(KA->in[I_W_OUT] + (size_t)l * D * D, D, D, wt_out + (size_t)l * D * D, 0, scr, r, lane); continue; } r -= I_OUT;
                if (r < I_MQ) { transpose_item(KA->in[I_W_MQ] + (size_t)l * D * 512, D, 512, wt_mq + (size_t)l * 512 * D, 0, scr, r, lane); continue; } r -= I_MQ;
                if (r < I_MQ) { transpose_item(KA->in[I_W_MK] + (size_t)l * D * 512, D, 512, wt_mk + (size_t)l * 512 * D, 0, scr, r, lane); continue; } r -= I_MQ;
                if (r < I_MQ) { transpose_item(KA->in[I_W_MV] + (size_t)l * D * 512, D, 512, wt_mv + (size_t)l * 512 * D, 0, scr, r, lane); continue; } r -= I_MQ;
                transpose_item(KA->in[I_W_MO] + (size_t)l * 512 * D, 512, D, wt_mo + (size_t)l * D * 512, 0, scr, r, lane);
            }
        }
        convert_experts(KA->in[I_W1], KA->in[I_W3], KA->in[I_W2], w13, w2t, scr, gw, NGW, lane);
        for (int i = gw * 64 + lane; i < DEPTH * 64 * D; i += NGW * 64) { const int l = i / (64 * D), n = (i / D) % 64, k = i % D; float v = 0.f;
            if (n < 4) v = KA->in[I_W_GROUP][(size_t)(l * D + k) * 4 + n]; else if (n < 36) v = KA->in[I_W_ROUTER][(size_t)(l * D + k) * 32 + (n - 4)];
            wtr[i] = (bf16)f2bf(v); }
        for (int m = gw; m < MEM_LEN; m += NGW) rms_row_to_bf16(KA->in[I_MEM] + (size_t)m * D, KA->in[I_MEM_NORM], memn + (size_t)m * D, lane);
        for (int i = gw * 64 + lane; i < 256 * D / 8; i += NGW * 64) ((u32x4*)(hb + (size_t)M * D))[i] = (u32x4){0u, 0u, 0u, 0u};
        for (int m = gw; m < M; m += NGW) rms_row_to_bf16(xin + (size_t)m * D, KA->in[I_NORM_MIX], hb + (size_t)m * D, lane);
    }
    SEAM(0);
    if (EN(20) && IN(1)) { PH_PTRS;
        pg8::Gemm g{memn, wt_mk, D, D, D, 0}; pg8::GridOrder S; S.init(1, 8, G, bx);
        pg8::EpiBf16<0> E{kvmem, 2048}; pg8::gemm_phase<pg8::EpiBf16<0>, pg8::GridOrder, false>(lds, g, S, E, tid);
    }
    SEAM(1);

    for (int l = 0; l < DEPTH; ++l) {
        const int pb = 2 + l * NPH_LAYER;
        if (EN(0) && IN(pb + 0)) { PH_PTRS;
            { pg8::Gemm g{hb, wt_in + (size_t)l * INC * D, D, D, D, M}; pg8::GridOrder S; S.init(M / 256, ZC / 256, G, bx);
              pg8::EpiBf16<0> E{zb, ZC}; pg8::gemm_phase<pg8::EpiBf16<0>, pg8::GridOrder, false>(lds, g, S, E, tid); }
        }
        SEAM(pb + 0);
#define LRU_P lru::LruP LP{zb, KA->in[I_CONV_W] + l * 2048, KA->in[I_CONV_B] + l * 512, KA->in[I_LRU_WA] + (size_t)l * 32768, KA->in[I_LRU_BA] + l * 512, \
                     KA->in[I_LRU_WX] + (size_t)l * 32768, KA->in[I_LRU_BX] + l * 512, KA->in[I_LRU_LAMBDA] + l * 512, carA, carH, carI, yb}
        if (EN(1) && IN(pb + 1)) { PH_PTRS; LRU_P;
#ifndef NO_LRU
            for (int u = gw; u < 2048; u += NGW) lru::unit<false>((LAS char*)lds + wid * 16384, LP, u >> 3, u & 7, lane);
#endif
#ifndef NO_RET
            for (int u = gw; u < 2048; u += NGW) ret::kv_unit((LAS char*)lds + wid * 16384, zb, kvT, u >> 3, u & 7, lane);
#endif
        }
        SEAM(pb + 1);
        if (EN(2) && IN(pb + 2)) { PH_PTRS;
            const int gt = vcu * NTHREADS + tid;
            if (gt < 32768) {
                const int hh = gt >> 12; const float gch = exp2f(64.0f * ret::gamma_log2(hh)); float S = 0.f;
#pragma unroll 8
                for (int c = 0; c < NCHUNK; ++c) { const float kv = kvT[(size_t)c * 32768 + gt]; rT[(size_t)c * 32768 + gt] = (bf16)f2bf(S); S = fmaf(gch, S, kv); }
            } else if (gt < 32768 + 512) {
                const int ch = gt - 32768; float hc = 0.f;
#pragma unroll 8
                for (int s = 0; s < 256; ++s) { carI[s * 512 + ch] = hc; hc = fmaf(carA[s * 512 + ch], hc, carH[s * 512 + ch]); }
            }
        }
        SEAM(pb + 2);
        if (EN(3) && IN(pb + 3)) { PH_PTRS; LRU_P;
#ifndef NO_LRU
            for (int u = gw; u < 2048; u += NGW) lru::unit<true>((LAS char*)lds + wid * 16384, LP, u >> 3, u & 7, lane);
#endif
#ifndef NO_RET
            for (int u = gw; u < 2048; u += NGW) ret::out_unit((LAS char*)lds + wid * 16384, zb, rT, yb, u >> 3, u & 7, lane);
#endif
        }
        SEAM(pb + 3);
        if (EN(4) && IN(pb + 4)) { PH_PTRS;
            LAS float* tab = (LAS float*)(lds + 65536);
            for (int u = vcu; u < 512; u += G) { const int head = u & 7, qblk = u >> 3;
                if (tid < 257) tab[tid] = KA->in[I_CA_REL][(size_t)(l * 8 + head) * 257 + tid] * LOG2E;
                __syncthreads();
                att::AttnP P{zb + Z_BQ + head * 64, zb + Z_BK + head * 64, zb + Z_BV + head * 64, yb + 512 + head * 64, ZC, ZC, ZC, YC,
                             qblk * 256, (4 * qblk - 8 < 0 ? 0 : 4 * qblk - 8), 4 * qblk + 4, 0.125f * LOG2E, 0.f, tab};
                att::attn_unit<64, 64, 1>((LAS char*)lds, P, tid);
                __syncthreads(); }
        }
        SEAM(pb + 4);
        if (EN(5) && IN(pb + 5)) { PH_PTRS;
            for (int u = vcu; u < 256; u += G) { const int hm = u & 7, pi = u >> 3; const int head = hm >> 1, mp = hm & 1;
                const float slope = exp2f(-8.0f * (float)(head + 1) / 4.0f) * LOG2E;
                for (int half = 0; half < 2; ++half) { const int qblk = half ? 63 - pi : pi;
                    att::AttnP P{zb + Z_DQ + head * 128 + mp * 64, zb + Z_DK + head * 128 + mp * 64, zb + Z_DV + head * 128, odb + hm * 128, ZC, ZC, ZC, 1024,
                                 qblk * 256, 0, 4 * qblk + 4, 0.125f * LOG2E, slope, nullptr};
                    att::attn_unit<64, 128, 2>((LAS char*)lds, P, tid); } }
        }
        SEAM(pb + 5);
        if (EN(6) && IN(pb + 6)) { PH_PTRS; const float lam_init = 0.8f - 0.6f * expf(-0.3f * (float)l);
            const float* dl = KA->in[I_DIFF_LAMBDA] + l * 256;
            const float lam = expf(wave_sum(dl[lane] * dl[64 + lane])) - expf(wave_sum(dl[128 + lane] * dl[192 + lane])) + lam_init;
            const int head = lane >> 4, sub = lane & 15; const float* sg = KA->in[I_DIFF_SUBLN] + l * 128 + sub * 8;
            float gsc[8];
#pragma unroll
            for (int j = 0; j < 8; ++j) gsc[j] = sg[j] * (1.0f - lam_init);
            for (int m = gw; m < M; m += NGW) {
                const u32x4 a = *(const u32x4*)(odb + (size_t)m * 1024 + (head * 2) * 128 + sub * 8), b = *(const u32x4*)(odb + (size_t)m * 1024 + (head * 2 + 1) * 128 + sub * 8);
                float o[8]; o[0] = bflo(a.x) - lam * bflo(b.x); o[1] = bfhi(a.x) - lam * bfhi(b.x); o[2] = bflo(a.y) - lam * bflo(b.y); o[3] = bfhi(a.y) - lam * bfhi(b.y);
                o[4] = bflo(a.z) - lam * bflo(b.z); o[5] = bfhi(a.z) - lam * bfhi(b.z); o[6] = bflo(a.w) - lam * bflo(b.w); o[7] = bfhi(a.w) - lam * bfhi(b.w);
                float ss = 0.f;
#pragma unroll
                for (int j = 0; j < 8; ++j) ss += o[j] * o[j];
                ss += __shfl_xor(ss, 1); ss += __shfl_xor(ss, 2); ss += __shfl_xor(ss, 4); ss += __shfl_xor(ss, 8);
                const float rs = 1.0f / sqrtf(ss * (1.f / 128.f) + GN_EPS);
                u32x4 w; w.x = cvt_pk_bf16(o[0] * rs * gsc[0], o[1] * rs * gsc[1]); w.y = cvt_pk_bf16(o[2] * rs * gsc[2], o[3] * rs * gsc[3]);
                w.z = cvt_pk_bf16(o[4] * rs * gsc[4], o[5] * rs * gsc[5]); w.w = cvt_pk_bf16(o[6] * rs * gsc[6], o[7] * rs * gsc[7]);
                *(u32x4*)(yb + (size_t)m * YC + 1536 + head * 128 + sub * 8) = w;
            }
            if (l == 1) convert_experts(KA->in[I_W1] + (size_t)NEXP * D * DEXP, KA->in[I_W3] + (size_t)NEXP * D * DEXP, KA->in[I_W2] + (size_t)NEXP * DEXP * D, w13, w2t, (LAS float*)(lds + wid * 16384), gw, NGW, lane);
        }
        SEAM(pb + 6);
        if (EN(7) && IN(pb + 7)) { PH_PTRS;
            pg8::Gemm g{hb, wt_in + (size_t)l * INC * D + (size_t)ZC * D, D, D, D, M}; pg8::GridOrder S; S.init(M / 256, 4096 / 256, G, bx);
            pg8::EpiBf16<1> E{gtb, 4096}; pg8::gemm_phase<pg8::EpiBf16<1>, pg8::GridOrder, false>(lds, g, S, E, tid);
        }
        SEAM(pb + 7);
        if (EN(8) && IN(pb + 8)) { PH_PTRS;
            pg8::Gemm g{yb, wt_br + (size_t)l * 4 * D * 512, YC, 512, 512, M}; pg8::BranchOrder S{G, bx};
            pg8::EpiGateAcc E{gtb, mrg}; pg8::gemm_phase<pg8::EpiGateAcc, pg8::BranchOrder, false>(lds, g, S, E, tid);
        }
        SEAM(pb + 8);
        if (EN(9) && IN(pb + 9)) { PH_PTRS;
            pg8::Gemm g{mrg, wt_out + (size_t)l * D * D, D, D, D, M}; pg8::GridOrder S; S.init(M / 256, D / 256, G, bx);
            pg8::EpiResF32 E{l == 0 ? xin : (const float*)xout, xout, D}; pg8::gemm_phase<pg8::EpiResF32, pg8::GridOrder, false>(lds, g, S, E, tid);
        }
        SEAM(pb + 9);
        if (EN(10) && IN(pb + 10)) { PH_PTRS; for (int m = gw; m < M; m += NGW) rms_row_to_bf16(xout + (size_t)m * D, KA->in[I_NORM_MEM] + l * D, hb + (size_t)m * D, lane); }
        SEAM(pb + 10);
        if (EN(11) && IN(pb + 11)) { PH_PTRS;
            pg8::Gemm g{hb, wt_mq + (size_t)l * 512 * D, D, D, D, M}; pg8::GridOrder S; S.init(M / 256, 2, G, bx);
            pg8::EpiBf16<0> E{qb, 512}; pg8::gemm_phase<pg8::EpiBf16<0>, pg8::GridOrder, false>(lds, g, S, E, tid);
        }
        SEAM(pb + 11);
        if (EN(12) && IN(pb + 12)) { PH_PTRS;
            for (int u = vcu; u < 256; u += G) { const int head = u & 3, qblk = u >> 2;
                att::AttnP P{qb + head * 128, kvmem + l * 512 + head * 128, kvmem + 1024 + l * 512 + head * 128, obf + head * 128, 512, 2048, 2048, 512,
                             qblk * 256, 0, 4, 0.08838834764831845f * LOG2E, 0.f, nullptr};
                att::attn_unit<128, 128, 0>((LAS char*)lds, P, tid); }
        }
        SEAM(pb + 12);
        if (EN(13) && IN(pb + 13)) { PH_PTRS;
            pg8::Gemm g{obf, wt_mo + (size_t)l * D * 512, 512, 512, 512, M}; pg8::GridOrder S; S.init(M / 256, D / 256, G, bx);
            pg8::EpiResF32 E{xout, xout, D}; pg8::gemm_phase<pg8::EpiResF32, pg8::GridOrder, false>(lds, g, S, E, tid);
        }
        SEAM(pb + 13);
        if (EN(14) && IN(pb + 14)) { PH_PTRS; for (int m = gw; m < M; m += NGW) rms_row_to_bf16(xout + (size_t)m * D, KA->in[I_NORM_FFN] + l * D, hb + (size_t)m * D, lane); }
        SEAM(pb + 14);
        if (EN(15) && IN(pb + 15)) { PH_PTRS; unsigned* ecnt = ctl + CW_ECNT + l * 32 * 64;
            LAS float* lg = (LAS float*)(lds + wid * 16384);
            const int r32 = lane & 31, hi = lane >> 5; const bf16* wl_ = wtr + (size_t)l * 64 * D;
            for (int u = gw; u < M / 32; u += NGW) { const int t0 = u * 32;
                f32x16 a0 = (f32x16){}, a1 = (f32x16){};
#pragma unroll 4
                for (int s = 0; s < 64; ++s) { const bf16x8 bf_ = *(const bf16x8*)(hb + (size_t)(t0 + r32) * D + 16 * s + 8 * hi);
                    a0 = __builtin_amdgcn_mfma_f32_32x32x16_bf16(*(const bf16x8*)(wl_ + (size_t)r32 * D + 16 * s + 8 * hi), bf_, a0, 0, 0, 0);
                    a1 = __builtin_amdgcn_mfma_f32_32x32x16_bf16(*(const bf16x8*)(wl_ + (size_t)(32 + r32) * D + 16 * s + 8 * hi), bf_, a1, 0, 0, 0); }
#pragma unroll
                for (int r = 0; r < 16; ++r) { lg[r32 * 65 + att::crow(r, hi)] = a0[r]; lg[r32 * 65 + 32 + att::crow(r, hi)] = a1[r]; }
                LDS_WAIT();
                const LAS float* tl = lg + r32 * 65; const float* bg = KA->in[I_B_GROUP] + l * 4; const float* br = KA->in[I_B_ROUTER] + l * 32;
                float gl[4];
#pragma unroll
                for (int j = 0; j < 4; ++j) gl[j] = tl[j] + bg[j];
                int gs = 0; float gmx = gl[0];
#pragma unroll
                for (int j = 1; j < 4; ++j) if (gl[j] > gmx) { gmx = gl[j]; gs = j; }
                float gsum = 0.f;
#pragma unroll
                for (int j = 0; j < 4; ++j) gsum += __expf(gl[j] - gmx);
                const float gprob = 1.0f / gsum;
                float el[8];
#pragma unroll
                for (int j = 0; j < 8; ++j) el[j] = tl[4 + 8 * gs + j] + br[8 * gs + j];
                int i0 = 0; float m0 = el[0];
#pragma unroll
                for (int j = 1; j < 8; ++j) if (el[j] > m0) { m0 = el[j]; i0 = j; }
                int i1 = -1; float m1 = -3.0e38f;
#pragma unroll
                for (int j = 0; j < 8; ++j) if (j != i0 && el[j] > m1) { m1 = el[j]; i1 = j; }
                const float e1 = __expf(m1 - m0); const float w0 = gprob / (1.0f + e1), w1 = gprob * e1 / (1.0f + e1);
                const int myk = hi; const int e = 8 * gs + (myk ? i1 : i0); const float w = myk ? w1 : w0;
                unsigned long long rem = ~0ull; int leader = 0, rank = 0, cnt = 0;
                while (rem) { const int ld_ = __builtin_ctzll(rem); const int ee = __shfl(e, ld_); const unsigned long long mk = __ballot(e == ee);
                    if (e == ee) { leader = ld_; rank = __builtin_popcountll(mk & ((1ull << lane) - 1ull)); cnt = __builtin_popcountll(mk); } rem &= ~mk; }
                unsigned base = 0u; if (lane == leader) base = __hip_atomic_fetch_add(ecnt + 64 * e, (unsigned)cnt, __ATOMIC_RELAXED, __HIP_MEMORY_SCOPE_AGENT);
                base = __shfl(base, leader); const int pos = (int)base + rank; const int tok = t0 + r32;
                elist[e * 16384 + pos] = tok; tokE[tok * 2 + myk] = e; tokP[tok * 2 + myk] = pos; tokW[tok * 2 + myk] = w;
                LDS_WAIT();
            }
        }
        SEAM(pb + 15);
        LAS int* mtab = (LAS int*)(lds + LDS_MISC + 1024);
        if ((EN(16) || EN(17)) && (IN(pb + 16) || IN(pb + 17))) { PH_PTRS; unsigned* ecnt = ctl + CW_ECNT + l * 32 * 64;
            if (tid == 0) { int nrt = 0; for (int e = 0; e < NEXP; ++e) { const int c = (int)__hip_atomic_load(ecnt + 64 * e, __ATOMIC_RELAXED, __HIP_MEMORY_SCOPE_AGENT); const int nt_ = (c + 255) >> 8;
                    for (int r = 0; r < nt_; ++r) { mtab[16 + 4 * nrt] = e; mtab[16 + 4 * nrt + 1] = r; mtab[16 + 4 * nrt + 2] = nrt; ++nrt; } }
                mtab[0] = nrt; }
            __syncthreads();
        }
        if (EN(16) && IN(pb + 16)) { PH_PTRS; unsigned* ecnt = ctl + CW_ECNT + l * 32 * 64;
            pg8::Gemm g{hb, w13, D, D, D, M}; pg8::MoeOrder S{mtab, G, bx, 4, 1024, elist, ecnt};
            pg8::EpiSwiGlu E{hid}; pg8::gemm_phase<pg8::EpiSwiGlu, pg8::MoeOrder, true>(lds, g, S, E, tid);
        }
        SEAM(pb + 16);
        if (EN(17) && IN(pb + 17)) { PH_PTRS; unsigned* ecnt = ctl + CW_ECNT + l * 32 * 64;
            pg8::Gemm g{hid, w2t, DEXP, DEXP, DEXP, M}; pg8::MoeOrder S{mtab, G, bx, 4, 1024, elist, ecnt};
            pg8::EpiBf16<0> E{ymoe, D}; pg8::gemm_phase<pg8::EpiBf16<0>, pg8::MoeOrder, false>(lds, g, S, E, tid);
        }
        SEAM(pb + 17);
        if (EN(18) && IN(pb + 18)) { PH_PTRS; unsigned* ecnt = ctl + CW_ECNT + l * 32 * 64;
            int sb = 0; { const int c = lane < NEXP ? (int)__hip_atomic_load(ecnt + 64 * (lane & 31), __ATOMIC_RELAXED, __HIP_MEMORY_SCOPE_AGENT) : 0; const int nt_ = (c + 255) >> 8; int inc = nt_;
#pragma unroll
                for (int o = 1; o < 32; o <<= 1) { const int v = __shfl_up(inc, o); if ((lane & 31) >= o) inc += v; }
                sb = (inc - nt_) * 256; }
            const float* gn = (l + 1 < DEPTH) ? KA->in[I_NORM_MIX] + (l + 1) * D : KA->in[I_FINAL_NORM];
            for (int m = gw; m < M; m += NGW) {
                const int e0 = tokE[m * 2], e1 = tokE[m * 2 + 1]; const float w0 = tokW[m * 2], w1 = tokW[m * 2 + 1];
                const size_t s0 = (size_t)(__shfl(sb, e0) + tokP[m * 2]), s1 = (size_t)(__shfl(sb, e1) + tokP[m * 2 + 1]);
                f32x4 v[4]; float ss = 0.f;
#pragma unroll
                for (int j = 0; j < 4; ++j) { v[j] = ((const f32x4*)(xout + (size_t)m * D))[lane + 64 * j];
                    const u32x2 a = ((const u32x2*)(ymoe + s0 * D))[lane + 64 * j], b = ((const u32x2*)(ymoe + s1 * D))[lane + 64 * j];
                    v[j].x += w0 * bflo(a.x) + w1 * bflo(b.x); v[j].y += w0 * bfhi(a.x) + w1 * bfhi(b.x); v[j].z += w0 * bflo(a.y) + w1 * bflo(b.y); v[j].w += w0 * bfhi(a.y) + w1 * bfhi(b.y);
                    ss += (v[j].x * v[j].x + v[j].y * v[j].y) + (v[j].z * v[j].z + v[j].w * v[j].w); }
                const float rstd = 1.f / sqrtf(wave_sum(ss) * (1.f / D) + NORM_EPS);
                if (l + 1 < DEPTH) {
#pragma unroll
                    for (int j = 0; j < 4; ++j) { ((f32x4*)(xout + (size_t)m * D))[lane + 64 * j] = v[j]; const f32x4 gg = ((const f32x4*)gn)[lane + 64 * j];
                        u32x2 w; w.x = pk2(v[j].x * rstd * gg.x, v[j].y * rstd * gg.y); w.y = pk2(v[j].z * rstd * gg.z, v[j].w * rstd * gg.w);
                        ((u32x2*)(hb + (size_t)m * D))[lane + 64 * j] = w; }
                } else {
#pragma unroll
                    for (int j = 0; j < 4; ++j) { const f32x4 gg = ((const f32x4*)gn)[lane + 64 * j];
                        ((f32x4*)(xout + (size_t)m * D))[lane + 64 * j] = (f32x4){v[j].x * rstd * gg.x, v[j].y * rstd * gg.y, v[j].z * rstd * gg.z, v[j].w * rstd * gg.w}; }
                }
            }
        }
        SEAM(pb + 18);
    }
#undef IN
#undef SEAM
}

extern "C" void kernel_launch(void* const* d_in, const int* in_sizes, int n_in, void* d_out, int out_size, void* d_ws, size_t ws_size, hipStream_t stream) {
    static int grid = 0;
    if (grid == 0) {
        if (n_in != 31 || in_sizes[0] != M * D || out_size != M * D || ws_size < WS_END) { fprintf(stderr, "kernel_launch: unexpected problem (n_in %d, in0 %d, out %d, ws %zu < %zu)\n", n_in, n_in > 0 ? in_sizes[0] : -1, out_size, ws_size, (size_t)WS_END); grid = -1; return; }
        int dev = 0, cus = 0, per_cu = 0;
        if (hipGetDevice(&dev) != hipSuccess || hipDeviceGetAttribute(&cus, hipDeviceAttributeMultiprocessorCount, dev) != hipSuccess) { grid = -1; return; }
        if (hipFuncSetAttribute((const void*)fwd_kernel, hipFuncAttributeMaxDynamicSharedMemorySize, LDS_BYTES) != hipSuccess) { fprintf(stderr, "kernel_launch: hipFuncSetAttribute failed\n"); grid = -1; return; }
        if (hipOccupancyMaxActiveBlocksPerMultiprocessor(&per_cu, (const void*)fwd_kernel, NTHREADS, LDS_BYTES) != hipSuccess || per_cu < 1) { fprintf(stderr, "kernel_launch: occupancy query says %d\n", per_cu); }
        (void)hipGetLastError();
        grid = cus;
    }
    if (grid < 0) return;
    if (hipMemsetAsync((char*)d_ws + WS_CTL, 0, CTL_ZERO_BYTES, stream) != hipSuccess) return;
    Args a{};
    for (int i = 0; i < 31; ++i) a.in[i] = (const float*)d_in[i];
    a.out = (float*)d_out; a.ws = (unsigned char*)d_ws;
#if MK_N_LAUNCHES == 1
    a.ph_lo = 0; a.ph_hi = NPHASE;
    hipLaunchKernelGGL(fwd_kernel, dim3(grid), dim3(NTHREADS), LDS_BYTES, stream, a);
#else
    for (int p = 0; p < NPHASE; ++p) { a.ph_lo = p; a.ph_hi = p + 1; hipLaunchKernelGGL(fwd_kernel, dim3(grid), dim3(NTHREADS), LDS_BYTES, stream, a); }
#endif
}
```

```cpp
#include <hip/hip_runtime.h>
#include <cstdio>
#include <cstdint>
#include <cmath>

#ifndef MK_N_LAUNCHES
#define MK_N_LAUNCHES 1
#endif

#define LAS __attribute__((address_space(3)))
#define GAS __attribute__((address_space(1)))
typedef unsigned short bf16;
typedef short bf16x8 __attribute__((ext_vector_type(8)));
typedef short s16x4 __attribute__((ext_vector_type(4)));
typedef float f32x4 __attribute__((ext_vector_type(4)));
typedef float f32x2 __attribute__((ext_vector_type(2)));
typedef float f32x16 __attribute__((ext_vector_type(16)));
typedef unsigned u32x4 __attribute__((ext_vector_type(4)));
typedef unsigned u32x2 __attribute__((ext_vector_type(2)));

constexpr int M = 16384, D = 1024, DEPTH = 2, CHUNK = 64, NCHUNK = M / CHUNK, MEM_LEN = 256;
constexpr int ZC = 6144, INC = 10240, YC = 2048;
constexpr int Z_AX = 0, Z_AG = 512, Z_BQ = 1024, Z_BK = 1536, Z_BV = 2048, Z_CQ = 2560, Z_CK = 3072, Z_CV = 3584, Z_CG = 4096, Z_DQ = 4608, Z_DK = 5120, Z_DV = 5632;
constexpr int NEXP = 32, DEXP = 512;
constexpr int HROWS = M + 256;
constexpr int MAXSLOT = 41216;
constexpr float NORM_EPS = 1e-6f, GN_EPS = 1e-5f;
constexpr float LOG2E = 1.4426950408889634f;

constexpr size_t MiB = 1u << 20;
constexpr size_t WS_CTL = 0, CTL_ZERO_BYTES = 1 * MiB;
constexpr size_t WS_MEMN = 1 * MiB;
constexpr size_t WS_KMEM = 2 * MiB;
constexpr size_t WS_VMEM = 2 * MiB + 512 * 1024;
constexpr size_t WS_WTR = 3 * MiB;
constexpr size_t WS_CARA = 4 * MiB;
constexpr size_t WS_CARH = 4 * MiB + 512 * 1024;
constexpr size_t WS_CARI = 5 * MiB;
constexpr size_t WS_TOKE = 6 * MiB;
constexpr size_t WS_TOKP = 6 * MiB + 128 * 1024;
constexpr size_t WS_TOKW = 6 * MiB + 256 * 1024;
constexpr size_t WS_ELIST = 8 * MiB;
constexpr size_t WS_WIN = 10 * MiB;
constexpr size_t WS_WBR = 50 * MiB;
constexpr size_t WS_WOUT = 58 * MiB;
constexpr size_t WS_WMQ = 62 * MiB;
constexpr size_t WS_WMK = 64 * MiB;
constexpr size_t WS_WMV = 66 * MiB;
constexpr size_t WS_WMO = 68 * MiB;
constexpr size_t WS_W13 = 70 * MiB;
constexpr size_t WS_W2 = 134 * MiB;
constexpr size_t WS_H = 166 * MiB;
constexpr size_t WS_Y = 200 * MiB;
constexpr size_t WS_KVT = 264 * MiB;
constexpr size_t WS_RT = 296 * MiB;
constexpr size_t WS_OD = 312 * MiB;
constexpr size_t WS_Z = 344 * MiB;
constexpr size_t WS_G = 344 * MiB;
constexpr size_t WS_MRG = 472 * MiB;
constexpr size_t WS_QB = 504 * MiB;
constexpr size_t WS_OB = 520 * MiB;
constexpr size_t WS_HID = 344 * MiB;
constexpr size_t WS_YMOE = 386 * MiB;
constexpr size_t WS_END = 536 * MiB;
static_assert(WS_HID + (size_t)MAXSLOT * 512 * 2 <= WS_YMOE && WS_YMOE + (size_t)MAXSLOT * 1024 * 2 <= WS_MRG, "moe overlay");
constexpr int CW_TMO = 0, CW_CODE = 1;
constexpr int CW_BAR = 4096;
constexpr int CW_ECNT = 16384;

constexpr int LDS_BYTES = 147456;
constexpr int LDS_MISC = 131072;
constexpr int NWAVES = 8, NTHREADS = 512;

__device__ __forceinline__ unsigned f2bf(float f) { unsigned u = __builtin_bit_cast(unsigned, f); return (u + 0x7fffu + ((u >> 16) & 1u)) >> 16; }
__device__ __forceinline__ unsigned pk2(float lo, float hi) { return f2bf(lo) | (f2bf(hi) << 16); }
__device__ __forceinline__ float bf2f(unsigned short b) { return __builtin_bit_cast(float, ((unsigned)b) << 16); }
__device__ __forceinline__ float bflo(unsigned w) { return __builtin_bit_cast(float, w << 16); }
__device__ __forceinline__ float bfhi(unsigned w) { return __builtin_bit_cast(float, w & 0xffff0000u); }
typedef __bf16 bf16x2_t __attribute__((ext_vector_type(2)));
__device__ __forceinline__ unsigned cvt_pk_bf16(float lo, float hi) { const f32x2 v = {lo, hi}; const bf16x2_t b = __builtin_convertvector(v, bf16x2_t); return __builtin_bit_cast(unsigned, b); }
__device__ __forceinline__ float fexp2(float x) { return __builtin_amdgcn_exp2f(x); }
__device__ __forceinline__ float frcp(float x) { return __builtin_amdgcn_rcpf(x); }
__device__ __forceinline__ float sigmoidf_(float x) { return frcp(1.0f + fexp2(-x * LOG2E)); }
__device__ __forceinline__ float wave_sum(float v) {
#pragma unroll
    for (int o = 1; o < 64; o <<= 1) v += __shfl_xor(v, o);
    return v;
}
#define LDS_WAIT() asm volatile("s_waitcnt lgkmcnt(0)" ::: "memory")
#define VM_WAIT() asm volatile("s_waitcnt vmcnt(0)" ::: "memory")

namespace pg8 {
constexpr int BM = 256, BK = 64, HALF = 128, HTB = HALF * BK * 2, STAGE_BYTES = 8 * HTB, NXCD = 8, WGM = 8;
__host__ __device__ __forceinline__ int lds_byte(int r, int c) { const int st = (r >> 4) * 2 + (c >> 5), rr = r & 15, cc = c & 31, ob = rr * 64 + cc * 2; return st * 1024 + (ob ^ (((ob >> 9) & 1) << 5)); }
__host__ __device__ __forceinline__ void stage_rc(int b, int& R, int& C) { const int st = b / 1024, sb = b % 1024, swz = sb ^ (((sb >> 9) & 1) << 5); R = (st >> 1) * 16 + swz / 64; C = (st & 1) * 32 + (swz % 64) / 2; }
__host__ __device__ __forceinline__ int perm32(int rho) { const int n = rho >> 4, i = rho & 15; return 8 * (i >> 2) + 4 * n + (i & 3); }

struct Unit { int arow, acol, brow, pm, pn, aux, gcnt; const int* gl; };
struct Gemm { const bf16* A; const bf16* Bt; int lda, ldb, K, zrow; };

template <class Epi, class Sched, bool GATHER>
__device__ __forceinline__ void gemm_phase(LAS unsigned char* lds, const Gemm g, const Sched& S, const Epi& E, const int tid) {
    const int wid = __builtin_amdgcn_readfirstlane(tid >> 6), lane = tid & 63, wr = wid >> 2, wc = wid & 3, fr = lane & 15, fq = lane >> 4;
    const int K = g.K, nt = K / BK;
    unsigned voffA[2][2], voffB[2];
#pragma unroll
    for (int i = 0; i < 2; ++i) { int R, C; stage_rc(tid * 16 + i * 8192, R, C); const int Rb = Epi::PERM ? ((R & ~31) + perm32(R & 31)) : R;
        voffA[0][i] = (unsigned)(R * g.lda + C) * 2u; voffA[1][i] = voffA[0][i]; voffB[i] = (unsigned)(Rb * g.ldb + C) * 2u; }
    const size_t kstep = (size_t)(BK * 2);
    const size_t hstepA = GATHER ? (size_t)0 : (size_t)HALF * g.lda * 2;
    const size_t hstepB = (size_t)HALF * g.ldb * 2;
    const unsigned ldsw = (unsigned)wid * 1024u;
    const int aoff = lds_byte(wr * 64 + fr, fq * 8), boff = lds_byte(wc * 32 + fr, fq * 8);
#define PG8_SA(b, h) (((b) * 2 + (h)) * HTB)
#define PG8_SB(b, h) ((4 + (b) * 2 + (h)) * HTB)
#define PG8_STAGE(bufoff, gbase, voff) do { _Pragma("unroll") for (int _i = 0; _i < 2; ++_i) \
        __builtin_amdgcn_global_load_lds((const unsigned*)((const char*)(gbase) + (voff)[_i]), (LAS unsigned*)(lds + (bufoff) + ldsw + _i * 8192), 16, 0, 0); } while (0)
#define PG8_LDA(dst, b, h) do { _Pragma("unroll") for (int m = 0; m < 4; ++m) _Pragma("unroll") for (int k = 0; k < 2; ++k) dst[m][k] = *(const LAS bf16x8*)(lds + PG8_SA(b, h) + aoff + m * 2048 + k * 1024); } while (0)
#define PG8_LDB(dst, b, h) do { _Pragma("unroll") for (int n = 0; n < 2; ++n) _Pragma("unroll") for (int k = 0; k < 2; ++k) dst[n][k] = *(const LAS bf16x8*)(lds + PG8_SB(b, h) + boff + n * 2048 + k * 1024); } while (0)
#define PG8_MMA(ai, bj, At, Bt) do { __builtin_amdgcn_s_setprio(1); _Pragma("unroll") for (int m = 0; m < 4; ++m) _Pragma("unroll") for (int n = 0; n < 2; ++n) _Pragma("unroll") for (int k = 0; k < 2; ++k) \
        acc[ai][bj][m][n] = __builtin_amdgcn_mfma_f32_16x16x32_bf16(Bt[n][k], At[m][k], acc[ai][bj][m][n], 0, 0, 0); __builtin_amdgcn_s_setprio(0); } while (0)
#define PG8_WAIT_V(n) asm volatile("s_waitcnt vmcnt(" #n ")" ::: "memory")
#define PG8_WAIT_L(n) asm volatile("s_waitcnt lgkmcnt(" #n ")" ::: "memory")
#define PG8_BAR __builtin_amdgcn_s_barrier()
#define PG8_SCHED __builtin_amdgcn_sched_barrier(0)
#define PG8_SETA(u) do { if constexpr (GATHER) { _Pragma("unroll") for (int _h = 0; _h < 2; ++_h) _Pragma("unroll") for (int _i = 0; _i < 2; ++_i) { \
        int _R, _C; stage_rc(tid * 16 + _i * 8192, _R, _C); const int _r = _h * HALF + _R; const int _row = (_r < (u).gcnt) ? (u).gl[_r] : g.zrow; \
        voffA[_h][_i] = ((unsigned)_row * (unsigned)g.lda + (unsigned)_C) * 2u; } } } while (0)
#define PG8_ABASE(u) (GATHER ? (const char*)g.A : (const char*)g.A + ((size_t)(u).arow * g.lda + (u).acol) * 2)
    Unit cur, nxt; int ui = 0;
    if (!S.next(0, cur)) return;
    f32x4 acc[2][2][4][2];
#pragma unroll
    for (int a = 0; a < 2; ++a)
#pragma unroll
        for (int b = 0; b < 2; ++b)
#pragma unroll
            for (int m = 0; m < 4; ++m)
#pragma unroll
                for (int n = 0; n < 2; ++n) acc[a][b][m][n] = (f32x4){0.f, 0.f, 0.f, 0.f};
    bf16x8 At[4][2], B0[2][2], B1[2][2];
    PG8_SETA(cur);
    const char* cA = PG8_ABASE(cur);
    const char* cB = (const char*)g.Bt + (size_t)cur.brow * g.ldb * 2;
    PG8_STAGE(PG8_SB(0, 0), cB, voffB); PG8_STAGE(PG8_SB(0, 1), cB + hstepB, voffB); PG8_STAGE(PG8_SA(0, 0), cA, voffA[0]); PG8_STAGE(PG8_SA(0, 1), cA + hstepA, voffA[1]);
    if (wr == 1) PG8_BAR;
    PG8_WAIT_V(2); PG8_BAR;
    PG8_STAGE(PG8_SB(1, 0), cB + kstep, voffB); PG8_STAGE(PG8_SA(1, 0), cA + kstep, voffA[0]); PG8_STAGE(PG8_SB(1, 1), cB + hstepB + kstep, voffB);
    PG8_WAIT_V(6); PG8_BAR;
    for (;;) {
        const bool has_next = S.next(ui + 1, nxt);
        const char* nA = has_next ? PG8_ABASE(nxt) : cA; const char* nB = has_next ? (const char*)g.Bt + (size_t)nxt.brow * g.ldb * 2 : cB;
        for (int t = 0; t < nt; t += 2) {
            const bool last = (t == nt - 2);
            const char* a1 = cA + (size_t)(t + 1) * kstep;
            const char* a2 = last ? nA : cA + (size_t)(t + 2) * kstep; const char* b2 = last ? nB : cB + (size_t)(t + 2) * kstep;
            const char* a3 = a2 + kstep; const char* b3 = b2 + kstep;
            PG8_LDB(B0, 0, 0); PG8_LDB(B1, 0, 1); PG8_SCHED; PG8_LDA(At, 0, 0); PG8_STAGE(PG8_SA(1, 1), a1 + hstepA, voffA[1]);
            if (last && has_next) { PG8_SETA(nxt); }
            PG8_WAIT_V(8); PG8_WAIT_L(0); PG8_BAR; PG8_MMA(0, 0, At, B0); PG8_MMA(0, 1, At, B1); PG8_BAR; PG8_SCHED;
            PG8_LDA(At, 0, 1); PG8_STAGE(PG8_SB(0, 0), b2, voffB); PG8_STAGE(PG8_SB(0, 1), b2 + hstepB, voffB); PG8_STAGE(PG8_SA(0, 0), a2, voffA[0]);
            PG8_WAIT_V(8); PG8_WAIT_L(0); PG8_BAR; PG8_MMA(1, 0, At, B0); PG8_MMA(1, 1, At, B1); PG8_BAR; PG8_SCHED;
            PG8_LDB(B0, 1, 0); PG8_LDB(B1, 1, 1); PG8_SCHED; PG8_LDA(At, 1, 0); PG8_STAGE(PG8_SA(0, 1), a2 + hstepA, voffA[1]);
            PG8_WAIT_V(8); PG8_WAIT_L(0); PG8_BAR; PG8_MMA(0, 0, At, B0); PG8_MMA(0, 1, At, B1); PG8_BAR; PG8_SCHED;
            PG8_LDA(At, 1, 1); PG8_STAGE(PG8_SB(1, 0), b3, voffB); PG8_STAGE(PG8_SB(1, 1), b3 + hstepB, voffB); PG8_STAGE(PG8_SA(1, 0), a3, voffA[0]);
            PG8_WAIT_V(8); PG8_WAIT_L(0); PG8_BAR; PG8_MMA(1, 0, At, B0); PG8_MMA(1, 1, At, B1); PG8_BAR; PG8_SCHED;
        }
        if (wr == 0) PG8_BAR;
        E(acc, cur, wr, wc, fr, fq);
        if (!has_next) break;
#pragma unroll
        for (int a = 0; a < 2; ++a)
#pragma unroll
            for (int b = 0; b < 2; ++b)
#pragma unroll
                for (int m = 0; m < 4; ++m)
#pragma unroll
                    for (int n = 0; n < 2; ++n) acc[a][b][m][n] = (f32x4){0.f, 0.f, 0.f, 0.f};
        cur = nxt; cA = nA; cB = nB; ++ui;
        if (wr == 1) PG8_BAR;
    }
    PG8_WAIT_V(0);
    PG8_BAR;
#undef PG8_SA
#undef PG8_SB
#undef PG8_STAGE
#undef PG8_LDA
#undef PG8_LDB
#undef PG8_MMA
#undef PG8_WAIT_V
#undef PG8_WAIT_L
#undef PG8_BAR
#undef PG8_SCHED
#undef PG8_SETA
#undef PG8_ABASE
}

struct GridOrder {
    int nM, nN, nwg, G, c, arow0, acol, brow0;
    __device__ void init(int nM_, int nN_, int G_, int c_, int arow0_ = 0, int acol_ = 0, int brow0_ = 0) { nM = nM_; nN = nN_; nwg = nM * nN; G = G_; c = c_; arow0 = arow0_; acol = acol_; brow0 = brow0_; }
    __device__ __forceinline__ bool next(int i, Unit& u) const {
        const long L = (long)i * G + c; if (L >= nwg) return false;
        int wgid = (int)L; { const int q = nwg / NXCD, r = nwg % NXCD, xcd = wgid % NXCD, off = wgid / NXCD; wgid = (xcd < r ? xcd * (q + 1) : r * (q + 1) + (xcd - r) * q) + off; }
        const int nig = WGM * nN, gid = wgid / nig, fm = gid * WGM, gsz = (nM - fm) < WGM ? (nM - fm) : WGM;
        u.pm = fm + ((wgid % nig) % gsz); u.pn = (wgid % nig) / gsz;
        u.arow = arow0 + u.pm * BM; u.acol = acol; u.brow = brow0 + u.pn * BM; u.aux = 0; u.gcnt = 0; u.gl = nullptr; return true;
    }
};
struct BranchOrder {
    int G, c;
    __device__ __forceinline__ bool next(int i, Unit& u) const {
        const int tile = (i >> 2) * G + c, b = i & 3; if (tile >= 256) return false;
        u.pm = tile >> 2; u.pn = tile & 3; u.arow = u.pm * BM; u.acol = b * 512; u.brow = b * 1024 + u.pn * BM; u.aux = b; u.gcnt = 0; u.gl = nullptr; return true;
    }
};
struct MoeOrder {
    const LAS int* tab; int G, c, nct, brows; const int* elist; const unsigned* ecnt;
    __device__ __forceinline__ bool next(int i, Unit& u) const {
        const int L = i * G + c, nrt = tab[0]; if (L >= nrt * nct) return false;
        const int j = L / nct, ct = L % nct; const int e = tab[16 + 4 * j], rt = tab[16 + 4 * j + 1], st = tab[16 + 4 * j + 2];
        u.pm = st; u.pn = ct; u.arow = st * BM; u.acol = 0; u.brow = e * brows + ct * BM; u.aux = e;
        const int cnt = (int)ecnt[64 * e]; u.gcnt = cnt - rt * BM; u.gl = elist + e * 16384 + rt * BM; return true;
    }
};

template <int ACT  > struct EpiBf16 {
    static constexpr bool PERM = true;
    bf16* O; int ldc;
    __device__ __forceinline__ void operator()(const f32x4 (&acc)[2][2][4][2], const Unit& u, int wr, int wc, int fr, int fq) const {
        const int row0 = u.pm * BM + wr * 64 + fr, col0 = u.pn * BM + wc * 32 + 8 * fq;
#pragma unroll
        for (int ai = 0; ai < 2; ++ai)
#pragma unroll
            for (int m = 0; m < 4; ++m) { bf16* rowp = O + (size_t)(row0 + ai * HALF + m * 16) * ldc + col0;
#pragma unroll
                for (int bj = 0; bj < 2; ++bj) { f32x4 v0 = acc[ai][bj][m][0], v1 = acc[ai][bj][m][1];
                    if (ACT == 1) {
#pragma unroll
                        for (int j = 0; j < 4; ++j) { v0[j] = sigmoidf_(v0[j]); v1[j] = sigmoidf_(v1[j]); } }
                    u32x4 w; w.x = cvt_pk_bf16(v0[0], v0[1]); w.y = cvt_pk_bf16(v0[2], v0[3]); w.z = cvt_pk_bf16(v1[0], v1[1]); w.w = cvt_pk_bf16(v1[2], v1[3]);
                    *(u32x4*)(rowp + bj * HALF) = w; } }
    }
};
struct EpiGateAcc {
    static constexpr bool PERM = true;
    const bf16* Gt; bf16* Mg;
    __device__ __forceinline__ void operator()(const f32x4 (&acc)[2][2][4][2], const Unit& u, int wr, int wc, int fr, int fq) const {
        const int row0 = u.pm * BM + wr * 64 + fr, col0 = u.pn * BM + wc * 32 + 8 * fq, b = u.aux;
#pragma unroll
        for (int ai = 0; ai < 2; ++ai)
#pragma unroll
            for (int m = 0; m < 4; ++m) { const size_t r = (size_t)(row0 + ai * HALF + m * 16);
#pragma unroll
                for (int bj = 0; bj < 2; ++bj) {
                    const u32x4 gw = *(const u32x4*)(Gt + r * 4096 + b * 1024 + col0 + bj * HALF);
                    bf16* mp = Mg + r * 1024 + col0 + bj * HALF;
                    u32x4 ow = (u32x4){0u, 0u, 0u, 0u}; if (b != 0) ow = *(const u32x4*)mp;
                    const f32x4 v0 = acc[ai][bj][m][0], v1 = acc[ai][bj][m][1];
                    u32x4 w;
                    w.x = cvt_pk_bf16(bflo(ow.x) + bflo(gw.x) * v0[0], bfhi(ow.x) + bfhi(gw.x) * v0[1]);
                    w.y = cvt_pk_bf16(bflo(ow.y) + bflo(gw.y) * v0[2], bfhi(ow.y) + bfhi(gw.y) * v0[3]);
                    w.z = cvt_pk_bf16(bflo(ow.z) + bflo(gw.z) * v1[0], bfhi(ow.z) + bfhi(gw.z) * v1[1]);
                    w.w = cvt_pk_bf16(bflo(ow.w) + bflo(gw.w) * v1[2], bfhi(ow.w) + bfhi(gw.w) * v1[3]);
                    *(u32x4*)mp = w; }
                asm volatile("" ::: "memory"); }
    }
};
struct EpiResF32 {
    static constexpr bool PERM = false;
    const float* base; float* out; int ldc;
    __device__ __forceinline__ void operator()(const f32x4 (&acc)[2][2][4][2], const Unit& u, int wr, int wc, int fr, int fq) const {
        const int row0 = u.pm * BM + wr * 64 + fr, col0 = u.pn * BM + wc * 32 + 4 * fq;
#pragma unroll
        for (int ai = 0; ai < 2; ++ai)
#pragma unroll
            for (int m = 0; m < 4; ++m) { const size_t off = (size_t)(row0 + ai * HALF + m * 16) * ldc + col0;
#pragma unroll
                for (int bj = 0; bj < 2; ++bj)
#pragma unroll
                    for (int n = 0; n < 2; ++n) { const f32x4 bs = *(const f32x4*)(base + off + bj * HALF + n * 16); *(f32x4*)(out + off + bj * HALF + n * 16) = bs + acc[ai][bj][m][n]; }
                if (m & 1) asm volatile("" ::: "memory"); }
    }
};
struct EpiSwiGlu {
    static constexpr bool PERM = true;
    bf16* Hd;
    __device__ __forceinline__ void operator()(const f32x4 (&acc)[2][2][4][2], const Unit& u, int wr, int wc, int fr, int fq) const {
        const int row0 = u.pm * BM + wr * 64 + fr, col0 = u.pn * HALF + wc * 32 + 8 * fq;
#pragma unroll
        for (int ai = 0; ai < 2; ++ai)
#pragma unroll
            for (int m = 0; m < 4; ++m) { bf16* rowp = Hd + (size_t)(row0 + ai * HALF + m * 16) * DEXP + col0;
                f32x4 o0, o1;
#pragma unroll
                for (int j = 0; j < 4; ++j) { const float a0 = acc[ai][0][m][0][j], a1 = acc[ai][0][m][1][j];
                    o0[j] = a0 * sigmoidf_(a0) * acc[ai][1][m][0][j]; o1[j] = a1 * sigmoidf_(a1) * acc[ai][1][m][1][j]; }
                u32x4 w; w.x = cvt_pk_bf16(o0[0], o0[1]); w.y = cvt_pk_bf16(o0[2], o0[3]); w.z = cvt_pk_bf16(o1[0], o1[1]); w.w = cvt_pk_bf16(o1[2], o1[3]);
                *(u32x4*)rowp = w; }
    }
};
}

#define XB_TMO      128
#define XB_XCNT(j)  (256  + 64 * (j))
#define XB_XSUB(j)  (1280 + 64 * (j))
#define XB_XGEN(j)  (2304 + 64 * (j))
#define XB_TOP      3328
#define XB_TOPGEN   3392
#define XCD_BAR_WORDS 3456
#define XB_SPIN_CAP (1u << 20)
__device__ __forceinline__ unsigned xb_ld(unsigned* p)              { return __hip_atomic_load(p, __ATOMIC_RELAXED, __HIP_MEMORY_SCOPE_AGENT); }
__device__ __forceinline__ unsigned xb_add(unsigned* p, unsigned v) { return __hip_atomic_fetch_add(p, v, __ATOMIC_RELAXED, __HIP_MEMORY_SCOPE_AGENT); }
__device__ __forceinline__ unsigned xb_xcc_id() { return (unsigned)__builtin_amdgcn_s_getreg((3 << 11) | 20) & 0xFu; }
#define XB_SPIN(cond, bar) do { unsigned _sp = 0; while (cond) { __builtin_amdgcn_s_sleep(1); \
    if ((++_sp & 255u) == 0u) { if (xb_ld(&(bar)[XB_TMO])) break; if (_sp > XB_SPIN_CAP) { atomicAdd(&(bar)[XB_TMO], 1u); break; } } } } while (0)
struct XcdBarrier { unsigned* bar; unsigned x; volatile LAS unsigned* st; };
__device__ __forceinline__ XcdBarrier xcd_barrier_post(unsigned* bar, volatile LAS unsigned* st) {
    XcdBarrier b; b.bar = bar; b.x = xb_xcc_id(); b.st = st;
    if (threadIdx.x == 0) (void)xb_add(&bar[XB_XCNT(b.x)], 1u);
    return b;
}
__device__ __forceinline__ void xcd_barrier_complete(unsigned* bar, unsigned x, unsigned& nloc, unsigned& nx) {
    const unsigned G = gridDim.x * gridDim.y * gridDim.z;
    unsigned sum, cnt, mine, sp = 0u;
    for (;;) {
        sum = 0u; cnt = 0u; mine = 0u;
#pragma unroll
        for (unsigned j = 0; j < 16; ++j) { const unsigned c = xb_ld(&bar[XB_XCNT(j)]); sum += c; cnt += (c > 0u) ? 1u : 0u; mine = (j == x) ? c : mine; }
        if (sum == G) break;
        __builtin_amdgcn_s_sleep(1);
        if ((++sp & 255u) == 0u) { if (xb_ld(&bar[XB_TMO])) break; if (sp > XB_SPIN_CAP) { atomicAdd(&bar[XB_TMO], 1u); break; } }
    }
    nloc = mine > 0u ? mine : 1u; nx = cnt > 0u ? cnt : 1u;
}
__device__ __forceinline__ void xcd_barrier(const XcdBarrier& b) {
    asm volatile("s_waitcnt vmcnt(0)" ::: "memory");
    __syncthreads();
    if (threadIdx.x == 0) {
        unsigned* bar = b.bar;
        __builtin_amdgcn_s_waitcnt(0);
        unsigned nloc = b.st[0], nx = b.st[1];
        if (nloc == 0u) { xcd_barrier_complete(bar, b.x, nloc, nx); b.st[0] = nloc; b.st[1] = nx; }
        const unsigned old = xb_add(&bar[XB_XSUB(b.x)], 1u);
        const unsigned gen = old / nloc;
        if (old + 1u == (gen + 1u) * nloc) {
            __builtin_amdgcn_fence(__ATOMIC_RELEASE, "agent");
            asm volatile("s_waitcnt vmcnt(0)" ::: "memory");
            const unsigned og = xb_add(&bar[XB_TOP], 1u);
            const unsigned tg = og / nx;
            if (og + 1u == (tg + 1u) * nx) xb_add(&bar[XB_TOPGEN], 1u);
            else XB_SPIN(xb_ld(&bar[XB_TOPGEN]) == tg, bar);
            __builtin_amdgcn_fence(__ATOMIC_ACQUIRE, "agent");
            xb_add(&bar[XB_XGEN(b.x)], 1u);
            asm volatile("s_waitcnt vmcnt(0)" ::: "memory");
        } else {
            XB_SPIN(xb_ld(&bar[XB_XGEN(b.x)]) == gen, bar);
            __builtin_amdgcn_fence(__ATOMIC_ACQUIRE, "agent");
            asm volatile("s_waitcnt vmcnt(0)" ::: "memory");
        }
    }
    __syncthreads();
}

struct Args {
    const float* in[31]; float* out; unsigned char* ws; int ph_lo, ph_hi;
};
enum InIdx { I_X = 0, I_MEM, I_NORM_MIX, I_W_IN, I_CONV_W, I_CONV_B, I_LRU_WA, I_LRU_BA, I_LRU_WX, I_LRU_BX, I_LRU_LAMBDA, I_CA_REL, I_DIFF_LAMBDA, I_DIFF_SUBLN,
             I_W_BRANCH, I_W_OUT, I_NORM_MEM, I_MEM_NORM, I_W_MQ, I_W_MK, I_W_MV, I_W_MO, I_NORM_FFN, I_W_GROUP, I_B_GROUP, I_W_ROUTER, I_B_ROUTER, I_W1, I_W3, I_W2, I_FINAL_NORM };

__device__ __forceinline__ void transpose_item(const float* W, int K, int N, bf16* WT, int row_off, LAS float* scr, int item, int lane) {
    const int nblk = N / 32, kb = item / nblk, nb = item % nblk, k0 = 64 * kb, n0 = 32 * nb;
#pragma unroll 8
    for (int i = 0; i < 32; ++i) { const int kk = 2 * i + (lane >> 5); scr[kk * 33 + (lane & 31)] = W[(size_t)(k0 + kk) * N + n0 + (lane & 31)]; }
    LDS_WAIT(); asm volatile("" ::: "memory");
    const int c = lane & 7;
#pragma unroll
    for (int j = 0; j < 4; ++j) { const int n = (lane >> 3) + 8 * j; const LAS float* s = scr + (8 * c) * 33 + n;
        u32x4 o; o.x = pk2(s[0 * 33], s[1 * 33]); o.y = pk2(s[2 * 33], s[3 * 33]); o.z = pk2(s[4 * 33], s[5 * 33]); o.w = pk2(s[6 * 33], s[7 * 33]);
        *(u32x4*)(WT + (size_t)(row_off + n0 + n) * K + k0 + 8 * c) = o; }
    LDS_WAIT(); asm volatile("" ::: "memory");
}
__device__ __forceinline__ void rms_row_to_bf16(const float* xrow, const float* g, bf16* orow, int lane) {
    const f32x4* xr = (const f32x4*)xrow + lane; const f32x4* gr = (const f32x4*)g + lane;
    f32x4 v[4]; float s = 0.f;
#pragma unroll
    for (int j = 0; j < 4; ++j) { v[j] = xr[64 * j]; s += (v[j].x * v[j].x + v[j].y * v[j].y) + (v[j].z * v[j].z + v[j].w * v[j].w); }
    const float rstd = 1.f / sqrtf(wave_sum(s) * (1.f / D) + NORM_EPS);
    unsigned long long* o8 = (unsigned long long*)orow + lane;
#pragma unroll
    for (int j = 0; j < 4; ++j) { const f32x4 gg = gr[64 * j];
        o8[64 * j] = (unsigned long long)pk2(v[j].x * rstd * gg.x, v[j].y * rstd * gg.y) | ((unsigned long long)pk2(v[j].z * rstd * gg.z, v[j].w * rstd * gg.w) << 32); }
}
__device__ __forceinline__ void convert_experts(const float* w1, const float* w3, const float* w2, bf16* W13, bf16* W2T, LAS float* scr, int gw, int NGW, int lane) {
    constexpr int I_13 = (D / 64) * (DEXP / 32);
    constexpr int I_2 = (DEXP / 64) * (D / 32);
    for (int it = gw; it < NEXP * (2 * I_13 + I_2); it += NGW) {
        const int e = it / (2 * I_13 + I_2); int r = it % (2 * I_13 + I_2);
        if (r < 2 * I_13) { const int which = r / I_13; r %= I_13; const int nb = r % (DEXP / 32), n0 = nb * 32;
            const int row_off = (n0 / 128) * 256 + which * 128 + (n0 % 128) - n0;
            transpose_item((which ? w3 : w1) + (size_t)e * D * DEXP, D, DEXP, W13 + (size_t)e * 1024 * 1024, row_off, scr, r, lane); }
        else { r -= 2 * I_13; transpose_item(w2 + (size_t)e * DEXP * D, DEXP, D, W2T + (size_t)e * 1024 * 512, 0, scr, r, lane); }
    }
}

namespace att {
typedef short v4i16_t __attribute__((ext_vector_type(4)));
__device__ __forceinline__ s16x4 vtr(const LAS char* p) { return __builtin_bit_cast(s16x4, __builtin_amdgcn_ds_read_tr16_b64_v4i16((LAS v4i16_t*)p)); }
__device__ __forceinline__ int crow(int r, int hi) { return (r & 3) + 8 * (r >> 2) + 4 * hi; }
__device__ __forceinline__ float xmax(float v) { auto rr = __builtin_amdgcn_permlane32_swap(__float_as_uint(v), __float_as_uint(v), false, false); return fmaxf(__uint_as_float(rr[0]), __uint_as_float(rr[1])); }
__device__ __forceinline__ float xsum(float v) { auto rr = __builtin_amdgcn_permlane32_swap(__float_as_uint(v), __float_as_uint(v), false, false); return __uint_as_float(rr[0]) + __uint_as_float(rr[1]); }
__device__ __forceinline__ bf16x8 vfrag(const LAS char* p) { const s16x4 lo = vtr(p), hi = vtr(p + 512); return (bf16x8){lo[0], lo[1], lo[2], lo[3], hi[0], hi[1], hi[2], hi[3]}; }
__device__ __forceinline__ int vbase(int lane) { const int hi = lane >> 5; return ((lane >> 4) & 1) * 32 + (lane & 3) * 8 + (4 * hi + ((lane & 15) >> 2)) * 64; }
__device__ __forceinline__ bf16x8 pack8(const f32x16& p, int r0) {
    u32x4 w; w.x = cvt_pk_bf16(p[r0], p[r0 + 1]); w.y = cvt_pk_bf16(p[r0 + 2], p[r0 + 3]); w.z = cvt_pk_bf16(p[r0 + 4], p[r0 + 5]); w.w = cvt_pk_bf16(p[r0 + 6], p[r0 + 7]);
    return __builtin_bit_cast(bf16x8, w);
}

struct AttnP {
    const bf16* Q; const bf16* K; const bf16* V; bf16* O; int ldq, ldk, ldv, ldo;
    int q0;
    int t_begin, t_end;
    float c;
    float slope;
    const LAS float* tab;
};
template <int DQK, int DV> struct Lay { static constexpr int KB = DQK * 128, VB = DV * 128, K0 = 0, V0 = 2 * KB, WSF = V0 + 2 * VB, END = WSF + 8 * 64 * 4; };

template <int DQK, int DV, int MODE>
__device__ __forceinline__ void attn_unit(LAS char* lds, const AttnP& P, const int tid) {
    typedef Lay<DQK, DV> L;
    constexpr int NKP = DQK / 64, NVP = DV / 64, ND0 = DQK / 16, NDB = DV / 32;
    const int lane = tid & 63, r32 = lane & 31, hi = lane >> 5; const int wid = __builtin_amdgcn_readfirstlane(tid >> 6);
    const int qrow0 = P.q0 + 32 * wid;
    const int cq = qrow0 >> 6;
    int wlo = P.t_begin, whi = P.t_end - 1;
    if (MODE == 1) { wlo = cq - 8 < 0 ? 0 : cq - 8; whi = cq; }
    if (MODE == 2) { whi = cq; }
    LAS float* wsf = (LAS float*)(lds + L::WSF) + wid * 64;
    bf16x8 qr[ND0];
#pragma unroll
    for (int d0 = 0; d0 < ND0; ++d0) qr[d0] = *(const bf16x8*)(P.Q + (size_t)(qrow0 + r32) * P.ldq + d0 * 16 + hi * 8);
    f32x16 o[NDB];
#pragma unroll
    for (int db = 0; db < NDB; ++db) o[db] = (f32x16){};
    float mrun = -1e30f, lrun = 0.f;
    const int qpos = qrow0 + r32;
    u32x4 kreg[NKP], vreg[NVP];
#define ATT_LOAD(t) do { _Pragma("unroll") for (int i_ = 0; i_ < NKP; ++i_) kreg[i_] = *(const u32x4*)(P.K + (size_t)(64 * (t) + lane) * P.ldk + (wid + 8 * i_) * 8); \
        _Pragma("unroll") for (int i_ = 0; i_ < NVP; ++i_) { const int p_ = wid + 8 * i_, db_ = p_ >> 2, rg_ = p_ & 3; \
            vreg[i_] = *(const u32x4*)(P.V + (size_t)(64 * (t) + 16 * rg_ + (lane >> 2)) * P.ldv + 32 * db_ + (lane & 3) * 8); } } while (0)
#define ATT_STORE(buf) do { _Pragma("unroll") for (int i_ = 0; i_ < NKP; ++i_) *(LAS u32x4*)(lds + L::K0 + (buf) * L::KB + (wid + 8 * i_) * 1024 + lane * 16) = kreg[i_]; \
        _Pragma("unroll") for (int i_ = 0; i_ < NVP; ++i_) *(LAS u32x4*)(lds + L::V0 + (buf) * L::VB + (wid + 8 * i_) * 1024 + lane * 16) = vreg[i_]; } while (0)
    ATT_LOAD(P.t_begin); ATT_STORE(0);
    __syncthreads();
    const int vb = vbase(lane);
    for (int t = P.t_begin; t < P.t_end; ++t) {
        const int buf = (t - P.t_begin) & 1;
        if (t + 1 < P.t_end) ATT_LOAD(t + 1);
        if (t >= wlo && t <= whi) {
            const LAS char* kp = lds + L::K0 + buf * L::KB + hi * 1024 + r32 * 16;
            f32x16 p0 = (f32x16){}, p1 = (f32x16){};
#pragma unroll
            for (int d0 = 0; d0 < ND0; ++d0) {
                const bf16x8 b0 = *(const LAS bf16x8*)(kp + d0 * 2048), b1 = *(const LAS bf16x8*)(kp + d0 * 2048 + 512);
                p0 = __builtin_amdgcn_mfma_f32_32x32x16_bf16(b0, qr[d0], p0, 0, 0, 0);
                p1 = __builtin_amdgcn_mfma_f32_32x32x16_bf16(b1, qr[d0], p1, 0, 0, 0);
            }
            if (MODE == 0) {
#pragma unroll
                for (int r = 0; r < 16; ++r) { p0[r] *= P.c; p1[r] *= P.c; }
            } else if (MODE == 1) {
                const int jrel = t - (cq - 8);
                if (jrel <= 5) { const float bc = P.tab[256];
#pragma unroll
                    for (int r = 0; r < 16; ++r) { p0[r] = fmaf(p0[r], P.c, bc); p1[r] = fmaf(p1[r], P.c, bc); }
                } else {
                    const int dbase = qpos - 64 * t - 4 * hi;
#pragma unroll
                    for (int r = 0; r < 16; ++r) { const int d0_ = dbase - ((r & 3) + 8 * (r >> 2)), d1_ = d0_ - 32;
                        const int i0 = (d0_ < -128 ? -128 : (d0_ > 128 ? 128 : d0_)) + 128, i1 = (d1_ < -128 ? -128 : (d1_ > 128 ? 128 : d1_)) + 128;
                        p0[r] = fmaf(p0[r], P.c, P.tab[i0]); p1[r] = fmaf(p1[r], P.c, P.tab[i1]); }
                }
            } else {
                const float xb = (float)(qpos - 64 * t - 4 * hi);
#pragma unroll
                for (int r = 0; r < 16; ++r) { const float x0 = xb - (float)((r & 3) + 8 * (r >> 2)), x1 = x0 - 32.f;
                    p0[r] = fmaf(-P.slope, fabsf(x0), p0[r] * P.c); p1[r] = fmaf(-P.slope, fabsf(x1), p1[r] * P.c); }
            }
            float rm = fmaxf(p0[0], p1[0]);
#pragma unroll
            for (int r = 1; r < 16; ++r) rm = fmaxf(rm, fmaxf(p0[r], p1[r]));
            rm = xmax(rm);
            if (__any(rm > mrun + 8.f)) {
                const float mn = fmaxf(mrun, rm), al = fexp2(mrun - mn); mrun = mn; lrun *= al;
                if (hi == 0) wsf[r32] = al;
                LDS_WAIT();
#pragma unroll
                for (int r = 0; r < 16; ++r) { const float a = wsf[crow(r, hi)];
#pragma unroll
                    for (int db = 0; db < NDB; ++db) o[db][r] *= a; }
            }
            float ls = 0.f;
#pragma unroll
            for (int r = 0; r < 16; ++r) { p0[r] = fexp2(p0[r] - mrun); p1[r] = fexp2(p1[r] - mrun); ls += p0[r] + p1[r]; }
            lrun += ls;
            const bf16x8 pw0 = pack8(p0, 0), pw1 = pack8(p0, 8), pw2 = pack8(p1, 0), pw3 = pack8(p1, 8);
            const LAS char* vp = lds + L::V0 + buf * L::VB + vb;
#pragma unroll
            for (int db = 0; db < NDB; ++db) {
                o[db] = __builtin_amdgcn_mfma_f32_32x32x16_bf16(pw0, vfrag(vp + db * 4096 + 0 * 1024), o[db], 0, 0, 0);
                o[db] = __builtin_amdgcn_mfma_f32_32x32x16_bf16(pw1, vfrag(vp + db * 4096 + 1 * 1024), o[db], 0, 0, 0);
                o[db] = __builtin_amdgcn_mfma_f32_32x32x16_bf16(pw2, vfrag(vp + db * 4096 + 2 * 1024), o[db], 0, 0, 0);
                o[db] = __builtin_amdgcn_mfma_f32_32x32x16_bf16(pw3, vfrag(vp + db * 4096 + 3 * 1024), o[db], 0, 0, 0);
            }
        }
        if (t + 1 < P.t_end) ATT_STORE(buf ^ 1);
        __syncthreads();
    }
#undef ATT_LOAD
#undef ATT_STORE
    const float lt = xsum(lrun);
    if (hi == 0) wsf[r32] = 1.0f / lt;
    LDS_WAIT();
#pragma unroll
    for (int r = 0; r < 16; ++r) { const int qr_ = crow(r, hi); const float inv = wsf[qr_];
        bf16* orow = P.O + (size_t)(qrow0 + qr_) * P.ldo + r32;
#pragma unroll
        for (int db = 0; db < NDB; ++db) orow[db * 32] = (bf16)f2bf(o[db][r] * inv); }
    LDS_WAIT();
}
}

namespace ret {
using att::crow; using att::vfrag; using att::vbase; using att::pack8; using att::xsum;
__device__ __forceinline__ float gamma_log2(int h) { return log2f(1.0f - exp2f(-5.0f - (float)h)); }
template <bool SCALE>
__device__ __forceinline__ void stage_tile(LAS char* dst, const bf16* src, int ld, int lane, float lg2, float mul) {
#pragma unroll
    for (int p = 0; p < 8; ++p) { const int db = p >> 2, rg = p & 3, row = 16 * rg + (lane >> 2), col = 32 * db + (lane & 3) * 8;
        u32x4 v = *(const u32x4*)(src + (size_t)row * ld + col);
        if (SCALE) { const float s = fexp2(lg2 * (float)(63 - row)) * mul;
            v.x = cvt_pk_bf16(bflo(v.x) * s, bfhi(v.x) * s); v.y = cvt_pk_bf16(bflo(v.y) * s, bfhi(v.y) * s); v.z = cvt_pk_bf16(bflo(v.z) * s, bfhi(v.z) * s); v.w = cvt_pk_bf16(bflo(v.w) * s, bfhi(v.w) * s); }
        *(LAS u32x4*)(dst + p * 1024 + lane * 16) = v; }
}
__device__ __forceinline__ void kv_unit(LAS char* wl, const bf16* z, float* kvT, int c, int h, int lane) {
    const int hi = lane >> 5, r32 = lane & 31;
    const bf16* kp = z + (size_t)(c * CHUNK) * ZC + Z_CK + h * 64; const bf16* vp = z + (size_t)(c * CHUNK) * ZC + Z_CV + h * 64;
    stage_tile<true>(wl, kp, ZC, lane, gamma_log2(h), 0.125f);
    stage_tile<false>(wl + 8192, vp, ZC, lane, 0.f, 1.f);
    LDS_WAIT();
    const int vb = vbase(lane);
    f32x16 acc[2][2];
#pragma unroll
    for (int dt = 0; dt < 2; ++dt)
#pragma unroll
        for (int et = 0; et < 2; ++et) { acc[dt][et] = (f32x16){};
#pragma unroll
            for (int ks = 0; ks < 4; ++ks) acc[dt][et] = __builtin_amdgcn_mfma_f32_32x32x16_bf16(vfrag(wl + vb + dt * 4096 + ks * 1024), vfrag(wl + 8192 + vb + et * 4096 + ks * 1024), acc[dt][et], 0, 0, 0); }
    float* ob = kvT + ((size_t)(c * 8 + h) * 64) * 64;
#pragma unroll
    for (int dt = 0; dt < 2; ++dt)
#pragma unroll
        for (int et = 0; et < 2; ++et)
#pragma unroll
            for (int g4 = 0; g4 < 4; ++g4)
                *(f32x4*)(ob + (size_t)(32 * et + r32) * 64 + 32 * dt + 8 * g4 + 4 * hi) = (f32x4){acc[dt][et][4 * g4], acc[dt][et][4 * g4 + 1], acc[dt][et][4 * g4 + 2], acc[dt][et][4 * g4 + 3]};
    LDS_WAIT();
}
__device__ __forceinline__ void out_unit(LAS char* wl, const bf16* z, const bf16* rT, bf16* y, int c, int h, int lane) {
    const int hi = lane >> 5, r32 = lane & 31;
    const size_t row0 = (size_t)c * CHUNK;
    const bf16* qp = z + row0 * ZC + Z_CQ + h * 64; const bf16* kp = z + row0 * ZC + Z_CK + h * 64; const bf16* vp = z + row0 * ZC + Z_CV + h * 64; const bf16* gp = z + row0 * ZC + Z_CG + h * 64;
    const bf16* rp = rT + ((size_t)(c * 8 + h) * 64) * 64;
    stage_tile<false>(wl, vp, ZC, lane, 0.f, 1.f);
    const float lg2 = gamma_log2(h);
    LDS_WAIT();
    const int vb = vbase(lane);
    bf16* yo = y + row0 * YC + 1024 + h * 64;
#pragma unroll 1
    for (int nt = 0; nt < 2; ++nt) {
        const int i = 32 * nt + r32;
        bf16x8 qf[4];
#pragma unroll
        for (int s = 0; s < 4; ++s) qf[s] = *(const bf16x8*)(qp + (size_t)i * ZC + 16 * s + 8 * hi);
        f32x16 oT[2], cr[2];
#pragma unroll
        for (int et = 0; et < 2; ++et) { oT[et] = (f32x16){}; cr[et] = (f32x16){};
#pragma unroll
            for (int s = 0; s < 4; ++s) cr[et] = __builtin_amdgcn_mfma_f32_32x32x16_bf16(*(const bf16x8*)(rp + (size_t)(32 * et + r32) * 64 + 16 * s + 8 * hi), qf[s], cr[et], 0, 0, 0); }
#pragma unroll
        for (int mt = 0; mt < 2; ++mt) {
            f32x16 st = (f32x16){};
#pragma unroll
            for (int s = 0; s < 4; ++s) st = __builtin_amdgcn_mfma_f32_32x32x16_bf16(*(const bf16x8*)(kp + (size_t)(32 * mt + r32) * ZC + 16 * s + 8 * hi), qf[s], st, 0, 0, 0);
#pragma unroll
            for (int r = 0; r < 16; ++r) { const int j = 32 * mt + crow(r, hi); const float w = (i >= j) ? fexp2(lg2 * (float)(i - j)) * 0.125f : 0.f; st[r] *= w; }
            const bf16x8 pA = pack8(st, 0), pB = pack8(st, 8);
#pragma unroll
            for (int et = 0; et < 2; ++et) {
                oT[et] = __builtin_amdgcn_mfma_f32_32x32x16_bf16(vfrag(wl + vb + et * 4096 + (2 * mt) * 1024), pA, oT[et], 0, 0, 0);
                oT[et] = __builtin_amdgcn_mfma_f32_32x32x16_bf16(vfrag(wl + vb + et * 4096 + (2 * mt + 1) * 1024), pB, oT[et], 0, 0, 0); }
        }
        const float xi = fexp2(lg2 * (float)(i + 1));
        float s1 = 0.f;
#pragma unroll
        for (int et = 0; et < 2; ++et)
#pragma unroll
            for (int r = 0; r < 16; ++r) { oT[et][r] = fmaf(xi, cr[et][r], oT[et][r]); s1 += oT[et][r]; }
        const float mean = xsum(s1) * (1.f / 64.f);
        float s2 = 0.f;
#pragma unroll
        for (int et = 0; et < 2; ++et)
#pragma unroll
            for (int r = 0; r < 16; ++r) { oT[et][r] -= mean; s2 += oT[et][r] * oT[et][r]; }
        const float rstd = 1.0f / sqrtf(xsum(s2) * (1.f / 64.f) + GN_EPS);
#pragma unroll
        for (int et = 0; et < 2; ++et)
#pragma unroll
            for (int g4 = 0; g4 < 4; ++g4) { const int e = 32 * et + 8 * g4 + 4 * hi;
                const u32x2 gw = *(const u32x2*)(gp + (size_t)i * ZC + e);
                const float g0 = bflo(gw.x), g1 = bfhi(gw.x), g2 = bflo(gw.y), g3 = bfhi(gw.y);
                u32x2 w; w.x = cvt_pk_bf16(g0 * sigmoidf_(g0) * oT[et][4 * g4] * rstd, g1 * sigmoidf_(g1) * oT[et][4 * g4 + 1] * rstd);
                w.y = cvt_pk_bf16(g2 * sigmoidf_(g2) * oT[et][4 * g4 + 2] * rstd, g3 * sigmoidf_(g3) * oT[et][4 * g4 + 3] * rstd);
                *(u32x2*)(yo + (size_t)i * YC + e) = w; }
    }
    LDS_WAIT();
}
}

namespace lru {
struct LruP { const bf16* z; const float *conv_w, *conv_b, *wa, *ba, *wx, *bx, *lam; float *carA, *carH; const float* carI; bf16* y; };
constexpr int XS = 144;
template <bool FINAL>
__device__ __forceinline__ void unit(LAS char* wl, const LruP& P, int seg, int k, int lane) {
    const int r32 = lane & 31, hi = lane >> 5;
    LAS float* tb = (LAS float*)(wl + 5120);
    { const int ch = k * 64 + lane;
      tb[0 * 64 + lane] = P.conv_w[ch]; tb[1 * 64 + lane] = P.conv_w[512 + ch]; tb[2 * 64 + lane] = P.conv_w[1024 + ch]; tb[3 * 64 + lane] = P.conv_w[1536 + ch];
      tb[4 * 64 + lane] = P.conv_b[ch]; tb[5 * 64 + lane] = P.ba[ch]; tb[6 * 64 + lane] = P.bx[ch]; tb[7 * 64 + lane] = 8.0f * log1pf(expf(-P.lam[ch])); }
#pragma unroll 1
    for (int mt = 0; mt < 2; ++mt) {
        bf16x8 WA[4], WX[4];
#pragma unroll
        for (int s = 0; s < 4; ++s) { u32x4 wa_, wx_; float fa[8], fx[8];
#pragma unroll
            for (int j = 0; j < 8; ++j) { const size_t o = (size_t)(k * 64 + 16 * s + 8 * hi + j) * 64 + 32 * mt + r32; fa[j] = P.wa[o]; fx[j] = P.wx[o]; }
            wa_.x = pk2(fa[0], fa[1]); wa_.y = pk2(fa[2], fa[3]); wa_.z = pk2(fa[4], fa[5]); wa_.w = pk2(fa[6], fa[7]);
            wx_.x = pk2(fx[0], fx[1]); wx_.y = pk2(fx[2], fx[3]); wx_.z = pk2(fx[4], fx[5]); wx_.w = pk2(fx[6], fx[7]);
            WA[s] = __builtin_bit_cast(bf16x8, wa_); WX[s] = __builtin_bit_cast(bf16x8, wx_); }
        f32x16 hin, apr;
#pragma unroll
        for (int g4 = 0; g4 < 4; ++g4) { f32x4 c4 = (f32x4){0.f, 0.f, 0.f, 0.f};
            if (FINAL) c4 = *(const f32x4*)(P.carI + (size_t)seg * 512 + k * 64 + 32 * mt + 8 * g4 + 4 * hi);
#pragma unroll
            for (int j = 0; j < 4; ++j) { hin[4 * g4 + j] = c4[j]; apr[4 * g4 + j] = 1.f; } }
#pragma unroll 1
        for (int half = 0; half < 2; ++half) {
            const int t0 = seg * 64 + half * 32;
#pragma unroll
            for (int i = 0; i < 5; ++i) { const int rr = i * 8 + (lane >> 3); if (rr < 35) { const int t = t0 - 3 + rr; u32x4 v = (u32x4){0u, 0u, 0u, 0u};
                    if (t >= 0) v = *(const u32x4*)(P.z + (size_t)t * ZC + Z_AX + k * 64 + (lane & 7) * 8);
                    *(LAS u32x4*)(wl + rr * XS + (lane & 7) * 16) = v; } }
            LDS_WAIT();
            f32x16 aA = (f32x16){}, aX = (f32x16){}, aI = (f32x16){};
#pragma unroll
            for (int s = 0; s < 4; ++s) {
                const int c0 = 16 * s + 8 * hi; float xc[8];
                { const f32x4 b0 = *(const LAS f32x4*)(tb + 4 * 64 + c0), b1 = *(const LAS f32x4*)(tb + 4 * 64 + c0 + 4);
                  xc[0] = b0[0]; xc[1] = b0[1]; xc[2] = b0[2]; xc[3] = b0[3]; xc[4] = b1[0]; xc[5] = b1[1]; xc[6] = b1[2]; xc[7] = b1[3]; }
#pragma unroll
                for (int jr = 0; jr < 4; ++jr) { const u32x4 xv = *(const LAS u32x4*)(wl + (r32 + jr) * XS + (2 * s + hi) * 16);
                    const f32x4 w0 = *(const LAS f32x4*)(tb + jr * 64 + c0), w1 = *(const LAS f32x4*)(tb + jr * 64 + c0 + 4);
                    xc[0] = fmaf(w0[0], bflo(xv.x), xc[0]); xc[1] = fmaf(w0[1], bfhi(xv.x), xc[1]); xc[2] = fmaf(w0[2], bflo(xv.y), xc[2]); xc[3] = fmaf(w0[3], bfhi(xv.y), xc[3]);
                    xc[4] = fmaf(w1[0], bflo(xv.z), xc[4]); xc[5] = fmaf(w1[1], bfhi(xv.z), xc[5]); xc[6] = fmaf(w1[2], bflo(xv.w), xc[6]); xc[7] = fmaf(w1[3], bfhi(xv.w), xc[7]); }
                u32x4 pw; pw.x = pk2(xc[0], xc[1]); pw.y = pk2(xc[2], xc[3]); pw.z = pk2(xc[4], xc[5]); pw.w = pk2(xc[6], xc[7]);
                const bf16x8 xb = __builtin_bit_cast(bf16x8, pw);
                aA = __builtin_amdgcn_mfma_f32_32x32x16_bf16(WA[s], xb, aA, 0, 0, 0);
                aX = __builtin_amdgcn_mfma_f32_32x32x16_bf16(WX[s], xb, aX, 0, 0, 0);
                u32x4 idw;
                { const int d = 32 * mt + r32 - 16 * s - 8 * hi;
                  idw.x = (d == 0 ? 0x3f80u : 0u) | (d == 1 ? 0x3f800000u : 0u); idw.y = (d == 2 ? 0x3f80u : 0u) | (d == 3 ? 0x3f800000u : 0u);
                  idw.z = (d == 4 ? 0x3f80u : 0u) | (d == 5 ? 0x3f800000u : 0u); idw.w = (d == 6 ? 0x3f80u : 0u) | (d == 7 ? 0x3f800000u : 0u); }
                aI = __builtin_amdgcn_mfma_f32_32x32x16_bf16(__builtin_bit_cast(bf16x8, idw), xb, aI, 0, 0, 0);
            }
#pragma unroll
            for (int g4 = 0; g4 < 4; ++g4) { const int cb_ = 32 * mt + 8 * g4 + 4 * hi;
                const f32x4 vba = *(const LAS f32x4*)(tb + 5 * 64 + cb_), vbx = *(const LAS f32x4*)(tb + 6 * 64 + cb_), vsp = *(const LAS f32x4*)(tb + 7 * 64 + cb_);
#pragma unroll
                for (int j = 0; j < 4; ++j) { const int r = 4 * g4 + j;
                    const float rg = sigmoidf_(aA[r] + vba[j]), ig = sigmoidf_(aX[r] + vbx[j]);
                    const float la = -rg * vsp[j];
                    aA[r] = fexp2(la * LOG2E);
                    aX[r] = sqrtf(-expm1f(2.0f * la)) * (ig * aI[r]); } }
#pragma unroll
            for (int r = 0; r < 16; ++r) { float a = aA[r], u = aX[r];
#pragma unroll
                for (int d = 1; d < 32; d <<= 1) { const float a2 = __shfl_up(a, d, 32), u2 = __shfl_up(u, d, 32); if (r32 >= d) { u = fmaf(a, u2, u); a *= a2; } }
                aA[r] = a; aX[r] = u; }
            if (FINAL) {
#pragma unroll
                for (int r = 0; r < 16; ++r) { const float h = fmaf(aA[r], hin[r], aX[r]); aX[r] = h; hin[r] = __shfl(h, 31, 32); }
#pragma unroll
                for (int g4 = 0; g4 < 4; ++g4) { const int cb_ = k * 64 + 32 * mt + 8 * g4 + 4 * hi;
                    const u32x2 gw = *(const u32x2*)(P.z + (size_t)(t0 + r32) * ZC + Z_AG + cb_);
                    float gv[4] = {bflo(gw.x), bfhi(gw.x), bflo(gw.y), bfhi(gw.y)}, o4[4];
#pragma unroll
                    for (int j = 0; j < 4; ++j) { const float g = gv[j]; o4[j] = aX[4 * g4 + j] * g * frcp(1.0f + fexp2(-1.5957691216f * LOG2E * (g + 0.044715f * g * g * g))); }
                    u32x2 w; w.x = pk2(o4[0], o4[1]); w.y = pk2(o4[2], o4[3]);
                    *(u32x2*)(P.y + (size_t)(t0 + r32) * YC + cb_) = w; }
            } else {
#pragma unroll
                for (int r = 0; r < 16; ++r) { const float a31 = __shfl(aA[r], 31, 32), u31 = __shfl(aX[r], 31, 32); hin[r] = fmaf(a31, hin[r], u31); apr[r] *= a31; }
            }
            LDS_WAIT();
        }
        if (!FINAL) { if (r32 == 0) {
#pragma unroll
            for (int g4 = 0; g4 < 4; ++g4) { const size_t o = (size_t)seg * 512 + k * 64 + 32 * mt + 8 * g4 + 4 * hi;
                *(f32x4*)(P.carA + o) = (f32x4){apr[4 * g4], apr[4 * g4 + 1], apr[4 * g4 + 2], apr[4 * g4 + 3]};
                *(f32x4*)(P.carH + o) = (f32x4){hin[4 * g4], hin[4 * g4 + 1], hin[4 * g4 + 2], hin[4 * g4 + 3]}; } } }
    }
}
}

constexpr int NPH_LAYER = 19, NPHASE = 2 + DEPTH * NPH_LAYER;

__global__ void __launch_bounds__(NTHREADS, 2) fwd_kernel(Args args) {
    extern __shared__ __attribute__((aligned(16))) unsigned char lds_raw[];
    LAS unsigned char* lds = (LAS unsigned char*)lds_raw;
    const int G = gridDim.x; const int bx = blockIdx.x;
    const int vcu = (G % 8 == 0) ? (bx % 8) * (G / 8) + bx / 8 : bx;
    const int NGW = G * NWAVES;
    typedef const __attribute__((address_space(4))) Args* KArgs;
#define PH_PTRS KArgs KA = (KArgs)__builtin_amdgcn_kernarg_segment_ptr(); asm volatile("" : "+s"(KA)); unsigned char* const ws = KA->ws; (void)ws; \
    int tid = threadIdx.x; asm volatile("" : "+v"(tid)); const int lane = tid & 63; const int wid = __builtin_amdgcn_readfirstlane(tid >> 6); const int gw = vcu * NWAVES + wid; (void)lane; (void)gw
#define ctl ((unsigned*)(ws + WS_CTL))
#define memn ((bf16*)(ws + WS_MEMN))
#define kvmem ((bf16*)(ws + WS_KMEM))
#define wtr ((bf16*)(ws + WS_WTR))
#define carA ((float*)(ws + WS_CARA))
#define carH ((float*)(ws + WS_CARH))
#define carI ((float*)(ws + WS_CARI))
#define tokE ((int*)(ws + WS_TOKE))
#define tokP ((int*)(ws + WS_TOKP))
#define tokW ((float*)(ws + WS_TOKW))
#define elist ((int*)(ws + WS_ELIST))
#define wt_in ((bf16*)(ws + WS_WIN))
#define wt_br ((bf16*)(ws + WS_WBR))
#define wt_out ((bf16*)(ws + WS_WOUT))
#define wt_mq ((bf16*)(ws + WS_WMQ))
#define wt_mk ((bf16*)(ws + WS_WMK))
#define wt_mv ((bf16*)(ws + WS_WMV))
#define wt_mo ((bf16*)(ws + WS_WMO))
#define w13 ((bf16*)(ws + WS_W13))
#define w2t ((bf16*)(ws + WS_W2))
#define hb ((bf16*)(ws + WS_H))
#define yb ((bf16*)(ws + WS_Y))
#define kvT ((float*)(ws + WS_KVT))
#define rT ((bf16*)(ws + WS_RT))
#define odb ((bf16*)(ws + WS_OD))
#define zb ((bf16*)(ws + WS_Z))
#define gtb ((bf16*)(ws + WS_G))
#define mrg ((bf16*)(ws + WS_MRG))
#define qb ((bf16*)(ws + WS_QB))
#define obf ((bf16*)(ws + WS_OB))
#define hid ((bf16*)(ws + WS_HID))
#define ymoe ((bf16*)(ws + WS_YMOE))
#define xin (KA->in[I_X])
#define xout (KA->out)
    volatile LAS unsigned* MISC = (volatile LAS unsigned*)(lds + LDS_MISC);
    if (threadIdx.x < 64) MISC[threadIdx.x] = 0u;
    __syncthreads();
    const int lo = args.ph_lo, hi_ph = args.ph_hi;
    XcdBarrier bar; bar.x = 0; bar.st = nullptr; bar.bar = nullptr;
    { PH_PTRS; bar.bar = ctl + CW_BAR; if (hi_ph - lo > 1) bar = xcd_barrier_post(ctl + CW_BAR, MISC + 8); }
#ifndef PH_EN
#define PH_EN 0xFFFFFFFFu
#endif
#define EN(p) (((PH_EN) >> (p)) & 1u)
#define IN(k) (lo <= (k) && (k) < hi_ph)
#define SEAM(k) do { if (IN(k) && IN((k) + 1)) xcd_barrier(bar); } while (0)

    if (EN(19) && IN(0)) { PH_PTRS;
        LAS float* scr = (LAS float*)(lds + wid * 16384);
        for (int l = 0; l < DEPTH; ++l) {
            constexpr int I_IN = (D / 64) * (INC / 32), I_BR = (512 / 64) * (D / 32), I_OUT = (D / 64) * (D / 32), I_MQ = (D / 64) * (512 / 32), I_MO = (512 / 64) * (D / 32);
            constexpr int NIT = I_IN + 4 * I_BR + I_OUT + 3 * I_MQ + I_MO;
            for (int it = gw; it < NIT; it += NGW) {
                int r = it;
                if (r < I_IN) { transpose_item(KA->in[I_W_IN] + (size_t)l * D * INC, D, INC, wt_in + (size_t)l * INC * D, 0, scr, r, lane); continue; } r -= I_IN;
                if (r < 4 * I_BR) { const int b = r / I_BR; transpose_item(KA->in[I_W_BRANCH] + (size_t)(l * 4 + b) * 512 * D, 512, D, wt_br + (size_t)(l * 4 + b) * D * 512, 0, scr, r % I_BR, lane); continue; } r -= 4 * I_BR;
                if (r < I_OUT) { transpose_item(KA->in[I_W_OUT] + (size_t)l * D * D, D, D, wt_out + (size_t)l * D * D, 0, scr, r, lane); continue; } r -= I_OUT;
                if (r < I_MQ) { transpose_item(KA->in[I_W_MQ] + (size_t)l * D * 512, D, 512, wt_mq + (size_t)l * 512 * D, 0, scr, r, lane); continue; } r -= I_MQ;
                if (r < I_MQ) { transpose_item(KA->in[I_W_MK] + (size_t)l * D * 512, D, 512, wt_mk + (size_t)l * 512 * D, 0, scr, r, lane); continue; } r -= I_MQ;
                if (r < I_MQ) { transpose_item(KA->in[I_W_MV] + (size_t)l * D * 512, D, 512, wt_mv + (size_t)l * 512 * D, 0, scr, r, lane); continue; } r -= I_MQ;
                transpose_item(KA->in[I_W_MO] + (size_t)l * 512 * D, 512, D, wt_mo + (size_t)l * D * 512, 0, scr, r, lane);
            }
        }
        convert_experts(KA->in[I_W1], KA->in[I_W3], KA->in[I_W2], w13, w2t, scr, gw, NGW, lane);
        for (int i = gw * 64 + lane; i < DEPTH * 64 * D; i += NGW * 64) { const int l = i / (64 * D), n = (i / D) % 64, k = i % D; float v = 0.f;
            if (n < 4) v = KA->in[I_W_GROUP][(size_t)(l * D + k) * 4 + n]; else if (n < 36) v = KA->in[I_W_ROUTER][(size_t)(l * D + k) * 32 + (n - 4)];
            wtr[i] = (bf16)f2bf(v); }
        for (int m = gw; m < MEM_LEN; m += NGW) rms_row_to_bf16(KA->in[I_MEM] + (size_t)m * D, KA->in[I_MEM_NORM], memn + (size_t)m * D, lane);
        for (int i = gw * 64 + lane; i < 256 * D / 8; i += NGW * 64) ((u32x4*)(hb + (size_t)M * D))[i] = (u32x4){0u, 0u, 0u, 0u};
        for (int m = gw; m < M; m += NGW) rms_row_to_bf16(xin + (size_t)m * D, KA->in[I_NORM_MIX], hb + (size_t)m * D, lane);
    }
    SEAM(0);
    if (EN(20) && IN(1)) { PH_PTRS;
        pg8::Gemm g{memn, wt_mk, D, D, D, 0}; pg8::GridOrder S; S.init(1, 8, G, bx);
        pg8::EpiBf16<0> E{kvmem, 2048}; pg8::gemm_phase<pg8::EpiBf16<0>, pg8::GridOrder, false>(lds, g, S, E, tid);
    }
    SEAM(1);

    for (int l = 0; l < DEPTH; ++l) {
        const int pb = 2 + l * NPH_LAYER;
        if (EN(0) && IN(pb + 0)) { PH_PTRS;
            { pg8::Gemm g{hb, wt_in + (size_t)l * INC * D, D, D, D, M}; pg8::GridOrder S; S.init(M / 256, ZC / 256, G, bx);
              pg8::EpiBf16<0> E{zb, ZC}; pg8::gemm_phase<pg8::EpiBf16<0>, pg8::GridOrder, false>(lds, g, S, E, tid); }
        }
        SEAM(pb + 0);
#define LRU_P lru::LruP LP{zb, KA->in[I_CONV_W] + l * 2048, KA->in[I_CONV_B] + l * 512, KA->in[I_LRU_WA] + (size_t)l * 32768, KA->in[I_LRU_BA] + l * 512, \
                     KA->in[I_LRU_WX] + (size_t)l * 32768, KA->in[I_LRU_BX] + l * 512, KA->in[I_LRU_LAMBDA] + l * 512, carA, carH, carI, yb}
        if (EN(1) && IN(pb + 1)) { PH_PTRS; LRU_P;
#ifndef NO_LRU
            for (int u = gw; u < 2048; u += NGW) lru::unit<false>((LAS char*)lds + wid * 16384, LP, u >> 3, u & 7, lane);
#endif
#ifndef NO_RET
            for (int u = gw; u < 2048; u += NGW) ret::kv_unit((LAS char*)lds + wid * 16384, zb, kvT, u >> 3, u & 7, lane);
#endif
        }
        SEAM(pb + 1);
        if (EN(2) && IN(pb + 2)) { PH_PTRS;
            const int gt = vcu * NTHREADS + tid;
            if (gt < 32768) {
                const int hh = gt >> 12; const float gch = exp2f(64.0f * ret::gamma_log2(hh)); float S = 0.f;
#pragma unroll 8
                for (int c = 0; c < NCHUNK; ++c) { const float kv = kvT[(size_t)c * 32768 + gt]; rT[(size_t)c * 32768 + gt] = (bf16)f2bf(S); S = fmaf(gch, S, kv); }
            } else if (gt < 32768 + 512) {
                const int ch = gt - 32768; float hc = 0.f;
#pragma unroll 8
                for (int s = 0; s < 256; ++s) { carI[s * 512 + ch] = hc; hc = fmaf(carA[s * 512 + ch], hc, carH[s * 512 + ch]); }
            }
        }
        SEAM(pb + 2);
        if (EN(3) && IN(pb + 3)) { PH_PTRS; LRU_P;
#ifndef NO_LRU
            for (int u = gw; u < 2048; u += NGW) lru::unit<true>((LAS char*)lds + wid * 16384, LP, u >> 3, u & 7, lane);
#endif
#ifndef NO_RET
            for (int u = gw; u < 2048; u += NGW) ret::out_unit((LAS char*)lds + wid * 16384, zb, rT, yb, u >> 3, u & 7, lane);
#endif
        }
        SEAM(pb + 3);
        if (EN(4) && IN(pb + 4)) { PH_PTRS;
            LAS float* tab = (LAS float*)(lds + 65536);
            for (int u = vcu; u < 512; u += G) { const int head = u & 7, qblk = u >> 3;
                if (tid < 257) tab[tid] = KA->in[I_CA_REL][(size_t)(l * 8 + head) * 257 + tid] * LOG2E;
                __syncthreads();
                att::AttnP P{zb + Z_BQ + head * 64, zb + Z_BK + head * 64, zb + Z_BV + head * 64, yb + 512 + head * 64, ZC, ZC, ZC, YC,
                             qblk * 256, (4 * qblk - 8 < 0 ? 0 : 4 * qblk - 8), 4 * qblk + 4, 0.125f * LOG2E, 0.f, tab};
                att::attn_unit<64, 64, 1>((LAS char*)lds, P, tid);
                __syncthreads(); }
        }
        SEAM(pb + 4);
        if (EN(5) && IN(pb + 5)) { PH_PTRS;
            for (int u = vcu; u < 256; u += G) { const int hm = u & 7, pi = u >> 3; const int head = hm >> 1, mp = hm & 1;
                const float slope = exp2f(-8.0f * (float)(head + 1) / 4.0f) * LOG2E;
                for (int half = 0; half < 2; ++half) { const int qblk = half ? 63 - pi : pi;
                    att::AttnP P{zb + Z_DQ + head * 128 + mp * 64, zb + Z_DK + head * 128 + mp * 64, zb + Z_DV + head * 128, odb + hm * 128, ZC, ZC, ZC, 1024,
                                 qblk * 256, 0, 4 * qblk + 4, 0.125f * LOG2E, slope, nullptr};
                    att::attn_unit<64, 128, 2>((LAS char*)lds, P, tid); } }
        }
        SEAM(pb + 5);
        if (EN(6) && IN(pb + 6)) { PH_PTRS; const float lam_init = 0.8f - 0.6f * expf(-0.3f * (float)l);
            const float* dl = KA->in[I_DIFF_LAMBDA] + l * 256;
            const float lam = expf(wave_sum(dl[lane] * dl[64 + lane])) - expf(wave_sum(dl[128 + lane] * dl[192 + lane])) + lam_init;
            const int head = lane >> 4, sub = lane & 15; const float* sg = KA->in[I_DIFF_SUBLN] + l * 128 + sub * 8;
            float gsc[8];
#pragma unroll
            for (int j = 0; j < 8; ++j) gsc[j] = sg[j] * (1.0f - lam_init);
            for (int m = gw; m < M; m += NGW) {
                const u32x4 a = *(const u32x4*)(odb + (size_t)m * 1024 + (head * 2) * 128 + sub * 8), b = *(const u32x4*)(odb + (size_t)m * 1024 + (head * 2 + 1) * 128 + sub * 8);
                float o[8]; o[0] = bflo(a.x) - lam * bflo(b.x); o[1] = bfhi(a.x) - lam * bfhi(b.x); o[2] = bflo(a.y) - lam * bflo(b.y); o[3] = bfhi(a.y) - lam * bfhi(b.y);
                o[4] = bflo(a.z) - lam * bflo(b.z); o[5] = bfhi(a.z) - lam * bfhi(b.z); o[6] = bflo(a.w) - lam * bflo(b.w); o[7] = bfhi(a.w) - lam * bfhi(b.w);
                float ss = 0.f;
#pragma unroll
                for (int j = 0; j < 8; ++j) ss += o[j] * o[j];
                ss += __shfl_xor(ss, 1); ss += __shfl_xor(ss, 2); ss += __shfl_xor(ss, 4); ss += __shfl_xor(ss, 8);
                const float rs = 1.0f / sqrtf(ss * (1.f / 128.f) + GN_EPS);
                u32x4 w; w.x = cvt_pk_bf16(o[0] * rs * gsc[0], o[1] * rs * gsc[1]); w.y = cvt_pk_bf16(o[2] * rs * gsc[2], o[3] * rs * gsc[3]);
                w.z = cvt_pk_bf16(o[4] * rs * gsc[4], o[5] * rs * gsc[5]); w.w = cvt_pk_bf16(o[6] * rs * gsc[6], o[7] * rs * gsc[7]);
                *(u32x4*)(yb + (size_t)m * YC + 1536 + head * 128 + sub * 8) = w;
            }
            if (l == 1) convert_experts(KA->in[I_W1] + (size_t)NEXP * D * DEXP, KA->in[I_W3] + (size_t)NEXP * D * DEXP, KA->in[I_W2] + (size_t)NEXP * DEXP * D, w13, w2t, (LAS float*)(lds + wid * 16384), gw, NGW, lane);
        }
        SEAM(pb + 6);
        if (EN(7) && IN(pb + 7)) { PH_PTRS;
            pg8::Gemm g{hb, wt_in + (size_t)l * INC * D + (size_t)ZC * D, D, D, D, M}; pg8::GridOrder S; S.init(M / 256, 4096 / 256, G, bx);
            pg8::EpiBf16<1> E{gtb, 4096}; pg8::gemm_phase<pg8::EpiBf16<1>, pg8::GridOrder, false>(lds, g, S, E, tid);
        }
        SEAM(pb + 7);
        if (EN(8) && IN(pb + 8)) { PH_PTRS;
            pg8::Gemm g{yb, wt_br + (size_t)l * 4 * D * 512, YC, 512, 512, M}; pg8::BranchOrder S{G, bx};
            pg8::EpiGateAcc E{gtb, mrg}; pg8::gemm_phase<pg8::EpiGateAcc, pg8::BranchOrder, false>(lds, g, S, E, tid);
        }
        SEAM(pb + 8);
        if (EN(9) && IN(pb + 9)) { PH_PTRS;
            pg8::Gemm g{mrg, wt_out + (size_t)l * D * D, D, D, D, M}; pg8::GridOrder S; S.init(M / 256, D / 256, G, bx);
            pg8::EpiResF32 E{l == 0 ? xin : (const float*)xout, xout, D}; pg8::gemm_phase<pg8::EpiResF32, pg8::GridOrder, false>(lds, g, S, E, tid);
        }
        SEAM(pb + 9);
        if (EN(10) && IN(pb + 10)) { PH_PTRS; for (int m = gw; m < M; m += NGW) rms_row_to_bf16(xout + (size_t)m * D, KA->in[I_NORM_MEM] + l * D, hb + (size_t)m * D, lane); }
        SEAM(pb + 10);
        if (EN(11) && IN(pb + 11)) { PH_PTRS;
            pg8::Gemm g{hb, wt_mq + (size_t)l * 512 * D, D, D, D, M}; pg8::GridOrder S; S.init(M / 256, 2, G, bx);
            pg8::EpiBf16<0> E{qb, 512}; pg8::gemm_phase<pg8::EpiBf16<0>, pg8::GridOrder, false>(lds, g, S, E, tid);
        }
        SEAM(pb + 11);
        if (EN(12) && IN(pb + 12)) { PH_PTRS;
            for (int u = vcu; u < 256; u += G) { const int head = u & 3, qblk = u >> 2;
                att::AttnP P{qb + head * 128, kvmem + l * 512 + head * 128, kvmem + 1024 + l * 512 + head * 128, obf + head * 128, 512, 2048, 2048, 512,
                             qblk * 256, 0, 4, 0.08838834764831845f * LOG2E, 0.f, nullptr};
                att::attn_unit<128, 128, 0>((LAS char*)lds, P, tid); }
        }
        SEAM(pb + 12);
        if (EN(13) && IN(pb + 13)) { PH_PTRS;
            pg8::Gemm g{obf, wt_mo + (size_t)l * D * 512, 512, 512, 512, M}; pg8::GridOrder S; S.init(M / 256, D / 256, G, bx);
            pg8::EpiResF32 E{xout, xout, D}; pg8::gemm_phase<pg8::EpiResF32, pg8::GridOrder, false>(lds, g, S, E, tid);
        }
        SEAM(pb + 13);
        if (EN(14) && IN(pb + 14)) { PH_PTRS; for (int m = gw; m < M; m += NGW) rms_row_to_bf16(xout + (size_t)m * D, KA->in[I_NORM_FFN] + l * D, hb + (size_t)m * D, lane); }
        SEAM(pb + 14);
        if (EN(15) && IN(pb + 15)) { PH_PTRS; unsigned* ecnt = ctl + CW_ECNT + l * 32 * 64;
            LAS float* lg = (LAS float*)(lds + wid * 16384);
            const int r32 = lane & 31, hi = lane >> 5; const bf16* wl_ = wtr + (size_t)l * 64 * D;
            for (int u = gw; u < M / 32; u += NGW) { const int t0 = u * 32;
                f32x16 a0 = (f32x16){}, a1 = (f32x16){};
#pragma unroll 4
                for (int s = 0; s < 64; ++s) { const bf16x8 bf_ = *(const bf16x8*)(hb + (size_t)(t0 + r32) * D + 16 * s + 8 * hi);
                    a0 = __builtin_amdgcn_mfma_f32_32x32x16_bf16(*(const bf16x8*)(wl_ + (size_t)r32 * D + 16 * s + 8 * hi), bf_, a0, 0, 0, 0);
                    a1 = __builtin_amdgcn_mfma_f32_32x32x16_bf16(*(const bf16x8*)(wl_ + (size_t)(32 + r32) * D + 16 * s + 8 * hi), bf_, a1, 0, 0, 0); }
#pragma unroll
                for (int r = 0; r < 16; ++r) { lg[r32 * 65 + att::crow(r, hi)] = a0[r]; lg[r32 * 65 + 32 + att::crow(r, hi)] = a1[r]; }
                LDS_WAIT();
                const LAS float* tl = lg + r32 * 65; const float* bg = KA->in[I_B_GROUP] + l * 4; const float* br = KA->in[I_B_ROUTER] + l * 32;
                float gl[4];
#pragma unroll
                for (int j = 0; j < 4; ++j) gl[j] = tl[j] + bg[j];
                int gs = 0; float gmx = gl[0];
#pragma unroll
                for (int j = 1; j < 4; ++j) if (gl[j] > gmx) { gmx = gl[j]; gs = j; }
                float gsum = 0.f;
#pragma unroll
                for (int j = 0; j < 4; ++j) gsum += __expf(gl[j] - gmx);
                const float gprob = 1.0f / gsum;
                float el[8];
#pragma unroll
                for (int j = 0; j < 8; ++j) el[j] = tl[4 + 8 * gs + j] + br[8 * gs + j];
                int i0 = 0; float m0 = el[0];
#pragma unroll
                for (int j = 1; j < 8; ++j) if (el[j] > m0) { m0 = el[j]; i0 = j; }
                int i1 = -1; float m1 = -3.0e38f;
#pragma unroll
                for (int j = 0; j < 8; ++j) if (j != i0 && el[j] > m1) { m1 = el[j]; i1 = j; }
                const float e1 = __expf(m1 - m0); const float w0 = gprob / (1.0f + e1), w1 = gprob * e1 / (1.0f + e1);
                const int myk = hi; const int e = 8 * gs + (myk ? i1 : i0); const float w = myk ? w1 : w0;
                unsigned long long rem = ~0ull; int leader = 0, rank = 0, cnt = 0;
                while (rem) { const int ld_ = __builtin_ctzll(rem); const int ee = __shfl(e, ld_); const unsigned long long mk = __ballot(e == ee);
                    if (e == ee) { leader = ld_; rank = __builtin_popcountll(mk & ((1ull << lane) - 1ull)); cnt = __builtin_popcountll(mk); } rem &= ~mk; }
                unsigned base = 0u; if (lane == leader) base = __hip_atomic_fetch_add(ecnt + 64 * e, (unsigned)cnt, __ATOMIC_RELAXED, __HIP_MEMORY_SCOPE_AGENT);
                base = __shfl(base, leader); const int pos = (int)base + rank; const int tok = t0 + r32;
                elist[e * 16384 + pos] = tok; tokE[tok * 2 + myk] = e; tokP[tok * 2 + myk] = pos; tokW[tok * 2 + myk] = w;
                LDS_WAIT();
            }
        }
        SEAM(pb + 15);
        LAS int* mtab = (LAS int*)(lds + LDS_MISC + 1024);
        if ((EN(16) || EN(17)) && (IN(pb + 16) || IN(pb + 17))) { PH_PTRS; unsigned* ecnt = ctl + CW_ECNT + l * 32 * 64;
            if (tid == 0) { int nrt = 0; for (int e = 0; e < NEXP; ++e) { const int c = (int)__hip_atomic_load(ecnt + 64 * e, __ATOMIC_RELAXED, __HIP_MEMORY_SCOPE_AGENT); const int nt_ = (c + 255) >> 8;
                    for (int r = 0; r < nt_; ++r) { mtab[16 + 4 * nrt] = e; mtab[16 + 4 * nrt + 1] = r; mtab[16 + 4 * nrt + 2] = nrt; ++nrt; } }
                mtab[0] = nrt; }
            __syncthreads();
        }
        if (EN(16) && IN(pb + 16)) { PH_PTRS; unsigned* ecnt = ctl + CW_ECNT + l * 32 * 64;
            pg8::Gemm g{hb, w13, D, D, D, M}; pg8::MoeOrder S{mtab, G, bx, 4, 1024, elist, ecnt};
            pg8::EpiSwiGlu E{hid}; pg8::gemm_phase<pg8::EpiSwiGlu, pg8::MoeOrder, true>(lds, g, S, E, tid);
        }
        SEAM(pb + 16);
        if (EN(17) && IN(pb + 17)) { PH_PTRS; unsigned* ecnt = ctl + CW_ECNT + l * 32 * 64;
            pg8::Gemm g{hid, w2t, DEXP, DEXP, DEXP, M}; pg8::MoeOrder S{mtab, G, bx, 4, 1024, elist, ecnt};
            pg8::EpiBf16<0> E{ymoe, D}; pg8::gemm_phase<pg8::EpiBf16<0>, pg8::MoeOrder, false>(lds, g, S, E, tid);
        }
        SEAM(pb + 17);
        if (EN(18) && IN(pb + 18)) { PH_PTRS; unsigned* ecnt = ctl + CW_ECNT + l * 32 * 64;
            int sb = 0; { const int c = lane < NEXP ? (int)__hip_atomic_load(ecnt + 64 * (lane & 31), __ATOMIC_RELAXED, __HIP_MEMORY_SCOPE_AGENT) : 0; const int nt_ = (c + 255) >> 8; int inc = nt_;
#pragma unroll
                for (int o = 1; o < 32; o <<= 1) { const int v = __shfl_up(inc, o); if ((lane & 31) >= o) inc += v; }
                sb = (inc - nt_) * 256; }
            const float* gn = (l + 1 < DEPTH) ? KA->in[I_NORM_MIX] + (l + 1) * D : KA->in[I_FINAL_NORM];
            for (int m = gw; m < M; m += NGW) {
                const int e0 = tokE[m * 2], e1 = tokE[m * 2 + 1]; const float w0 = tokW[m * 2], w1 = tokW[m * 2 + 1];
                const size_t s0 = (size_t)(__shfl(sb, e0) + tokP[m * 2]), s1 = (size_t)(__shfl(sb, e1) + tokP[m * 2 + 1]);
                f32x4 v[4]; float ss = 0.f;
#pragma unroll
                for (int j = 0; j < 4; ++j) { v[j] = ((const f32x4*)(xout + (size_t)m * D))[lane + 64 * j];
                    const u32x2 a = ((const u32x2*)(ymoe + s0 * D))[lane + 64 * j], b = ((const u32x2*)(ymoe + s1 * D))[lane + 64 * j];
                    v[j].x += w0 * bflo(a.x) + w1 * bflo(b.x); v[j].y += w0 * bfhi(a.x) + w1 * bfhi(b.x); v[j].z += w0 * bflo(a.y) + w1 * bflo(b.y); v[j].w += w0 * bfhi(a.y) + w1 * bfhi(b.y);
                    ss += (v[j].x * v[j].x + v[j].y * v[j].y) + (v[j].z * v[j].z + v[j].w * v[j].w); }
                const float rstd = 1.f / sqrtf(wave_sum(ss) * (1.f / D) + NORM_EPS);
                if (l + 1 < DEPTH) {
#pragma unroll
                    for (int j = 0; j < 4; ++j) { ((f32x4*)(xout + (size_t)m * D))[lane + 64 * j] = v[j]; const f32x4 gg = ((const f32x4*)gn)[lane + 64 * j];
                        u32x2 w; w.x = pk2(v[j].x * rstd * gg.x, v[j].y * rstd * gg.y); w.y = pk2(v[j].z * rstd * gg.z, v[j].w * rstd * gg.w);
                        ((u32x2*)(hb + (size_t)m * D))[lane + 64 * j] = w; }
                } else {
#pragma unroll
                    for (int j = 0; j < 4; ++j) { const f32x4 gg = ((const f32x4*)gn)[lane + 64 * j];
                        ((f32x4*)(xout + (size_t)m * D))[lane + 64 * j] = (f32x4){v[j].x * rstd * gg.x, v[j].y * rstd * gg.y, v[j].z * rstd * gg.z, v[j].w * rstd * gg.w}; }
                }
            }
        }
        SEAM(pb + 18);
    }
#undef IN
#undef SEAM
}

extern "C" void kernel_launch(void* const* d_in, const int* in_sizes, int n_in, void* d_out, int out_size, void* d_ws, size_t ws_size, hipStream_t stream) {
    static int grid = 0;
    if (grid == 0) {
        if (n_in != 31 || in_sizes[0] != M * D || out_size != M * D || ws_size < WS_END) { fprintf(stderr, "kernel_launch: unexpected problem (n_in %d, in0 %d, out %d, ws %zu < %zu)\n", n_in, n_in > 0 ? in_sizes[0] : -1, out_size, ws_size, (size_t)WS_END); grid = -1; return; }
        int dev = 0, cus = 0, per_cu = 0;
        if (hipGetDevice(&dev) != hipSuccess || hipDeviceGetAttribute(&cus, hipDeviceAttributeMultiprocessorCount, dev) != hipSuccess) { grid = -1; return; }
        if (hipFuncSetAttribute((const void*)fwd_kernel, hipFuncAttributeMaxDynamicSharedMemorySize, LDS_BYTES) != hipSuccess) { fprintf(stderr, "kernel_launch: hipFuncSetAttribute failed\n"); grid = -1; return; }
        if (hipOccupancyMaxActiveBlocksPerMultiprocessor(&per_cu, (const void*)fwd_kernel, NTHREADS, LDS_BYTES) != hipSuccess || per_cu < 1) { fprintf(stderr, "kernel_launch: occupancy query says %d\n", per_cu); }
        (void)hipGetLastError();
        grid = cus;
    }
    if (grid < 0) return;
    if (hipMemsetAsync((char*)d_ws + WS_CTL, 0, CTL_ZERO_BYTES, stream) != hipSuccess) return;
    Args a{};
    for (int i = 0; i < 31; ++i) a.in[i] = (const float*)d_in[i];
    a.out = (float*)d_out; a.ws = (unsigned char*)d_ws;
#if MK_N_LAUNCHES == 1
    a.ph_lo = 0; a.ph_hi = NPHASE;
    hipLaunchKernelGGL(fwd_kernel, dim3(grid), dim3(NTHREADS), LDS_BYTES, stream, a);
#else
    for (int p = 0; p < NPHASE; ++p) { a.ph_lo = p; a.ph_hi = p + 1; hipLaunchKernelGGL(fwd_kernel, dim3(grid), dim3(NTHREADS), LDS_BYTES, stream, a); }
#endif
}
```

```cpp
#include <hip/hip_runtime.h>
#include <cstdio>
#include <cstdint>
#include <cmath>

#ifndef MK_N_LAUNCHES
#define MK_N_LAUNCHES 1
#endif

#define LAS __attribute__((address_space(3)))
#define GAS __attribute__((address_space(1)))
typedef unsigned short bf16;
typedef short bf16x8 __attribute__((ext_vector_type(8)));
typedef short s16x4 __attribute__((ext_vector_type(4)));
typedef float f32x4 __attribute__((ext_vector_type(4)));
typedef float f32x2 __attribute__((ext_vector_type(2)));
typedef float f32x16 __attribute__((ext_vector_type(16)));
typedef unsigned u32x4 __attribute__((ext_vector_type(4)));
typedef unsigned u32x2 __attribute__((ext_vector_type(2)));

constexpr int M = 16384, D = 1024, DEPTH = 2, CHUNK = 64, NCHUNK = M / CHUNK, MEM_LEN = 256;
constexpr int ZC = 6144, INC = 10240, YC = 2048;
constexpr int Z_AX = 0, Z_AG = 512, Z_BQ = 1024, Z_BK = 1536, Z_BV = 2048, Z_CQ = 2560, Z_CK = 3072, Z_CV = 3584, Z_CG = 4096, Z_DQ = 4608, Z_DK = 5120, Z_DV = 5632;
constexpr int NEXP = 32, DEXP = 512;
constexpr int HROWS = M + 256;
constexpr int MAXSLOT = 41216;
constexpr float NORM_EPS = 1e-6f, GN_EPS = 1e-5f;
constexpr float LOG2E = 1.4426950408889634f;

constexpr size_t MiB = 1u << 20;
constexpr size_t WS_CTL = 0, CTL_ZERO_BYTES = 1 * MiB;
constexpr size_t WS_MEMN = 1 * MiB;
constexpr size_t WS_KMEM = 2 * MiB;
constexpr size_t WS_VMEM = 2 * MiB + 512 * 1024;
constexpr size_t WS_WTR = 3 * MiB;
constexpr size_t WS_CARA = 4 * MiB;
constexpr size_t WS_CARH = 4 * MiB + 512 * 1024;
constexpr size_t WS_CARI = 5 * MiB;
constexpr size_t WS_QKN = 5 * MiB + 512 * 1024;
constexpr size_t WS_LSE = 6 * MiB + 512 * 1024;
constexpr size_t WS_TOKE = 6 * MiB;
constexpr size_t WS_TOKP = 6 * MiB + 128 * 1024;
constexpr size_t WS_TOKW = 6 * MiB + 256 * 1024;
constexpr size_t WS_ELIST = 8 * MiB;
constexpr size_t WS_WIN = 10 * MiB;
constexpr size_t WS_WBR = 50 * MiB;
constexpr size_t WS_WOUT = 58 * MiB;
constexpr size_t WS_WMQ = 62 * MiB;
constexpr size_t WS_WMK = 64 * MiB;
constexpr size_t WS_WMV = 66 * MiB;
constexpr size_t WS_WMO = 68 * MiB;
constexpr size_t WS_W13 = 70 * MiB;
constexpr size_t WS_W2 = 134 * MiB;
constexpr size_t WS_H = 166 * MiB;
constexpr size_t WS_Y = 200 * MiB;
constexpr size_t WS_KVT = 264 * MiB;
constexpr size_t WS_RT = 296 * MiB;
constexpr size_t WS_OD = 312 * MiB;
constexpr size_t WS_Z = 344 * MiB;
constexpr size_t WS_G = 344 * MiB;
constexpr size_t WS_MRG = 472 * MiB;
constexpr size_t WS_QB = 504 * MiB;
constexpr size_t WS_OB = 520 * MiB;
constexpr size_t WS_HID = 344 * MiB;
constexpr size_t WS_YMOE = 386 * MiB;
constexpr size_t WS_XS1 = 536 * MiB;
constexpr size_t WS_XS2 = 552 * MiB;
constexpr size_t WS_END = 568 * MiB;
static_assert(WS_HID + (size_t)MAXSLOT * 512 * 2 <= WS_YMOE && WS_YMOE + (size_t)MAXSLOT * 1024 * 2 <= WS_MRG, "moe overlay");
constexpr int CW_TMO = 0, CW_CODE = 1;
constexpr int CW_BAR = 4096;
constexpr int CW_ECNT = 16384;
constexpr int CW_DQ = 24576;

constexpr int LDS_BYTES = 147456;
constexpr int LDS_MISC = 131072;
constexpr int NWAVES = 8, NTHREADS = 512;

__device__ __forceinline__ unsigned f2bf(float f) { unsigned u = __builtin_bit_cast(unsigned, f); return (u + 0x7fffu + ((u >> 16) & 1u)) >> 16; }
__device__ __forceinline__ unsigned pk2(float lo, float hi) { return f2bf(lo) | (f2bf(hi) << 16); }
__device__ __forceinline__ float bf2f(unsigned short b) { return __builtin_bit_cast(float, ((unsigned)b) << 16); }
__device__ __forceinline__ float bflo(unsigned w) { return __builtin_bit_cast(float, w << 16); }
__device__ __forceinline__ float bfhi(unsigned w) { return __builtin_bit_cast(float, w & 0xffff0000u); }
typedef __bf16 bf16x2_t __attribute__((ext_vector_type(2)));
__device__ __forceinline__ unsigned cvt_pk_bf16(float lo, float hi) { const f32x2 v = {lo, hi}; const bf16x2_t b = __builtin_convertvector(v, bf16x2_t); return __builtin_bit_cast(unsigned, b); }
__device__ __forceinline__ float fexp2(float x) { return __builtin_amdgcn_exp2f(x); }
__device__ __forceinline__ float frcp(float x) { return __builtin_amdgcn_rcpf(x); }
__device__ __forceinline__ float sigmoidf_(float x) { return frcp(1.0f + fexp2(-x * LOG2E)); }
__device__ __forceinline__ float wave_sum(float v) {
#pragma unroll
    for (int o = 1; o < 64; o <<= 1) v += __shfl_xor(v, o);
    return v;
}
#define LDS_WAIT() asm volatile("s_waitcnt lgkmcnt(0)" ::: "memory")
#define VM_WAIT() asm volatile("s_waitcnt vmcnt(0)" ::: "memory")

namespace pg8 {
constexpr int BM = 256, BK = 64, HALF = 128, HTB = HALF * BK * 2, STAGE_BYTES = 8 * HTB, NXCD = 8, WGM = 8;
__host__ __device__ __forceinline__ int lds_byte(int r, int c) { const int st = (r >> 4) * 2 + (c >> 5), rr = r & 15, cc = c & 31, ob = rr * 64 + cc * 2; return st * 1024 + (ob ^ (((ob >> 9) & 1) << 5)); }
__host__ __device__ __forceinline__ void stage_rc(int b, int& R, int& C) { const int st = b / 1024, sb = b % 1024, swz = sb ^ (((sb >> 9) & 1) << 5); R = (st >> 1) * 16 + swz / 64; C = (st & 1) * 32 + (swz % 64) / 2; }
__host__ __device__ __forceinline__ int perm32(int rho) { const int n = rho >> 4, i = rho & 15; return 8 * (i >> 2) + 4 * n + (i & 3); }

struct Unit { int arow, acol, brow, pm, pn, aux, gcnt; const int* gl; };
struct Gemm { const bf16* A; const bf16* Bt; int lda, ldb, K, zrow; };

template <class Epi, class Sched, bool GATHER>
__device__ __forceinline__ void gemm_phase(LAS unsigned char* lds, const Gemm g, const Sched& S, const Epi& E, const int tid) {
    const int wid = __builtin_amdgcn_readfirstlane(tid >> 6), lane = tid & 63, wr = wid >> 2, wc = wid & 3, fr = lane & 15, fq = lane >> 4;
    const int K = g.K, nt = K / BK;
    unsigned voffA[2][2], voffB[2];
#pragma unroll
    for (int i = 0; i < 2; ++i) { int R, C; stage_rc(tid * 16 + i * 8192, R, C); const int Rb = Epi::PERM ? ((R & ~31) + perm32(R & 31)) : R;
        voffA[0][i] = (unsigned)(R * g.lda + C) * 2u; voffA[1][i] = voffA[0][i]; voffB[i] = (unsigned)(Rb * g.ldb + C) * 2u; }
    const size_t kstep = (size_t)(BK * 2);
    const size_t hstepA = GATHER ? (size_t)0 : (size_t)HALF * g.lda * 2;
    const size_t hstepB = (size_t)HALF * g.ldb * 2;
    const unsigned ldsw = (unsigned)wid * 1024u;
    const int aoff = lds_byte(wr * 64 + fr, fq * 8), boff = lds_byte(wc * 32 + fr, fq * 8);
#define PG8_SA(b, h) (((b) * 2 + (h)) * HTB)
#define PG8_SB(b, h) ((4 + (b) * 2 + (h)) * HTB)
#define PG8_STAGE(bufoff, gbase, voff) do { _Pragma("unroll") for (int _i = 0; _i < 2; ++_i) \
        __builtin_amdgcn_global_load_lds((const unsigned*)((const char*)(gbase) + (voff)[_i]), (LAS unsigned*)(lds + (bufoff) + ldsw + _i * 8192), 16, 0, 0); } while (0)
#define PG8_LDA(dst, b, h) do { _Pragma("unroll") for (int m = 0; m < 4; ++m) _Pragma("unroll") for (int k = 0; k < 2; ++k) dst[m][k] = *(const LAS bf16x8*)(lds + PG8_SA(b, h) + aoff + m * 2048 + k * 1024); } while (0)
#define PG8_LDB(dst, b, h) do { _Pragma("unroll") for (int n = 0; n < 2; ++n) _Pragma("unroll") for (int k = 0; k < 2; ++k) dst[n][k] = *(const LAS bf16x8*)(lds + PG8_SB(b, h) + boff + n * 2048 + k * 1024); } while (0)
#define PG8_MMA(ai, bj, At, Bt) do { __builtin_amdgcn_s_setprio(1); _Pragma("unroll") for (int m = 0; m < 4; ++m) _Pragma("unroll") for (int n = 0; n < 2; ++n) _Pragma("unroll") for (int k = 0; k < 2; ++k) \
        acc[ai][bj][m][n] = __builtin_amdgcn_mfma_f32_16x16x32_bf16(Bt[n][k], At[m][k], acc[ai][bj][m][n], 0, 0, 0); __builtin_amdgcn_s_setprio(0); } while (0)
#define PG8_WAIT_V(n) asm volatile("s_waitcnt vmcnt(" #n ")" ::: "memory")
#define PG8_WAIT_L(n) asm volatile("s_waitcnt lgkmcnt(" #n ")" ::: "memory")
#define PG8_BAR __builtin_amdgcn_s_barrier()
#define PG8_SCHED __builtin_amdgcn_sched_barrier(0)
#define PG8_SETA(u) do { if constexpr (GATHER) { _Pragma("unroll") for (int _h = 0; _h < 2; ++_h) _Pragma("unroll") for (int _i = 0; _i < 2; ++_i) { \
        int _R, _C; stage_rc(tid * 16 + _i * 8192, _R, _C); const int _r = _h * HALF + _R; const int _row = (_r < (u).gcnt) ? (u).gl[_r] : g.zrow; \
        voffA[_h][_i] = ((unsigned)_row * (unsigned)g.lda + (unsigned)_C) * 2u; } } } while (0)
#define PG8_ABASE(u) (GATHER ? (const char*)g.A : (const char*)g.A + ((size_t)(u).arow * g.lda + (u).acol) * 2)
    Unit cur, nxt; int ui = 0;
    if (!S.next(0, cur)) return;
    f32x4 acc[2][2][4][2];
#pragma unroll
    for (int a = 0; a < 2; ++a)
#pragma unroll
        for (int b = 0; b < 2; ++b)
#pragma unroll
            for (int m = 0; m < 4; ++m)
#pragma unroll
                for (int n = 0; n < 2; ++n) acc[a][b][m][n] = (f32x4){0.f, 0.f, 0.f, 0.f};
    bf16x8 At[4][2], B0[2][2], B1[2][2];
    PG8_SETA(cur);
    const char* cA = PG8_ABASE(cur);
    const char* cB = (const char*)g.Bt + (size_t)cur.brow * g.ldb * 2;
    PG8_STAGE(PG8_SB(0, 0), cB, voffB); PG8_STAGE(PG8_SB(0, 1), cB + hstepB, voffB); PG8_STAGE(PG8_SA(0, 0), cA, voffA[0]); PG8_STAGE(PG8_SA(0, 1), cA + hstepA, voffA[1]);
    if (wr == 1) PG8_BAR;
    PG8_WAIT_V(2); PG8_BAR;
    PG8_STAGE(PG8_SB(1, 0), cB + kstep, voffB); PG8_STAGE(PG8_SA(1, 0), cA + kstep, voffA[0]); PG8_STAGE(PG8_SB(1, 1), cB + hstepB + kstep, voffB);
    PG8_WAIT_V(6); PG8_BAR;
    for (;;) {
        const bool has_next = S.next(ui + 1, nxt);
        const char* nA = has_next ? PG8_ABASE(nxt) : cA; const char* nB = has_next ? (const char*)g.Bt + (size_t)nxt.brow * g.ldb * 2 : cB;
        for (int t = 0; t < nt; t += 2) {
            const bool last = (t == nt - 2);
            const char* a1 = cA + (size_t)(t + 1) * kstep;
            const char* a2 = last ? nA : cA + (size_t)(t + 2) * kstep; const char* b2 = last ? nB : cB + (size_t)(t + 2) * kstep;
            const char* a3 = a2 + kstep; const char* b3 = b2 + kstep;
            PG8_LDB(B0, 0, 0); PG8_LDB(B1, 0, 1); PG8_SCHED; PG8_LDA(At, 0, 0); PG8_STAGE(PG8_SA(1, 1), a1 + hstepA, voffA[1]);
            if (last && has_next) { PG8_SETA(nxt); }
            PG8_WAIT_V(8); PG8_WAIT_L(0); PG8_BAR; PG8_MMA(0, 0, At, B0); PG8_MMA(0, 1, At, B1); PG8_BAR; PG8_SCHED;
            PG8_LDA(At, 0, 1); PG8_STAGE(PG8_SB(0, 0), b2, voffB); PG8_STAGE(PG8_SB(0, 1), b2 + hstepB, voffB); PG8_STAGE(PG8_SA(0, 0), a2, voffA[0]);
            PG8_WAIT_V(8); PG8_WAIT_L(0); PG8_BAR; PG8_MMA(1, 0, At, B0); PG8_MMA(1, 1, At, B1); PG8_BAR; PG8_SCHED;
            PG8_LDB(B0, 1, 0); PG8_LDB(B1, 1, 1); PG8_SCHED; PG8_LDA(At, 1, 0); PG8_STAGE(PG8_SA(0, 1), a2 + hstepA, voffA[1]);
            PG8_WAIT_V(8); PG8_WAIT_L(0); PG8_BAR; PG8_MMA(0, 0, At, B0); PG8_MMA(0, 1, At, B1); PG8_BAR; PG8_SCHED;
            PG8_LDA(At, 1, 1); PG8_STAGE(PG8_SB(1, 0), b3, voffB); PG8_STAGE(PG8_SB(1, 1), b3 + hstepB, voffB); PG8_STAGE(PG8_SA(1, 0), a3, voffA[0]);
            PG8_WAIT_V(8); PG8_WAIT_L(0); PG8_BAR; PG8_MMA(1, 0, At, B0); PG8_MMA(1, 1, At, B1); PG8_BAR; PG8_SCHED;
        }
        if (wr == 0) PG8_BAR;
        E(acc, cur, wr, wc, fr, fq);
        if (!has_next) break;
#pragma unroll
        for (int a = 0; a < 2; ++a)
#pragma unroll
            for (int b = 0; b < 2; ++b)
#pragma unroll
                for (int m = 0; m < 4; ++m)
#pragma unroll
                    for (int n = 0; n < 2; ++n) acc[a][b][m][n] = (f32x4){0.f, 0.f, 0.f, 0.f};
        cur = nxt; cA = nA; cB = nB; ++ui;
        if (wr == 1) PG8_BAR;
    }
    PG8_WAIT_V(0);
    PG8_BAR;
#undef PG8_SA
#undef PG8_SB
#undef PG8_STAGE
#undef PG8_LDA
#undef PG8_LDB
#undef PG8_MMA
#undef PG8_WAIT_V
#undef PG8_WAIT_L
#undef PG8_BAR
#undef PG8_SCHED
#undef PG8_SETA
#undef PG8_ABASE
}

struct GridOrder {
    int nM, nN, nwg, G, c, arow0, acol, brow0;
    __device__ void init(int nM_, int nN_, int G_, int c_, int arow0_ = 0, int acol_ = 0, int brow0_ = 0) { nM = nM_; nN = nN_; nwg = nM * nN; G = G_; c = c_; arow0 = arow0_; acol = acol_; brow0 = brow0_; }
    __device__ __forceinline__ bool next(int i, Unit& u) const {
        const long L = (long)i * G + c; if (L >= nwg) return false;
        int wgid = (int)L; { const int q = nwg / NXCD, r = nwg % NXCD, xcd = wgid % NXCD, off = wgid / NXCD; wgid = (xcd < r ? xcd * (q + 1) : r * (q + 1) + (xcd - r) * q) + off; }
        const int nig = WGM * nN, gid = wgid / nig, fm = gid * WGM, gsz = (nM - fm) < WGM ? (nM - fm) : WGM;
        u.pm = fm + ((wgid % nig) % gsz); u.pn = (wgid % nig) / gsz;
        u.arow = arow0 + u.pm * BM; u.acol = acol; u.brow = brow0 + u.pn * BM; u.aux = 0; u.gcnt = 0; u.gl = nullptr; return true;
    }
};
struct BranchOrder {
    int G, c;
    __device__ __forceinline__ bool next(int i, Unit& u) const {
        const int tile = (i >> 2) * G + c, b = i & 3; if (tile >= 256) return false;
        u.pm = tile >> 2; u.pn = tile & 3; u.arow = u.pm * BM; u.acol = b * 512; u.brow = b * 1024 + u.pn * BM; u.aux = b; u.gcnt = 0; u.gl = nullptr; return true;
    }
};
struct MoeOrder {
    const LAS int* tab; int G, c, nct, brows; const int* elist; const unsigned* ecnt;
    __device__ __forceinline__ bool next(int i, Unit& u) const {
        const int L = i * G + c, nrt = tab[0]; if (L >= nrt * nct) return false;
        const int j = L / nct, ct = L % nct; const int e = tab[16 + 4 * j], rt = tab[16 + 4 * j + 1], st = tab[16 + 4 * j + 2];
        u.pm = st; u.pn = ct; u.arow = st * BM; u.acol = 0; u.brow = e * brows + ct * BM; u.aux = e;
        const int cnt = (int)ecnt[64 * e]; u.gcnt = cnt - rt * BM; u.gl = elist + e * 16384 + rt * BM; return true;
    }
};

template <int ACT  > struct EpiBf16 {
    static constexpr bool PERM = true;
    bf16* O; int ldc;
    __device__ __forceinline__ void operator()(const f32x4 (&acc)[2][2][4][2], const Unit& u, int wr, int wc, int fr, int fq) const {
        const int row0 = u.pm * BM + wr * 64 + fr, col0 = u.pn * BM + wc * 32 + 8 * fq;
#pragma unroll
        for (int ai = 0; ai < 2; ++ai)
#pragma unroll
            for (int m = 0; m < 4; ++m) { bf16* rowp = O + (size_t)(row0 + ai * HALF + m * 16) * ldc + col0;
#pragma unroll
                for (int bj = 0; bj < 2; ++bj) { f32x4 v0 = acc[ai][bj][m][0], v1 = acc[ai][bj][m][1];
                    if (ACT == 1) {
#pragma unroll
                        for (int j = 0; j < 4; ++j) { v0[j] = sigmoidf_(v0[j]); v1[j] = sigmoidf_(v1[j]); } }
                    u32x4 w; w.x = cvt_pk_bf16(v0[0], v0[1]); w.y = cvt_pk_bf16(v0[2], v0[3]); w.z = cvt_pk_bf16(v1[0], v1[1]); w.w = cvt_pk_bf16(v1[2], v1[3]);
                    *(u32x4*)(rowp + bj * HALF) = w; } }
    }
};
struct EpiGateAcc {
    static constexpr bool PERM = true;
    const bf16* Gt; bf16* Mg;
    __device__ __forceinline__ void operator()(const f32x4 (&acc)[2][2][4][2], const Unit& u, int wr, int wc, int fr, int fq) const {
        const int row0 = u.pm * BM + wr * 64 + fr, col0 = u.pn * BM + wc * 32 + 8 * fq, b = u.aux;
#pragma unroll
        for (int ai = 0; ai < 2; ++ai)
#pragma unroll
            for (int m = 0; m < 4; ++m) { const size_t r = (size_t)(row0 + ai * HALF + m * 16);
#pragma unroll
                for (int bj = 0; bj < 2; ++bj) {
                    const u32x4 gw = *(const u32x4*)(Gt + r * 4096 + b * 1024 + col0 + bj * HALF);
                    bf16* mp = Mg + r * 1024 + col0 + bj * HALF;
                    u32x4 ow = (u32x4){0u, 0u, 0u, 0u}; if (b != 0) ow = *(const u32x4*)mp;
                    const f32x4 v0 = acc[ai][bj][m][0], v1 = acc[ai][bj][m][1];
                    u32x4 w;
                    w.x = cvt_pk_bf16(bflo(ow.x) + bflo(gw.x) * v0[0], bfhi(ow.x) + bfhi(gw.x) * v0[1]);
                    w.y = cvt_pk_bf16(bflo(ow.y) + bflo(gw.y) * v0[2], bfhi(ow.y) + bfhi(gw.y) * v0[3]);
                    w.z = cvt_pk_bf16(bflo(ow.z) + bflo(gw.z) * v1[0], bfhi(ow.z) + bfhi(gw.z) * v1[1]);
                    w.w = cvt_pk_bf16(bflo(ow.w) + bflo(gw.w) * v1[2], bfhi(ow.w) + bfhi(gw.w) * v1[3]);
                    *(u32x4*)mp = w; }
                asm volatile("" ::: "memory"); }
    }
};
struct EpiResF32 {
    static constexpr bool PERM = false;
    const float* base; float* out; int ldc;
    __device__ __forceinline__ void operator()(const f32x4 (&acc)[2][2][4][2], const Unit& u, int wr, int wc, int fr, int fq) const {
        const int row0 = u.pm * BM + wr * 64 + fr, col0 = u.pn * BM + wc * 32 + 4 * fq;
#pragma unroll
        for (int ai = 0; ai < 2; ++ai)
#pragma unroll
            for (int m = 0; m < 4; ++m) { const size_t off = (size_t)(row0 + ai * HALF + m * 16) * ldc + col0;
#pragma unroll
                for (int bj = 0; bj < 2; ++bj)
#pragma unroll
                    for (int n = 0; n < 2; ++n) { const f32x4 bs = *(const f32x4*)(base + off + bj * HALF + n * 16); *(f32x4*)(out + off + bj * HALF + n * 16) = bs + acc[ai][bj][m][n]; }
                if (m & 1) asm volatile("" ::: "memory"); }
    }
};
struct EpiSwiGlu {
    static constexpr bool PERM = true;
    bf16* Hd;
    __device__ __forceinline__ void operator()(const f32x4 (&acc)[2][2][4][2], const Unit& u, int wr, int wc, int fr, int fq) const {
        const int row0 = u.pm * BM + wr * 64 + fr, col0 = u.pn * HALF + wc * 32 + 8 * fq;
#pragma unroll
        for (int ai = 0; ai < 2; ++ai)
#pragma unroll
            for (int m = 0; m < 4; ++m) { bf16* rowp = Hd + (size_t)(row0 + ai * HALF + m * 16) * DEXP + col0;
                f32x4 o0, o1;
#pragma unroll
                for (int j = 0; j < 4; ++j) { const float a0 = acc[ai][0][m][0][j], a1 = acc[ai][0][m][1][j];
                    o0[j] = a0 * sigmoidf_(a0) * acc[ai][1][m][0][j]; o1[j] = a1 * sigmoidf_(a1) * acc[ai][1][m][1][j]; }
                u32x4 w; w.x = cvt_pk_bf16(o0[0], o0[1]); w.y = cvt_pk_bf16(o0[2], o0[3]); w.z = cvt_pk_bf16(o1[0], o1[1]); w.w = cvt_pk_bf16(o1[2], o1[3]);
                *(u32x4*)rowp = w; }
    }
};
}

#define XB_TMO      128
#define XB_XCNT(j)  (256  + 64 * (j))
#define XB_XSUB(j)  (1280 + 64 * (j))
#define XB_XGEN(j)  (2304 + 64 * (j))
#define XB_TOP      3328
#define XB_TOPGEN   3392
#define XCD_BAR_WORDS 3456
#define XB_SPIN_CAP (1u << 20)
__device__ __forceinline__ unsigned xb_ld(unsigned* p)              { return __hip_atomic_load(p, __ATOMIC_RELAXED, __HIP_MEMORY_SCOPE_AGENT); }
__device__ __forceinline__ unsigned xb_add(unsigned* p, unsigned v) { return __hip_atomic_fetch_add(p, v, __ATOMIC_RELAXED, __HIP_MEMORY_SCOPE_AGENT); }
__device__ __forceinline__ unsigned xb_xcc_id() { return (unsigned)__builtin_amdgcn_s_getreg((3 << 11) | 20) & 0xFu; }
#define XB_SPIN(cond, bar) do { unsigned _sp = 0; while (cond) { __builtin_amdgcn_s_sleep(1); \
    if ((++_sp & 255u) == 0u) { if (xb_ld(&(bar)[XB_TMO])) break; if (_sp > XB_SPIN_CAP) { atomicAdd(&(bar)[XB_TMO], 1u); break; } } } } while (0)
struct XcdBarrier { unsigned* bar; unsigned x; volatile LAS unsigned* st; };
__device__ __forceinline__ XcdBarrier xcd_barrier_post(unsigned* bar, volatile LAS unsigned* st) {
    XcdBarrier b; b.bar = bar; b.x = xb_xcc_id(); b.st = st;
    if (threadIdx.x == 0) (void)xb_add(&bar[XB_XCNT(b.x)], 1u);
    return b;
}
__device__ __forceinline__ void xcd_barrier_complete(unsigned* bar, unsigned x, unsigned& nloc, unsigned& nx) {
    const unsigned G = gridDim.x * gridDim.y * gridDim.z;
    unsigned sum, cnt, mine, sp = 0u;
    for (;;) {
        sum = 0u; cnt = 0u; mine = 0u;
#pragma unroll
        for (unsigned j = 0; j < 16; ++j) { const unsigned c = xb_ld(&bar[XB_XCNT(j)]); sum += c; cnt += (c > 0u) ? 1u : 0u; mine = (j == x) ? c : mine; }
        if (sum == G) break;
        __builtin_amdgcn_s_sleep(1);
        if ((++sp & 255u) == 0u) { if (xb_ld(&bar[XB_TMO])) break; if (sp > XB_SPIN_CAP) { atomicAdd(&bar[XB_TMO], 1u); break; } }
    }
    nloc = mine > 0u ? mine : 1u; nx = cnt > 0u ? cnt : 1u;
}
__device__ __forceinline__ void xcd_barrier(const XcdBarrier& b) {
    asm volatile("s_waitcnt vmcnt(0)" ::: "memory");
    __syncthreads();
    if (threadIdx.x == 0) {
        unsigned* bar = b.bar;
        __builtin_amdgcn_s_waitcnt(0);
        unsigned nloc = b.st[0], nx = b.st[1];
        if (nloc == 0u) { xcd_barrier_complete(bar, b.x, nloc, nx); b.st[0] = nloc; b.st[1] = nx; }
        const unsigned old = xb_add(&bar[XB_XSUB(b.x)], 1u);
        const unsigned gen = old / nloc;
        if (old + 1u == (gen + 1u) * nloc) {
            __builtin_amdgcn_fence(__ATOMIC_RELEASE, "agent");
            asm volatile("s_waitcnt vmcnt(0)" ::: "memory");
            const unsigned og = xb_add(&bar[XB_TOP], 1u);
            const unsigned tg = og / nx;
            if (og + 1u == (tg + 1u) * nx) xb_add(&bar[XB_TOPGEN], 1u);
            else XB_SPIN(xb_ld(&bar[XB_TOPGEN]) == tg, bar);
            __builtin_amdgcn_fence(__ATOMIC_ACQUIRE, "agent");
            xb_add(&bar[XB_XGEN(b.x)], 1u);
            asm volatile("s_waitcnt vmcnt(0)" ::: "memory");
        } else {
            XB_SPIN(xb_ld(&bar[XB_XGEN(b.x)]) == gen, bar);
            __builtin_amdgcn_fence(__ATOMIC_ACQUIRE, "agent");
            asm volatile("s_waitcnt vmcnt(0)" ::: "memory");
        }
    }
    __syncthreads();
}

struct Args {
    const float* in[31]; float* out; unsigned char* ws; int ph_lo, ph_hi;
};
enum InIdx { I_X = 0, I_MEM, I_NORM_MIX, I_W_IN, I_CONV_W, I_CONV_B, I_LRU_WA, I_LRU_BA, I_LRU_WX, I_LRU_BX, I_LRU_LAMBDA, I_CA_REL, I_DIFF_LAMBDA, I_DIFF_SUBLN,
             I_W_BRANCH, I_W_OUT, I_NORM_MEM, I_MEM_NORM, I_W_MQ, I_W_MK, I_W_MV, I_W_MO, I_NORM_FFN, I_W_GROUP, I_B_GROUP, I_W_ROUTER, I_B_ROUTER, I_W1, I_W3, I_W2, I_FINAL_NORM };

__device__ __forceinline__ void transpose_item(const float* W, int K, int N, bf16* WT, int row_off, LAS float* scr, int item, int lane, float sc = 1.0f) {
    const int nblk = N / 32, kb = item / nblk, nb = item % nblk, k0 = 64 * kb, n0 = 32 * nb;
#pragma unroll 8
    for (int i = 0; i < 32; ++i) { const int kk = 2 * i + (lane >> 5); scr[kk * 33 + (lane & 31)] = W[(size_t)(k0 + kk) * N + n0 + (lane & 31)] * sc; }
    LDS_WAIT(); asm volatile("" ::: "memory");
    const int c = lane & 7;
#pragma unroll
    for (int j = 0; j < 4; ++j) { const int n = (lane >> 3) + 8 * j; const LAS float* s = scr + (8 * c) * 33 + n;
        u32x4 o; o.x = pk2(s[0 * 33], s[1 * 33]); o.y = pk2(s[2 * 33], s[3 * 33]); o.z = pk2(s[4 * 33], s[5 * 33]); o.w = pk2(s[6 * 33], s[7 * 33]);
        *(u32x4*)(WT + (size_t)(row_off + n0 + n) * K + k0 + 8 * c) = o; }
    LDS_WAIT(); asm volatile("" ::: "memory");
}
__device__ __forceinline__ void rms_row_to_bf16(const float* xrow, const float* g, bf16* orow, int lane) {
    const f32x4* xr = (const f32x4*)xrow + lane; const f32x4* gr = (const f32x4*)g + lane;
    f32x4 v[4]; float s = 0.f;
#pragma unroll
    for (int j = 0; j < 4; ++j) { v[j] = xr[64 * j]; s += (v[j].x * v[j].x + v[j].y * v[j].y) + (v[j].z * v[j].z + v[j].w * v[j].w); }
    const float rstd = 1.f / sqrtf(wave_sum(s) * (1.f / D) + NORM_EPS);
    unsigned long long* o8 = (unsigned long long*)orow + lane;
#pragma unroll
    for (int j = 0; j < 4; ++j) { const f32x4 gg = gr[64 * j];
        o8[64 * j] = (unsigned long long)pk2(v[j].x * rstd * gg.x, v[j].y * rstd * gg.y) | ((unsigned long long)pk2(v[j].z * rstd * gg.z, v[j].w * rstd * gg.w) << 32); }
}
__device__ __forceinline__ void convert_experts(const float* w1, const float* w3, const float* w2, bf16* W13, bf16* W2T, LAS float* scr, int gw, int NGW, int lane) {
    constexpr int I_13 = (D / 64) * (DEXP / 32);
    constexpr int I_2 = (DEXP / 64) * (D / 32);
    for (int it = gw; it < NEXP * (2 * I_13 + I_2); it += NGW) {
        const int e = it / (2 * I_13 + I_2); int r = it % (2 * I_13 + I_2);
        if (r < 2 * I_13) { const int which = r / I_13; r %= I_13; const int nb = r % (DEXP / 32), n0 = nb * 32;
            const int row_off = (n0 / 128) * 256 + which * 128 + (n0 % 128) - n0;
            transpose_item((which ? w3 : w1) + (size_t)e * D * DEXP, D, DEXP, W13 + (size_t)e * 1024 * 1024, row_off, scr, r, lane); }
        else { r -= 2 * I_13; transpose_item(w2 + (size_t)e * DEXP * D, DEXP, D, W2T + (size_t)e * 1024 * 512, 0, scr, r, lane); }
    }
}

namespace att {
typedef short v4i16_t __attribute__((ext_vector_type(4)));
__device__ __forceinline__ s16x4 vtr(const LAS char* p) { return __builtin_bit_cast(s16x4, __builtin_amdgcn_ds_read_tr16_b64_v4i16((LAS v4i16_t*)p)); }
__device__ __forceinline__ int crow(int r, int hi) { return (r & 3) + 8 * (r >> 2) + 4 * hi; }
__device__ __forceinline__ float xmax(float v) { auto rr = __builtin_amdgcn_permlane32_swap(__float_as_uint(v), __float_as_uint(v), false, false); return fmaxf(__uint_as_float(rr[0]), __uint_as_float(rr[1])); }
__device__ __forceinline__ float xsum(float v) { auto rr = __builtin_amdgcn_permlane32_swap(__float_as_uint(v), __float_as_uint(v), false, false); return __uint_as_float(rr[0]) + __uint_as_float(rr[1]); }
__device__ __forceinline__ bf16x8 vfrag(const LAS char* p) { const s16x4 lo = vtr(p), hi = vtr(p + 512); return (bf16x8){lo[0], lo[1], lo[2], lo[3], hi[0], hi[1], hi[2], hi[3]}; }
__device__ __forceinline__ int vbase(int lane) { const int hi = lane >> 5; return ((lane >> 4) & 1) * 32 + (lane & 3) * 8 + (4 * hi + ((lane & 15) >> 2)) * 64; }
__device__ __forceinline__ bf16x8 pack8(const f32x16& p, int r0) {
    u32x4 w; w.x = cvt_pk_bf16(p[r0], p[r0 + 1]); w.y = cvt_pk_bf16(p[r0 + 2], p[r0 + 3]); w.z = cvt_pk_bf16(p[r0 + 4], p[r0 + 5]); w.w = cvt_pk_bf16(p[r0 + 6], p[r0 + 7]);
    return __builtin_bit_cast(bf16x8, w);
}

struct AttnP {
    const bf16* Q; const bf16* K; const bf16* V; bf16* O; int ldq, ldk, ldv, ldo;
    int q0;
    int t_begin, t_end;
    float slope2;
    int dmax;
    const LAS float* tab;
    float* lse;
};
template <int DQK, int DV, int MODE> struct Lay { static constexpr int KCH = DQK / 8 + (MODE == 2 ? 1 : 0), KB = KCH * 1024, VB = DV * 128, K0 = 0, V0 = 2 * KB, WSF = V0 + 2 * VB, END = WSF + 8 * 64 * 4; };

template <int DQK, int DV, int MODE>
__device__ __forceinline__ void attn_unit(LAS char* lds, const AttnP& P, const int tid) {
    typedef Lay<DQK, DV, MODE> L;
    constexpr int NKP = DQK / 64, NVP = DV / 64, NQ0 = DQK / 16, ND0 = NQ0 + (MODE == 2 ? 1 : 0), NDB = DV / 32;
    const int lane = tid & 63, r32 = lane & 31, hi = lane >> 5; const int wid = __builtin_amdgcn_readfirstlane(tid >> 6);
    const int qrow0 = P.q0 + 32 * wid;
    const int cq = qrow0 >> 6;
    int wlo = P.t_begin, whi = P.t_end - 1;
    if (MODE == 1) { wlo = cq - 8 < 0 ? 0 : cq - 8; whi = cq; }
    if (MODE == 2) { const int a = qrow0 - P.dmax; wlo = a > 0 ? (a >> 6) : 0; if (wlo < P.t_begin) wlo = P.t_begin; whi = cq; }
    LAS float* wsf = (LAS float*)(lds + L::WSF) + wid * 64;
    bf16x8 qr[ND0];
#pragma unroll
    for (int d0 = 0; d0 < NQ0; ++d0) qr[d0] = *(const bf16x8*)(P.Q + (size_t)(qrow0 + r32) * P.ldq + d0 * 16 + hi * 8);
    if (MODE == 2) { const u32x4 one = (u32x4){hi == 0 ? 0x3f803f80u : 0u, 0u, 0u, 0u}; qr[ND0 - 1] = __builtin_bit_cast(bf16x8, one);
        if (tid < 128) { const int b = tid >> 6, key = tid & 63; const float bv = P.slope2 * (float)key; const unsigned bh = f2bf(bv); const unsigned bl = f2bf(bv - bflo(bh));
            *(LAS u32x4*)(lds + L::K0 + b * L::KB + 8 * 1024 + key * 16) = (u32x4){bh | (bl << 16), 0u, 0u, 0u}; } }
    f32x16 o[NDB];
#pragma unroll
    for (int db = 0; db < NDB; ++db) o[db] = (f32x16){};
    float mrun = 0.f, lrun = 0.f; bool first = true;
    const int qpos = qrow0 + r32;
    u32x4 kreg[NKP], vreg[NVP];
#define ATT_LOAD(t) do { _Pragma("unroll") for (int i_ = 0; i_ < NKP; ++i_) kreg[i_] = *(const u32x4*)(P.K + (size_t)(64 * (t) + lane) * P.ldk + (wid + 8 * i_) * 8); \
        _Pragma("unroll") for (int i_ = 0; i_ < NVP; ++i_) { const int p_ = wid + 8 * i_, db_ = p_ >> 2, rg_ = p_ & 3; \
            vreg[i_] = *(const u32x4*)(P.V + (size_t)(64 * (t) + 16 * rg_ + (lane >> 2)) * P.ldv + 32 * db_ + (lane & 3) * 8); } } while (0)
#define ATT_STORE(buf) do { _Pragma("unroll") for (int i_ = 0; i_ < NKP; ++i_) *(LAS u32x4*)(lds + L::K0 + (buf) * L::KB + (wid + 8 * i_) * 1024 + lane * 16) = kreg[i_]; \
        _Pragma("unroll") for (int i_ = 0; i_ < NVP; ++i_) *(LAS u32x4*)(lds + L::V0 + (buf) * L::VB + (wid + 8 * i_) * 1024 + lane * 16) = vreg[i_]; } while (0)
    ATT_LOAD(P.t_begin); ATT_STORE(0);
    __syncthreads();
    const int vb = vbase(lane);
    for (int t = P.t_begin; t < P.t_end; ++t) {
        const int buf = (t - P.t_begin) & 1;
        if (t + 1 < P.t_end) ATT_LOAD(t + 1);
        if (t >= wlo && t <= whi) {
            const LAS char* kp = lds + L::K0 + buf * L::KB + hi * 1024 + r32 * 16;
            const int jrel = t - (cq - 8);
            float cin = -mrun;
            if (MODE == 1) { if (jrel <= 5) cin += P.tab[256]; }
            if (MODE == 2) cin += P.slope2 * (float)(64 * t - qpos);
            f32x16 p0, p1;
#pragma unroll
            for (int r = 0; r < 16; ++r) { p0[r] = cin; p1[r] = cin; }
#pragma unroll
            for (int d0 = 0; d0 < ND0; ++d0) {
                const LAS char* kq = (MODE == 2 && d0 == ND0 - 1) ? kp - hi * 1024 : kp;
                const bf16x8 b0 = *(const LAS bf16x8*)(kq + d0 * 2048), b1 = *(const LAS bf16x8*)(kq + d0 * 2048 + 512);
                p0 = __builtin_amdgcn_mfma_f32_32x32x16_bf16(b0, qr[d0], p0, 0, 0, 0);
                p1 = __builtin_amdgcn_mfma_f32_32x32x16_bf16(b1, qr[d0], p1, 0, 0, 0);
            }
            if (MODE == 1) { if (jrel > 5) {
                    const int dbase = qpos - 64 * t - 4 * hi;
#pragma unroll
                    for (int r = 0; r < 16; ++r) { const int d0_ = dbase - ((r & 3) + 8 * (r >> 2)), d1_ = d0_ - 32;
                        const int i0 = (d0_ < -128 ? -128 : (d0_ > 128 ? 128 : d0_)) + 128, i1 = (d1_ < -128 ? -128 : (d1_ > 128 ? 128 : d1_)) + 128;
                        p0[r] += P.tab[i0]; p1[r] += P.tab[i1]; } } }
            if (MODE == 2) { if (t == cq) {
                    const float xb = (float)(64 * t + 4 * hi - qpos), s2 = -2.0f * P.slope2;
#pragma unroll
                    for (int r = 0; r < 16; ++r) { const float x0 = xb + (float)((r & 3) + 8 * (r >> 2)), x1 = x0 + 32.f;
                        p0[r] = fmaf(s2, fmaxf(x0, 0.f), p0[r]); p1[r] = fmaf(s2, fmaxf(x1, 0.f), p1[r]); } } }
            float rm = fmaxf(p0[0], p1[0]);
#pragma unroll
            for (int r = 1; r < 16; ++r) rm = fmaxf(rm, fmaxf(p0[r], p1[r]));
            rm = xmax(rm);
            if (first || __any(rm > 8.f)) {
                const float dl = first ? rm : fmaxf(rm, 0.f), al = first ? 0.f : fexp2(-dl); mrun += dl; lrun *= al; first = false;
#pragma unroll
                for (int r = 0; r < 16; ++r) { p0[r] -= dl; p1[r] -= dl; }
                if (hi == 0) wsf[r32] = al;
                LDS_WAIT();
#pragma unroll
                for (int r = 0; r < 16; ++r) { const float a = wsf[crow(r, hi)];
#pragma unroll
                    for (int db = 0; db < NDB; ++db) o[db][r] *= a; }
            }
            float ls = 0.f;
#pragma unroll
            for (int r = 0; r < 16; ++r) { p0[r] = fexp2(p0[r]); p1[r] = fexp2(p1[r]); ls += p0[r] + p1[r]; }
            lrun += ls;
            const bf16x8 pw0 = pack8(p0, 0), pw1 = pack8(p0, 8), pw2 = pack8(p1, 0), pw3 = pack8(p1, 8);
            const LAS char* vp = lds + L::V0 + buf * L::VB + vb;
#pragma unroll
            for (int db = 0; db < NDB; ++db) {
                o[db] = __builtin_amdgcn_mfma_f32_32x32x16_bf16(pw0, vfrag(vp + db * 4096 + 0 * 1024), o[db], 0, 0, 0);
                o[db] = __builtin_amdgcn_mfma_f32_32x32x16_bf16(pw1, vfrag(vp + db * 4096 + 1 * 1024), o[db], 0, 0, 0);
                o[db] = __builtin_amdgcn_mfma_f32_32x32x16_bf16(pw2, vfrag(vp + db * 4096 + 2 * 1024), o[db], 0, 0, 0);
                o[db] = __builtin_amdgcn_mfma_f32_32x32x16_bf16(pw3, vfrag(vp + db * 4096 + 3 * 1024), o[db], 0, 0, 0);
                __builtin_amdgcn_sched_barrier(0);
            }
        }
        if (t + 1 < P.t_end) ATT_STORE(buf ^ 1);
        __syncthreads();
    }
#undef ATT_LOAD
#undef ATT_STORE
    const float lt = xsum(lrun);
    if (hi == 0) wsf[r32] = lt > 0.f ? 1.0f / lt : 0.f;
    if (MODE == 2) { if (hi == 0) P.lse[(size_t)(qrow0 + r32) * 8] = lt > 0.f ? mrun + log2f(lt) : -1.0e30f; }
    LDS_WAIT();
#pragma unroll
    for (int r = 0; r < 16; ++r) { const int qr_ = crow(r, hi); const float inv = wsf[qr_];
        bf16* orow = P.O + (size_t)(qrow0 + qr_) * P.ldo + r32;
#pragma unroll
        for (int db = 0; db < NDB; ++db) orow[db * 32] = (bf16)f2bf(o[db][r] * inv); }
    LDS_WAIT();
}
}

namespace ret {
using att::crow; using att::vfrag; using att::vbase; using att::pack8; using att::xsum;
__device__ __forceinline__ float gamma_log2(int h) { return log2f(1.0f - exp2f(-5.0f - (float)h)); }
template <bool SCALE>
__device__ __forceinline__ void stage_tile(LAS char* dst, const bf16* src, int ld, int lane, float lg2, float mul) {
#pragma unroll
    for (int p = 0; p < 8; ++p) { const int db = p >> 2, rg = p & 3, row = 16 * rg + (lane >> 2), col = 32 * db + (lane & 3) * 8;
        u32x4 v = *(const u32x4*)(src + (size_t)row * ld + col);
        if (SCALE) { const float s = fexp2(lg2 * (float)(63 - row)) * mul;
            v.x = cvt_pk_bf16(bflo(v.x) * s, bfhi(v.x) * s); v.y = cvt_pk_bf16(bflo(v.y) * s, bfhi(v.y) * s); v.z = cvt_pk_bf16(bflo(v.z) * s, bfhi(v.z) * s); v.w = cvt_pk_bf16(bflo(v.w) * s, bfhi(v.w) * s); }
        *(LAS u32x4*)(dst + p * 1024 + lane * 16) = v; }
}
__device__ __forceinline__ void kv_unit(LAS char* wl, const bf16* z, float* kvT, int c, int h, int lane) {
    const int hi = lane >> 5, r32 = lane & 31;
    const bf16* kp = z + (size_t)(c * CHUNK) * ZC + Z_CK + h * 64; const bf16* vp = z + (size_t)(c * CHUNK) * ZC + Z_CV + h * 64;
    stage_tile<true>(wl, kp, ZC, lane, gamma_log2(h), 0.125f);
    stage_tile<false>(wl + 8192, vp, ZC, lane, 0.f, 1.f);
    LDS_WAIT();
    const int vb = vbase(lane);
    f32x16 acc[2][2];
#pragma unroll
    for (int dt = 0; dt < 2; ++dt)
#pragma unroll
        for (int et = 0; et < 2; ++et) { acc[dt][et] = (f32x16){};
#pragma unroll
            for (int ks = 0; ks < 4; ++ks) acc[dt][et] = __builtin_amdgcn_mfma_f32_32x32x16_bf16(vfrag(wl + vb + dt * 4096 + ks * 1024), vfrag(wl + 8192 + vb + et * 4096 + ks * 1024), acc[dt][et], 0, 0, 0); }
    float* ob = kvT + ((size_t)(c * 8 + h) * 64) * 64;
#pragma unroll
    for (int dt = 0; dt < 2; ++dt)
#pragma unroll
        for (int et = 0; et < 2; ++et)
#pragma unroll
            for (int g4 = 0; g4 < 4; ++g4)
                *(f32x4*)(ob + (size_t)(32 * et + r32) * 64 + 32 * dt + 8 * g4 + 4 * hi) = (f32x4){acc[dt][et][4 * g4], acc[dt][et][4 * g4 + 1], acc[dt][et][4 * g4 + 2], acc[dt][et][4 * g4 + 3]};
    LDS_WAIT();
}
__device__ __forceinline__ void out_unit(LAS char* wl, const bf16* z, const bf16* rT, bf16* y, int c, int h, int lane) {
    const int hi = lane >> 5, r32 = lane & 31;
    const size_t row0 = (size_t)c * CHUNK;
    const bf16* qp = z + row0 * ZC + Z_CQ + h * 64; const bf16* kp = z + row0 * ZC + Z_CK + h * 64; const bf16* vp = z + row0 * ZC + Z_CV + h * 64; const bf16* gp = z + row0 * ZC + Z_CG + h * 64;
    const bf16* rp = rT + ((size_t)(c * 8 + h) * 64) * 64;
    stage_tile<false>(wl, vp, ZC, lane, 0.f, 1.f);
    const float lg2 = gamma_log2(h);
    LDS_WAIT();
    const int vb = vbase(lane);
    bf16* yo = y + row0 * YC + 1024 + h * 64;
#pragma unroll 1
    for (int nt = 0; nt < 2; ++nt) {
        const int i = 32 * nt + r32;
        bf16x8 qf[4];
#pragma unroll
        for (int s = 0; s < 4; ++s) qf[s] = *(const bf16x8*)(qp + (size_t)i * ZC + 16 * s + 8 * hi);
        f32x16 oT[2], cr[2];
#pragma unroll
        for (int et = 0; et < 2; ++et) { oT[et] = (f32x16){}; cr[et] = (f32x16){};
#pragma unroll
            for (int s = 0; s < 4; ++s) cr[et] = __builtin_amdgcn_mfma_f32_32x32x16_bf16(*(const bf16x8*)(rp + (size_t)(32 * et + r32) * 64 + 16 * s + 8 * hi), qf[s], cr[et], 0, 0, 0); }
#pragma unroll
        for (int mt = 0; mt < 2; ++mt) {
            f32x16 st = (f32x16){};
#pragma unroll
            for (int s = 0; s < 4; ++s) st = __builtin_amdgcn_mfma_f32_32x32x16_bf16(*(const bf16x8*)(kp + (size_t)(32 * mt + r32) * ZC + 16 * s + 8 * hi), qf[s], st, 0, 0, 0);
#pragma unroll
            for (int r = 0; r < 16; ++r) { const int j = 32 * mt + crow(r, hi); const float w = (i >= j) ? fexp2(lg2 * (float)(i - j)) * 0.125f : 0.f; st[r] *= w; }
            const bf16x8 pA = pack8(st, 0), pB = pack8(st, 8);
#pragma unroll
            for (int et = 0; et < 2; ++et) {
                oT[et] = __builtin_amdgcn_mfma_f32_32x32x16_bf16(vfrag(wl + vb + et * 4096 + (2 * mt) * 1024), pA, oT[et], 0, 0, 0);
                oT[et] = __builtin_amdgcn_mfma_f32_32x32x16_bf16(vfrag(wl + vb + et * 4096 + (2 * mt + 1) * 1024), pB, oT[et], 0, 0, 0); }
        }
        const float xi = fexp2(lg2 * (float)(i + 1));
        float s1 = 0.f;
#pragma unroll
        for (int et = 0; et < 2; ++et)
#pragma unroll
            for (int r = 0; r < 16; ++r) { oT[et][r] = fmaf(xi, cr[et][r], oT[et][r]); s1 += oT[et][r]; }
        const float mean = xsum(s1) * (1.f / 64.f);
        float s2 = 0.f;
#pragma unroll
        for (int et = 0; et < 2; ++et)
#pragma unroll
            for (int r = 0; r < 16; ++r) { oT[et][r] -= mean; s2 += oT[et][r] * oT[et][r]; }
        const float rstd = 1.0f / sqrtf(xsum(s2) * (1.f / 64.f) + GN_EPS);
#pragma unroll
        for (int et = 0; et < 2; ++et)
#pragma unroll
            for (int g4 = 0; g4 < 4; ++g4) { const int e = 32 * et + 8 * g4 + 4 * hi;
                const u32x2 gw = *(const u32x2*)(gp + (size_t)i * ZC + e);
                const float g0 = bflo(gw.x), g1 = bfhi(gw.x), g2 = bflo(gw.y), g3 = bfhi(gw.y);
                u32x2 w; w.x = cvt_pk_bf16(g0 * sigmoidf_(g0) * oT[et][4 * g4] * rstd, g1 * sigmoidf_(g1) * oT[et][4 * g4 + 1] * rstd);
                w.y = cvt_pk_bf16(g2 * sigmoidf_(g2) * oT[et][4 * g4 + 2] * rstd, g3 * sigmoidf_(g3) * oT[et][4 * g4 + 3] * rstd);
                *(u32x2*)(yo + (size_t)i * YC + e) = w; }
    }
    LDS_WAIT();
}
}

namespace lru {
struct LruP { const bf16* z; const float *conv_w, *conv_b, *wa, *ba, *wx, *bx, *lam; float *carA, *carH; const float* carI; bf16* y; };
constexpr int XS = 144;
template <bool FINAL>
__device__ __forceinline__ void unit(LAS char* wl, const LruP& P, int seg, int k, int lane) {
    const int r32 = lane & 31, hi = lane >> 5;
    LAS float* tb = (LAS float*)(wl + 5120);
    { const int ch = k * 64 + lane;
      tb[0 * 64 + lane] = P.conv_w[ch]; tb[1 * 64 + lane] = P.conv_w[512 + ch]; tb[2 * 64 + lane] = P.conv_w[1024 + ch]; tb[3 * 64 + lane] = P.conv_w[1536 + ch];
      tb[4 * 64 + lane] = P.conv_b[ch]; tb[5 * 64 + lane] = P.ba[ch]; tb[6 * 64 + lane] = P.bx[ch]; tb[7 * 64 + lane] = 8.0f * log1pf(expf(-P.lam[ch])); }
#pragma unroll 1
    for (int mt = 0; mt < 2; ++mt) {
        bf16x8 WA[4], WX[4];
#pragma unroll
        for (int s = 0; s < 4; ++s) { u32x4 wa_, wx_; float fa[8], fx[8];
#pragma unroll
            for (int j = 0; j < 8; ++j) { const size_t o = (size_t)(k * 64 + 16 * s + 8 * hi + j) * 64 + 32 * mt + r32; fa[j] = P.wa[o]; fx[j] = P.wx[o]; }
            wa_.x = pk2(fa[0], fa[1]); wa_.y = pk2(fa[2], fa[3]); wa_.z = pk2(fa[4], fa[5]); wa_.w = pk2(fa[6], fa[7]);
            wx_.x = pk2(fx[0], fx[1]); wx_.y = pk2(fx[2], fx[3]); wx_.z = pk2(fx[4], fx[5]); wx_.w = pk2(fx[6], fx[7]);
            WA[s] = __builtin_bit_cast(bf16x8, wa_); WX[s] = __builtin_bit_cast(bf16x8, wx_); }
        f32x16 hin, apr;
#pragma unroll
        for (int g4 = 0; g4 < 4; ++g4) { f32x4 c4 = (f32x4){0.f, 0.f, 0.f, 0.f};
            if (FINAL) c4 = *(const f32x4*)(P.carI + (size_t)seg * 512 + k * 64 + 32 * mt + 8 * g4 + 4 * hi);
#pragma unroll
            for (int j = 0; j < 4; ++j) { hin[4 * g4 + j] = c4[j]; apr[4 * g4 + j] = 1.f; } }
#pragma unroll 1
        for (int half = 0; half < 2; ++half) {
            const int t0 = seg * 64 + half * 32;
#pragma unroll
            for (int i = 0; i < 5; ++i) { const int rr = i * 8 + (lane >> 3); if (rr < 35) { const int t = t0 - 3 + rr; u32x4 v = (u32x4){0u, 0u, 0u, 0u};
                    if (t >= 0) v = *(const u32x4*)(P.z + (size_t)t * ZC + Z_AX + k * 64 + (lane & 7) * 8);
                    *(LAS u32x4*)(wl + rr * XS + (lane & 7) * 16) = v; } }
            LDS_WAIT();
            f32x16 aA = (f32x16){}, aX = (f32x16){}, aI = (f32x16){};
#pragma unroll
            for (int s = 0; s < 4; ++s) {
                const int c0 = 16 * s + 8 * hi; float xc[8];
                { const f32x4 b0 = *(const LAS f32x4*)(tb + 4 * 64 + c0), b1 = *(const LAS f32x4*)(tb + 4 * 64 + c0 + 4);
                  xc[0] = b0[0]; xc[1] = b0[1]; xc[2] = b0[2]; xc[3] = b0[3]; xc[4] = b1[0]; xc[5] = b1[1]; xc[6] = b1[2]; xc[7] = b1[3]; }
#pragma unroll
                for (int jr = 0; jr < 4; ++jr) { const u32x4 xv = *(const LAS u32x4*)(wl + (r32 + jr) * XS + (2 * s + hi) * 16);
                    const f32x4 w0 = *(const LAS f32x4*)(tb + jr * 64 + c0), w1 = *(const LAS f32x4*)(tb + jr * 64 + c0 + 4);
                    xc[0] = fmaf(w0[0], bflo(xv.x), xc[0]); xc[1] = fmaf(w0[1], bfhi(xv.x), xc[1]); xc[2] = fmaf(w0[2], bflo(xv.y), xc[2]); xc[3] = fmaf(w0[3], bfhi(xv.y), xc[3]);
                    xc[4] = fmaf(w1[0], bflo(xv.z), xc[4]); xc[5] = fmaf(w1[1], bfhi(xv.z), xc[5]); xc[6] = fmaf(w1[2], bflo(xv.w), xc[6]); xc[7] = fmaf(w1[3], bfhi(xv.w), xc[7]); }
                u32x4 pw; pw.x = pk2(xc[0], xc[1]); pw.y = pk2(xc[2], xc[3]); pw.z = pk2(xc[4], xc[5]); pw.w = pk2(xc[6], xc[7]);
                const bf16x8 xb = __builtin_bit_cast(bf16x8, pw);
                aA = __builtin_amdgcn_mfma_f32_32x32x16_bf16(WA[s], xb, aA, 0, 0, 0);
                aX = __builtin_amdgcn_mfma_f32_32x32x16_bf16(WX[s], xb, aX, 0, 0, 0);
                u32x4 idw;
                { const int d = 32 * mt + r32 - 16 * s - 8 * hi;
                  idw.x = (d == 0 ? 0x3f80u : 0u) | (d == 1 ? 0x3f800000u : 0u); idw.y = (d == 2 ? 0x3f80u : 0u) | (d == 3 ? 0x3f800000u : 0u);
                  idw.z = (d == 4 ? 0x3f80u : 0u) | (d == 5 ? 0x3f800000u : 0u); idw.w = (d == 6 ? 0x3f80u : 0u) | (d == 7 ? 0x3f800000u : 0u); }
                aI = __builtin_amdgcn_mfma_f32_32x32x16_bf16(__builtin_bit_cast(bf16x8, idw), xb, aI, 0, 0, 0);
            }
#pragma unroll
            for (int g4 = 0; g4 < 4; ++g4) { const int cb_ = 32 * mt + 8 * g4 + 4 * hi;
                const f32x4 vba = *(const LAS f32x4*)(tb + 5 * 64 + cb_), vbx = *(const LAS f32x4*)(tb + 6 * 64 + cb_), vsp = *(const LAS f32x4*)(tb + 7 * 64 + cb_);
#pragma unroll
                for (int j = 0; j < 4; ++j) { const int r = 4 * g4 + j;
                    const float rg = sigmoidf_(aA[r] + vba[j]), ig = sigmoidf_(aX[r] + vbx[j]);
                    const float la = -rg * vsp[j];
                    aA[r] = fexp2(la * LOG2E);
                    aX[r] = sqrtf(-expm1f(2.0f * la)) * (ig * aI[r]); } }
#pragma unroll
            for (int r = 0; r < 16; ++r) { float a = aA[r], u = aX[r];
#pragma unroll
                for (int d = 1; d < 32; d <<= 1) { const float a2 = __shfl_up(a, d, 32), u2 = __shfl_up(u, d, 32); if (r32 >= d) { u = fmaf(a, u2, u); a *= a2; } }
                aA[r] = a; aX[r] = u; }
            if (FINAL) {
#pragma unroll
                for (int r = 0; r < 16; ++r) { const float h = fmaf(aA[r], hin[r], aX[r]); aX[r] = h; hin[r] = __shfl(h, 31, 32); }
#pragma unroll
                for (int g4 = 0; g4 < 4; ++g4) { const int cb_ = k * 64 + 32 * mt + 8 * g4 + 4 * hi;
                    const u32x2 gw = *(const u32x2*)(P.z + (size_t)(t0 + r32) * ZC + Z_AG + cb_);
                    float gv[4] = {bflo(gw.x), bfhi(gw.x), bflo(gw.y), bfhi(gw.y)}, o4[4];
#pragma unroll
                    for (int j = 0; j < 4; ++j) { const float g = gv[j]; o4[j] = aX[4 * g4 + j] * g * frcp(1.0f + fexp2(-1.5957691216f * LOG2E * (g + 0.044715f * g * g * g))); }
                    u32x2 w; w.x = pk2(o4[0], o4[1]); w.y = pk2(o4[2], o4[3]);
                    *(u32x2*)(P.y + (size_t)(t0 + r32) * YC + cb_) = w; }
            } else {
#pragma unroll
                for (int r = 0; r < 16; ++r) { const float a31 = __shfl(aA[r], 31, 32), u31 = __shfl(aX[r], 31, 32); hin[r] = fmaf(a31, hin[r], u31); apr[r] *= a31; }
            }
            LDS_WAIT();
        }
        if (!FINAL) { if (r32 == 0) {
#pragma unroll
            for (int g4 = 0; g4 < 4; ++g4) { const size_t o = (size_t)seg * 512 + k * 64 + 32 * mt + 8 * g4 + 4 * hi;
                *(f32x4*)(P.carA + o) = (f32x4){apr[4 * g4], apr[4 * g4 + 1], apr[4 * g4 + 2], apr[4 * g4 + 3]};
                *(f32x4*)(P.carH + o) = (f32x4){hin[4 * g4], hin[4 * g4 + 1], hin[4 * g4 + 2], hin[4 * g4 + 3]}; } } }
    }
}
}

constexpr int NPH_LAYER = 16, NPHASE = 2 + DEPTH * NPH_LAYER;

__global__ void __launch_bounds__(NTHREADS, 2) fwd_kernel(Args args) {
    extern __shared__ __attribute__((aligned(16))) unsigned char lds_raw[];
    LAS unsigned char* lds = (LAS unsigned char*)lds_raw;
    const int G = gridDim.x; const int bx = blockIdx.x;
    const int vcu = (G % 8 == 0) ? (bx % 8) * (G / 8) + bx / 8 : bx;
    const int NGW = G * NWAVES;
    typedef const __attribute__((address_space(4))) Args* KArgs;
#define PH_PTRS KArgs KA = (KArgs)__builtin_amdgcn_kernarg_segment_ptr(); asm volatile("" : "+s"(KA)); unsigned char* const ws = KA->ws; (void)ws; \
    int tid = threadIdx.x; asm volatile("" : "+v"(tid)); const int lane = tid & 63; const int wid = __builtin_amdgcn_readfirstlane(tid >> 6); const int gw = vcu * NWAVES + wid; (void)lane; (void)gw
#define ctl ((unsigned*)(ws + WS_CTL))
#define memn ((bf16*)(ws + WS_MEMN))
#define kvmem ((bf16*)(ws + WS_KMEM))
#define wtr ((bf16*)(ws + WS_WTR))
#define carA ((float*)(ws + WS_CARA))
#define carH ((float*)(ws + WS_CARH))
#define carI ((float*)(ws + WS_CARI))
#define qknrm ((float*)(ws + WS_QKN))
#define lseb ((float*)(ws + WS_LSE))
#define tokE ((int*)(ws + WS_TOKE))
#define tokP ((int*)(ws + WS_TOKP))
#define tokW ((float*)(ws + WS_TOKW))
#define elist ((int*)(ws + WS_ELIST))
#define wt_in ((bf16*)(ws + WS_WIN))
#define wt_br ((bf16*)(ws + WS_WBR))
#define wt_out ((bf16*)(ws + WS_WOUT))
#define wt_mq ((bf16*)(ws + WS_WMQ))
#define wt_mk ((bf16*)(ws + WS_WMK))
#define wt_mv ((bf16*)(ws + WS_WMV))
#define wt_mo ((bf16*)(ws + WS_WMO))
#define w13 ((bf16*)(ws + WS_W13))
#define w2t ((bf16*)(ws + WS_W2))
#define hb ((bf16*)(ws + WS_H))
#define yb ((bf16*)(ws + WS_Y))
#define kvT ((float*)(ws + WS_KVT))
#define rT ((bf16*)(ws + WS_RT))
#define odb ((bf16*)(ws + WS_OD))
#define zb ((bf16*)(ws + WS_Z))
#define gtb ((bf16*)(ws + WS_G))
#define mrg ((bf16*)(ws + WS_MRG))
#define qb ((bf16*)(ws + WS_QB))
#define obf ((bf16*)(ws + WS_OB))
#define hid ((bf16*)(ws + WS_HID))
#define ymoe ((bf16*)(ws + WS_YMOE))
#define xs1 ((bf16*)(ws + WS_XS1))
#define xs2 ((bf16*)(ws + WS_XS2))
#define xin (KA->in[I_X])
#define xout (KA->out)
    volatile LAS unsigned* MISC = (volatile LAS unsigned*)(lds + LDS_MISC);
    if (threadIdx.x < 64) MISC[threadIdx.x] = 0u;
    __syncthreads();
    const int lo = args.ph_lo, hi_ph = args.ph_hi;
    XcdBarrier bar; bar.x = 0; bar.st = nullptr; bar.bar = nullptr;
    { PH_PTRS; bar.bar = ctl + CW_BAR; if (hi_ph - lo > 1) bar = xcd_barrier_post(ctl + CW_BAR, MISC + 8); }
#ifndef PH_EN
#define PH_EN 0xFFFFFFFFu
#endif
#define EN(p) (((PH_EN) >> (p)) & 1u)
#define IN(k) (lo <= (k) && (k) < hi_ph)
#define SEAM(k) do { if (IN(k) && IN((k) + 1)) xcd_barrier(bar); } while (0)

    if (EN(19) && IN(0)) { PH_PTRS;
        LAS float* scr = (LAS float*)(lds + wid * 16384);
        for (int l = 0; l < DEPTH; ++l) {
            constexpr int I_IN = (D / 64) * (INC / 32), I_BR = (512 / 64) * (D / 32), I_OUT = (D / 64) * (D / 32), I_MQ = (D / 64) * (512 / 32), I_MO = (512 / 64) * (D / 32);
            constexpr int NIT = I_IN + 4 * I_BR + I_OUT + 3 * I_MQ + I_MO;
            for (int it = gw; it < NIT; it += NGW) {
                int r = it;
                if (r < I_IN) { const int n0_ = (r % (INC / 32)) * 32; const float sc_ = ((n0_ >= Z_BQ && n0_ < Z_BK) || (n0_ >= Z_DQ && n0_ < Z_DK)) ? 0.125f * LOG2E : 1.0f;
                    transpose_item(KA->in[I_W_IN] + (size_t)l * D * INC, D, INC, wt_in + (size_t)l * INC * D, 0, scr, r, lane, sc_); continue; } r -= I_IN;
                if (r < 4 * I_BR) { const int b = r / I_BR; transpose_item(KA->in[I_W_BRANCH] + (size_t)(l * 4 + b) * 512 * D, 512, D, wt_br + (size_t)(l * 4 + b) * D * 512, 0, scr, r % I_BR, lane); continue; } r -= 4 * I_BR;
                if (r < I_OUT) { transpose_item(KA->in[I_W_OUT] + (size_t)l * D * D, D, D, wt_out + (size_t)l * D * D, 0, scr, r, lane); continue; } r -= I_OUT;
                if (r < I_MQ) { transpose_item(KA->in[I_W_MQ] + (size_t)l * D * 512, D, 512, wt_mq + (size_t)l * 512 * D, 0, scr, r, lane, 0.08838834764831845f * LOG2E); continue; } r -= I_MQ;
                if (r < I_MQ) { transpose_item(KA->in[I_W_MK] + (size_t)l * D * 512, D, 512, wt_mk + (size_t)l * 512 * D, 0, scr, r, lane); continue; } r -= I_MQ;
                if (r < I_MQ) { transpose_item(KA->in[I_W_MV] + (size_t)l * D * 512, D, 512, wt_mv + (size_t)l * 512 * D, 0, scr, r, lane); continue; } r -= I_MQ;
                transpose_item(KA->in[I_W_MO] + (size_t)l * 512 * D, 512, D, wt_mo + (size_t)l * D * 512, 0, scr, r, lane);
            }
        }
        convert_experts(KA->in[I_W1], KA->in[I_W3], KA->in[I_W2], w13, w2t, scr, gw, NGW, lane);
        for (int i = gw * 64 + lane; i < DEPTH * 64 * D; i += NGW * 64) { const int l = i / (64 * D), n = (i / D) % 64, k = i % D; float v = 0.f;
            if (n < 4) v = KA->in[I_W_GROUP][(size_t)(l * D + k) * 4 + n]; else if (n < 36) v = KA->in[I_W_ROUTER][(size_t)(l * D + k) * 32 + (n - 4)];
            wtr[i] = (bf16)f2bf(v); }
        for (int m = gw; m < MEM_LEN; m += NGW) rms_row_to_bf16(KA->in[I_MEM] + (size_t)m * D, KA->in[I_MEM_NORM], memn + (size_t)m * D, lane);
        for (int i = gw * 64 + lane; i < 256 * D / 8; i += NGW * 64) ((u32x4*)(hb + (size_t)M * D))[i] = (u32x4){0u, 0u, 0u, 0u};
        for (int m = gw; m < M; m += NGW) rms_row_to_bf16(xin + (size_t)m * D, KA->in[I_NORM_MIX], hb + (size_t)m * D, lane);
    }
    SEAM(0);
    if (EN(20) && IN(1)) { PH_PTRS;
        pg8::Gemm g{memn, wt_mk, D, D, D, 0}; pg8::GridOrder S; S.init(1, 8, G, bx);
        pg8::EpiBf16<0> E{kvmem, 2048}; pg8::gemm_phase<pg8::EpiBf16<0>, pg8::GridOrder, false>(lds, g, S, E, tid);
    }
    SEAM(1);

    for (int l = 0; l < DEPTH; ++l) {
        const int pb = 2 + l * NPH_LAYER;
        if (EN(0) && IN(pb + 0)) { PH_PTRS;
            { pg8::Gemm g{hb, wt_in + (size_t)l * INC * D, D, D, D, M}; pg8::GridOrder S; S.init(M / 256, ZC / 256, G, bx);
              pg8::EpiBf16<0> E{zb, ZC}; pg8::gemm_phase<pg8::EpiBf16<0>, pg8::GridOrder, false>(lds, g, S, E, tid); }
        }
        SEAM(pb + 0);
#define LRU_P lru::LruP LP{zb, KA->in[I_CONV_W] + l * 2048, KA->in[I_CONV_B] + l * 512, KA->in[I_LRU_WA] + (size_t)l * 32768, KA->in[I_LRU_BA] + l * 512, \
                     KA->in[I_LRU_WX] + (size_t)l * 32768, KA->in[I_LRU_BX] + l * 512, KA->in[I_LRU_LAMBDA] + l * 512, carA, carH, carI, yb}
        if (EN(1) && IN(pb + 1)) { PH_PTRS; LRU_P;
            for (int u = gw; u < 2048; u += NGW) lru::unit<false>((LAS char*)lds + wid * 16384, LP, u >> 3, u & 7, lane);
            for (int u = gw; u < 2048; u += NGW) ret::kv_unit((LAS char*)lds + wid * 16384, zb, kvT, u >> 3, u & 7, lane);
            { float mx = 0.f;
              for (int m = gw; m < M; m += NGW) { const u32x4 v0 = *(const u32x4*)(zb + (size_t)m * ZC + Z_DQ + lane * 16), v1 = *(const u32x4*)(zb + (size_t)m * ZC + Z_DQ + lane * 16 + 8);
                  float ss = bflo(v0.x) * bflo(v0.x) + bfhi(v0.x) * bfhi(v0.x) + bflo(v0.y) * bflo(v0.y) + bfhi(v0.y) * bfhi(v0.y) + bflo(v0.z) * bflo(v0.z) + bfhi(v0.z) * bfhi(v0.z) + bflo(v0.w) * bflo(v0.w) + bfhi(v0.w) * bfhi(v0.w)
                           + bflo(v1.x) * bflo(v1.x) + bfhi(v1.x) * bfhi(v1.x) + bflo(v1.y) * bflo(v1.y) + bfhi(v1.y) * bfhi(v1.y) + bflo(v1.z) * bflo(v1.z) + bfhi(v1.z) * bfhi(v1.z) + bflo(v1.w) * bflo(v1.w) + bfhi(v1.w) * bfhi(v1.w);
                  ss += __shfl_xor(ss, 1); ss += __shfl_xor(ss, 2); mx = fmaxf(mx, ss); }
              LAS float* wm = (LAS float*)(lds + LDS_MISC + 4096);
              __syncthreads();
              if ((lane & 3) == 0) wm[wid * 16 + (lane >> 2)] = mx;
              __syncthreads();
              if (tid < 16) { float v = wm[tid]; for (int w = 1; w < 8; ++w) v = fmaxf(v, wm[w * 16 + tid]); qknrm[vcu * 16 + tid] = sqrtf(v); } }
        }
        SEAM(pb + 1);
#define DQ_SETUP LAS float* qkm = (LAS float*)(lds + LDS_MISC + 4096);   \
            { float v = 0.f; const int idx = wid * 2 + (lane >> 5); for (int j = (lane & 31); j < G; j += 32) v = fmaxf(v, qknrm[j * 16 + idx]); \
              for (int o_ = 1; o_ < 32; o_ <<= 1) v = fmaxf(v, __shfl_xor(v, o_)); if ((lane & 31) == 0) qkm[idx] = v; } \
            __syncthreads()
#define DQ_DMAX(hm_) ((int)((150.0f + 2.02f * qkm[(hm_)] * qkm[8 + (hm_)]) / (exp2f(-2.0f * (float)(((hm_) >> 1) + 1)) * LOG2E)) + 2)
        if (EN(2) && IN(pb + 2)) { PH_PTRS;
            DQ_SETUP;
            LAS unsigned short* dord = (LAS unsigned short*)(lds + LDS_MISC + 8192);
            LAS int* dq = (LAS int*)(lds + LDS_MISC + 4096 + 128);
            {
              const int hdesc = tid >> 7, j = tid & 127, qblk = 63 - (j >> 1), hm = (3 - hdesc) * 2 + (j & 1);
              const int a = qblk * 256 - DQ_DMAX(hm); const int tlo = a > 0 ? (a >> 6) : 0, ntile = 4 * qblk + 4 - tlo, nseg = hm < 4 ? 1 : (ntile + 85) / 86;
              int inc = nseg;
#pragma unroll
              for (int o_ = 1; o_ < 64; o_ <<= 1) { const int v = __shfl_up(inc, o_); if (lane >= o_) inc += v; }
              if (lane == 63) dq[8 + wid] = inc;
              __syncthreads();
              int base = 0; for (int w = 0; w < wid; ++w) base += dq[8 + w];
              if (tid == NTHREADS - 1) dq[0] = base + inc;
              for (int sg = 0; sg < nseg; ++sg) dord[base + inc - nseg + sg] = (unsigned short)(((hm * 64 + qblk) << 2) | sg);
              __syncthreads(); }
            { const int gt = vcu * NTHREADS + tid;
              if (gt < 32768) { const int hh = gt >> 12; const float gch = exp2f(64.0f * ret::gamma_log2(hh)); float S = 0.f;
#pragma unroll 8
                  for (int c = 0; c < NCHUNK; ++c) { const float kv = kvT[(size_t)c * 32768 + gt]; rT[(size_t)c * 32768 + gt] = (bf16)f2bf(S); S = fmaf(gch, S, kv); }
              } else if (gt < 32768 + 512) { const int ch = gt - 32768; float hc = 0.f;
#pragma unroll 8
                  for (int sgm = 0; sgm < 256; ++sgm) { carI[sgm * 512 + ch] = hc; hc = fmaf(carA[sgm * 512 + ch], hc, carH[sgm * 512 + ch]); } } }
#ifndef NO_DQ
            const int nd = dq[0];
            unsigned* qctr = ctl + CW_DQ + l * 128;
            for (;;) {
                __syncthreads();
                if (tid == 0) dq[1] = (int)__hip_atomic_fetch_add(qctr, 1u, __ATOMIC_RELAXED, __HIP_MEMORY_SCOPE_AGENT);
                __syncthreads();
                const int n = dq[1]; if (n >= nd) break;
                const int id = dord[n], sg = id & 3, qblk = (id >> 2) & 63, hm = id >> 8, head = hm >> 1, mp = hm & 1;
                const int dmx = DQ_DMAX(hm); const int a = qblk * 256 - dmx; const int tlo = a > 0 ? (a >> 6) : 0, thi = 4 * qblk + 4, ntile = thi - tlo, nseg = hm < 4 ? 1 : (ntile + 85) / 86, len = (ntile + nseg - 1) / nseg;
                const int t0 = tlo + sg * len, t1 = (t0 + len < thi) ? t0 + len : thi;
                bf16* ob_ = sg == 0 ? odb + hm * 128 : (sg == 1 ? xs1 : xs2) + (hm - 4) * 128;
                att::AttnP P{zb + Z_DQ + head * 128 + mp * 64, zb + Z_DK + head * 128 + mp * 64, zb + Z_DV + head * 128, ob_, ZC, ZC, ZC, sg == 0 ? 1024 : 512,
                             qblk * 256, t0, t1, exp2f(-2.0f * (float)(head + 1)) * LOG2E, dmx, nullptr, lseb + (size_t)sg * M * 8 + hm};
                int tid_u = tid; asm volatile("" : "+v"(tid_u));
                att::attn_unit<64, 128, 2>((LAS char*)lds, P, tid_u);
            }
#endif
#ifndef NO_BQ
            LAS float* tab = (LAS float*)(lds + 65536);
            unsigned* bctr = ctl + CW_DQ + l * 128 + 64;
            for (;;) {
                __syncthreads();
                if (tid == 0) dq[2] = (int)__hip_atomic_fetch_add(bctr, 1u, __ATOMIC_RELAXED, __HIP_MEMORY_SCOPE_AGENT);
                __syncthreads();
                const int u = dq[2]; if (u >= 512) break;
                const int head = u & 7, qblk = u >> 3;
                if (tid < 257) tab[tid] = KA->in[I_CA_REL][(size_t)(l * 8 + head) * 257 + tid] * LOG2E;
                __syncthreads();
                att::AttnP P{zb + Z_BQ + head * 64, zb + Z_BK + head * 64, zb + Z_BV + head * 64, yb + 512 + head * 64, ZC, ZC, ZC, YC,
                             qblk * 256, (4 * qblk - 8 < 0 ? 0 : 4 * qblk - 8), 4 * qblk + 4, 0.f, 0, tab, nullptr};
                int tid_u = tid; asm volatile("" : "+v"(tid_u));
                att::attn_unit<64, 64, 1>((LAS char*)lds, P, tid_u);
            }
#endif
        }
        SEAM(pb + 2);
        if (EN(3) && IN(pb + 3)) { PH_PTRS; LRU_P; const float lam_init = 0.8f - 0.6f * expf(-0.3f * (float)l);
            DQ_SETUP;
            for (int u = gw; u < 2048; u += NGW) lru::unit<true>((LAS char*)lds + wid * 16384, LP, u >> 3, u & 7, lane);
            for (int u = gw; u < 2048; u += NGW) ret::out_unit((LAS char*)lds + wid * 16384, zb, rT, yb, u >> 3, u & 7, lane);
            const float* dl = KA->in[I_DIFF_LAMBDA] + l * 256;
            const float lam = expf(wave_sum(dl[lane] * dl[64 + lane])) - expf(wave_sum(dl[128 + lane] * dl[192 + lane])) + lam_init;
            const int head = lane >> 4, sub = lane & 15; const float* sg_ = KA->in[I_DIFF_SUBLN] + l * 128 + sub * 8;
            float gsc[8];
#pragma unroll
            for (int j = 0; j < 8; ++j) gsc[j] = sg_[j] * (1.0f - lam_init);
            const int dm0 = DQ_DMAX(head * 2), dm1 = DQ_DMAX(head * 2 + 1);
            for (int m = gw; m < M; m += NGW) {
                const int qblk = m >> 8; float om[2][8];
#pragma unroll
                for (int mp = 0; mp < 2; ++mp) { const int hm = head * 2 + mp; const int a = qblk * 256 - (mp ? dm1 : dm0); const int tlo = a > 0 ? (a >> 6) : 0, nseg = hm < 4 ? 1 : (4 * qblk + 4 - tlo + 85) / 86;
                    float c0 = lseb[(size_t)m * 8 + hm], c1 = -1.0e30f, c2 = -1.0e30f;
                    if (nseg > 1) c1 = lseb[(size_t)M * 8 + (size_t)m * 8 + hm];
                    if (nseg > 2) c2 = lseb[(size_t)2 * M * 8 + (size_t)m * 8 + hm];
                    const float cm = fmaxf(c0, fmaxf(c1, c2)); float w0 = fexp2(c0 - cm), w1 = fexp2(c1 - cm), w2 = fexp2(c2 - cm); const float wi = 1.0f / (w0 + w1 + w2); w0 *= wi; w1 *= wi; w2 *= wi;
                    const u32x4 a0 = *(const u32x4*)(odb + (size_t)m * 1024 + hm * 128 + sub * 8);
                    om[mp][0] = w0 * bflo(a0.x); om[mp][1] = w0 * bfhi(a0.x); om[mp][2] = w0 * bflo(a0.y); om[mp][3] = w0 * bfhi(a0.y); om[mp][4] = w0 * bflo(a0.z); om[mp][5] = w0 * bfhi(a0.z); om[mp][6] = w0 * bflo(a0.w); om[mp][7] = w0 * bfhi(a0.w);
                    if (nseg > 1) { const u32x4 a1 = *(const u32x4*)(xs1 + (size_t)m * 512 + (hm - 4) * 128 + sub * 8);
                        om[mp][0] += w1 * bflo(a1.x); om[mp][1] += w1 * bfhi(a1.x); om[mp][2] += w1 * bflo(a1.y); om[mp][3] += w1 * bfhi(a1.y); om[mp][4] += w1 * bflo(a1.z); om[mp][5] += w1 * bfhi(a1.z); om[mp][6] += w1 * bflo(a1.w); om[mp][7] += w1 * bfhi(a1.w); }
                    if (nseg > 2) { const u32x4 a2 = *(const u32x4*)(xs2 + (size_t)m * 512 + (hm - 4) * 128 + sub * 8);
                        om[mp][0] += w2 * bflo(a2.x); om[mp][1] += w2 * bfhi(a2.x); om[mp][2] += w2 * bflo(a2.y); om[mp][3] += w2 * bfhi(a2.y); om[mp][4] += w2 * bflo(a2.z); om[mp][5] += w2 * bfhi(a2.z); om[mp][6] += w2 * bflo(a2.w); om[mp][7] += w2 * bfhi(a2.w); } }
                float o[8], ss = 0.f;
#pragma unroll
                for (int j = 0; j < 8; ++j) { o[j] = om[0][j] - lam * om[1][j]; ss += o[j] * o[j]; }
                ss += __shfl_xor(ss, 1); ss += __shfl_xor(ss, 2); ss += __shfl_xor(ss, 4); ss += __shfl_xor(ss, 8);
                const float rs = 1.0f / sqrtf(ss * (1.f / 128.f) + GN_EPS);
                u32x4 w; w.x = cvt_pk_bf16(o[0] * rs * gsc[0], o[1] * rs * gsc[1]); w.y = cvt_pk_bf16(o[2] * rs * gsc[2], o[3] * rs * gsc[3]);
                w.z = cvt_pk_bf16(o[4] * rs * gsc[4], o[5] * rs * gsc[5]); w.w = cvt_pk_bf16(o[6] * rs * gsc[6], o[7] * rs * gsc[7]);
                *(u32x4*)(yb + (size_t)m * YC + 1536 + head * 128 + sub * 8) = w;
            }
            if (l == 1) convert_experts(KA->in[I_W1] + (size_t)NEXP * D * DEXP, KA->in[I_W3] + (size_t)NEXP * D * DEXP, KA->in[I_W2] + (size_t)NEXP * DEXP * D, w13, w2t, (LAS float*)(lds + wid * 16384), gw, NGW, lane);
        }
        SEAM(pb + 3);
        if (EN(4) && IN(pb + 4)) { PH_PTRS;
            pg8::Gemm g{hb, wt_in + (size_t)l * INC * D + (size_t)ZC * D, D, D, D, M}; pg8::GridOrder S; S.init(M / 256, 4096 / 256, G, bx);
            pg8::EpiBf16<1> E{gtb, 4096}; pg8::gemm_phase<pg8::EpiBf16<1>, pg8::GridOrder, false>(lds, g, S, E, tid);
        }
        SEAM(pb + 4);
        if (EN(5) && IN(pb + 5)) { PH_PTRS;
            pg8::Gemm g{yb, wt_br + (size_t)l * 4 * D * 512, YC, 512, 512, M}; pg8::BranchOrder S{G, bx};
            pg8::EpiGateAcc E{gtb, mrg}; pg8::gemm_phase<pg8::EpiGateAcc, pg8::BranchOrder, false>(lds, g, S, E, tid);
        }
        SEAM(pb + 5);
        if (EN(6) && IN(pb + 6)) { PH_PTRS;
            pg8::Gemm g{mrg, wt_out + (size_t)l * D * D, D, D, D, M}; pg8::GridOrder S; S.init(M / 256, D / 256, G, bx);
            pg8::EpiResF32 E{l == 0 ? xin : (const float*)xout, xout, D}; pg8::gemm_phase<pg8::EpiResF32, pg8::GridOrder, false>(lds, g, S, E, tid);
        }
        SEAM(pb + 6);
        if (EN(7) && IN(pb + 7)) { PH_PTRS; for (int m = gw; m < M; m += NGW) rms_row_to_bf16(xout + (size_t)m * D, KA->in[I_NORM_MEM] + l * D, hb + (size_t)m * D, lane); }
        SEAM(pb + 7);
        if (EN(8) && IN(pb + 8)) { PH_PTRS;
            pg8::Gemm g{hb, wt_mq + (size_t)l * 512 * D, D, D, D, M}; pg8::GridOrder S; S.init(M / 256, 2, G, bx);
            pg8::EpiBf16<0> E{qb, 512}; pg8::gemm_phase<pg8::EpiBf16<0>, pg8::GridOrder, false>(lds, g, S, E, tid);
        }
        SEAM(pb + 8);
        if (EN(9) && IN(pb + 9)) { PH_PTRS;
            for (int u = vcu; u < 256; u += G) { const int head = u & 3, qblk = u >> 2;
                att::AttnP P{qb + head * 128, kvmem + l * 512 + head * 128, kvmem + 1024 + l * 512 + head * 128, obf + head * 128, 512, 2048, 2048, 512,
                             qblk * 256, 0, 4, 0.f, 0, nullptr, nullptr};
                att::attn_unit<128, 128, 0>((LAS char*)lds, P, tid); }
        }
        SEAM(pb + 9);
        if (EN(10) && IN(pb + 10)) { PH_PTRS;
            pg8::Gemm g{obf, wt_mo + (size_t)l * D * 512, 512, 512, 512, M}; pg8::GridOrder S; S.init(M / 256, D / 256, G, bx);
            pg8::EpiResF32 E{xout, xout, D}; pg8::gemm_phase<pg8::EpiResF32, pg8::GridOrder, false>(lds, g, S, E, tid);
        }
        SEAM(pb + 10);
        if (EN(11) && IN(pb + 11)) { PH_PTRS; for (int m = gw; m < M; m += NGW) rms_row_to_bf16(xout + (size_t)m * D, KA->in[I_NORM_FFN] + l * D, hb + (size_t)m * D, lane); }
        SEAM(pb + 11);
        if (EN(12) && IN(pb + 12)) { PH_PTRS; unsigned* ecnt = ctl + CW_ECNT + l * 32 * 64;
            LAS float* lg = (LAS float*)(lds + wid * 16384);
            const int r32 = lane & 31, hi = lane >> 5; const bf16* wl_ = wtr + (size_t)l * 64 * D;
            for (int u = gw; u < M / 32; u += NGW) { const int t0 = u * 32;
                f32x16 a0 = (f32x16){}, a1 = (f32x16){};
#pragma unroll 4
                for (int s = 0; s < 64; ++s) { const bf16x8 bf_ = *(const bf16x8*)(hb + (size_t)(t0 + r32) * D + 16 * s + 8 * hi);
                    a0 = __builtin_amdgcn_mfma_f32_32x32x16_bf16(*(const bf16x8*)(wl_ + (size_t)r32 * D + 16 * s + 8 * hi), bf_, a0, 0, 0, 0);
                    a1 = __builtin_amdgcn_mfma_f32_32x32x16_bf16(*(const bf16x8*)(wl_ + (size_t)(32 + r32) * D + 16 * s + 8 * hi), bf_, a1, 0, 0, 0); }
#pragma unroll
                for (int r = 0; r < 16; ++r) { lg[r32 * 65 + att::crow(r, hi)] = a0[r]; lg[r32 * 65 + 32 + att::crow(r, hi)] = a1[r]; }
                LDS_WAIT();
                const LAS float* tl = lg + r32 * 65; const float* bg = KA->in[I_B_GROUP] + l * 4; const float* br = KA->in[I_B_ROUTER] + l * 32;
                float gl[4];
#pragma unroll
                for (int j = 0; j < 4; ++j) gl[j] = tl[j] + bg[j];
                int gs = 0; float gmx = gl[0];
#pragma unroll
                for (int j = 1; j < 4; ++j) if (gl[j] > gmx) { gmx = gl[j]; gs = j; }
                float gsum = 0.f;
#pragma unroll
                for (int j = 0; j < 4; ++j) gsum += __expf(gl[j] - gmx);
                const float gprob = 1.0f / gsum;
                float el[8];
#pragma unroll
                for (int j = 0; j < 8; ++j) el[j] = tl[4 + 8 * gs + j] + br[8 * gs + j];
                int i0 = 0; float m0 = el[0];
#pragma unroll
                for (int j = 1; j < 8; ++j) if (el[j] > m0) { m0 = el[j]; i0 = j; }
                int i1 = -1; float m1 = -3.0e38f;
#pragma unroll
                for (int j = 0; j < 8; ++j) if (j != i0 && el[j] > m1) { m1 = el[j]; i1 = j; }
                const float e1 = __expf(m1 - m0); const float w0 = gprob / (1.0f + e1), w1 = gprob * e1 / (1.0f + e1);
                const int myk = hi; const int e = 8 * gs + (myk ? i1 : i0); const float w = myk ? w1 : w0;
                unsigned long long rem = ~0ull; int leader = 0, rank = 0, cnt = 0;
                while (rem) { const int ld_ = __builtin_ctzll(rem); const int ee = __shfl(e, ld_); const unsigned long long mk = __ballot(e == ee);
                    if (e == ee) { leader = ld_; rank = __builtin_popcountll(mk & ((1ull << lane) - 1ull)); cnt = __builtin_popcountll(mk); } rem &= ~mk; }
                unsigned base = 0u; if (lane == leader) base = __hip_atomic_fetch_add(ecnt + 64 * e, (unsigned)cnt, __ATOMIC_RELAXED, __HIP_MEMORY_SCOPE_AGENT);
                base = __shfl(base, leader); const int pos = (int)base + rank; const int tok = t0 + r32;
                elist[e * 16384 + pos] = tok; tokE[tok * 2 + myk] = e; tokP[tok * 2 + myk] = pos; tokW[tok * 2 + myk] = w;
                LDS_WAIT();
            }
        }
        SEAM(pb + 12);
        LAS int* mtab = (LAS int*)(lds + LDS_MISC + 1024);
        if ((EN(13) || EN(14)) && (IN(pb + 13) || IN(pb + 14))) { PH_PTRS; unsigned* ecnt = ctl + CW_ECNT + l * 32 * 64;
            if (tid == 0) { int nrt = 0; for (int e = 0; e < NEXP; ++e) { const int c = (int)__hip_atomic_load(ecnt + 64 * e, __ATOMIC_RELAXED, __HIP_MEMORY_SCOPE_AGENT); const int nt_ = (c + 255) >> 8;
                    for (int r = 0; r < nt_; ++r) { mtab[16 + 4 * nrt] = e; mtab[16 + 4 * nrt + 1] = r; mtab[16 + 4 * nrt + 2] = nrt; ++nrt; } }
                mtab[0] = nrt; }
            __syncthreads();
        }
        if (EN(13) && IN(pb + 13)) { PH_PTRS; unsigned* ecnt = ctl + CW_ECNT + l * 32 * 64;
            pg8::Gemm g{hb, w13, D, D, D, M}; pg8::MoeOrder S{mtab, G, bx, 4, 1024, elist, ecnt};
            pg8::EpiSwiGlu E{hid}; pg8::gemm_phase<pg8::EpiSwiGlu, pg8::MoeOrder, true>(lds, g, S, E, tid);
        }
        SEAM(pb + 13);
        if (EN(14) && IN(pb + 14)) { PH_PTRS; unsigned* ecnt = ctl + CW_ECNT + l * 32 * 64;
            pg8::Gemm g{hid, w2t, DEXP, DEXP, DEXP, M}; pg8::MoeOrder S{mtab, G, bx, 4, 1024, elist, ecnt};
            pg8::EpiBf16<0> E{ymoe, D}; pg8::gemm_phase<pg8::EpiBf16<0>, pg8::MoeOrder, false>(lds, g, S, E, tid);
        }
        SEAM(pb + 14);
        if (EN(15) && IN(pb + 15)) { PH_PTRS; unsigned* ecnt = ctl + CW_ECNT + l * 32 * 64;
            int sb = 0; { const int c = lane < NEXP ? (int)__hip_atomic_load(ecnt + 64 * (lane & 31), __ATOMIC_RELAXED, __HIP_MEMORY_SCOPE_AGENT) : 0; const int nt_ = (c + 255) >> 8; int inc = nt_;
#pragma unroll
                for (int o = 1; o < 32; o <<= 1) { const int v = __shfl_up(inc, o); if ((lane & 31) >= o) inc += v; }
                sb = (inc - nt_) * 256; }
            const float* gn = (l + 1 < DEPTH) ? KA->in[I_NORM_MIX] + (l + 1) * D : KA->in[I_FINAL_NORM];
            for (int m = gw; m < M; m += NGW) {
                const int e0 = tokE[m * 2], e1 = tokE[m * 2 + 1]; const float w0 = tokW[m * 2], w1 = tokW[m * 2 + 1];
                const size_t s0 = (size_t)(__shfl(sb, e0) + tokP[m * 2]), s1 = (size_t)(__shfl(sb, e1) + tokP[m * 2 + 1]);
                f32x4 v[4]; float ss = 0.f;
#pragma unroll
                for (int j = 0; j < 4; ++j) { v[j] = ((const f32x4*)(xout + (size_t)m * D))[lane + 64 * j];
                    const u32x2 a = ((const u32x2*)(ymoe + s0 * D))[lane + 64 * j], b = ((const u32x2*)(ymoe + s1 * D))[lane + 64 * j];
                    v[j].x += w0 * bflo(a.x) + w1 * bflo(b.x); v[j].y += w0 * bfhi(a.x) + w1 * bfhi(b.x); v[j].z += w0 * bflo(a.y) + w1 * bflo(b.y); v[j].w += w0 * bfhi(a.y) + w1 * bfhi(b.y);
                    ss += (v[j].x * v[j].x + v[j].y * v[j].y) + (v[j].z * v[j].z + v[j].w * v[j].w); }
                const float rstd = 1.f / sqrtf(wave_sum(ss) * (1.f / D) + NORM_EPS);
                if (l + 1 < DEPTH) {
#pragma unroll
                    for (int j = 0; j < 4; ++j) { ((f32x4*)(xout + (size_t)m * D))[lane + 64 * j] = v[j]; const f32x4 gg = ((const f32x4*)gn)[lane + 64 * j];
                        u32x2 w; w.x = pk2(v[j].x * rstd * gg.x, v[j].y * rstd * gg.y); w.y = pk2(v[j].z * rstd * gg.z, v[j].w * rstd * gg.w);
                        ((u32x2*)(hb + (size_t)m * D))[lane + 64 * j] = w; }
                } else {
#pragma unroll
                    for (int j = 0; j < 4; ++j) { const f32x4 gg = ((const f32x4*)gn)[lane + 64 * j];
                        ((f32x4*)(xout + (size_t)m * D))[lane + 64 * j] = (f32x4){v[j].x * rstd * gg.x, v[j].y * rstd * gg.y, v[j].z * rstd * gg.z, v[j].w * rstd * gg.w}; }
                }
            }
        }
        SEAM(pb + 15);
    }
#undef IN
#undef SEAM
}

extern "C" void kernel_launch(void* const* d_in, const int* in_sizes, int n_in, void* d_out, int out_size, void* d_ws, size_t ws_size, hipStream_t stream) {
    static int grid = 0;
    if (grid == 0) {
        if (n_in != 31 || in_sizes[0] != M * D || out_size != M * D || ws_size < WS_END) { fprintf(stderr, "kernel_launch: unexpected problem (n_in %d, in0 %d, out %d, ws %zu < %zu)\n", n_in, n_in > 0 ? in_sizes[0] : -1, out_size, ws_size, (size_t)WS_END); grid = -1; return; }
        int dev = 0, cus = 0, per_cu = 0;
        if (hipGetDevice(&dev) != hipSuccess || hipDeviceGetAttribute(&cus, hipDeviceAttributeMultiprocessorCount, dev) != hipSuccess) { grid = -1; return; }
        if (hipFuncSetAttribute((const void*)fwd_kernel, hipFuncAttributeMaxDynamicSharedMemorySize, LDS_BYTES) != hipSuccess) { fprintf(stderr, "kernel_launch: hipFuncSetAttribute failed\n"); grid = -1; return; }
        if (hipOccupancyMaxActiveBlocksPerMultiprocessor(&per_cu, (const void*)fwd_kernel, NTHREADS, LDS_BYTES) != hipSuccess || per_cu < 1) { fprintf(stderr, "kernel_launch: occupancy query says %d\n", per_cu); }
        (void)hipGetLastError();
        grid = cus;
    }
    if (grid < 0) return;
    if (hipMemsetAsync((char*)d_ws + WS_CTL, 0, CTL_ZERO_BYTES, stream) != hipSuccess) return;
    Args a{};
    for (int i = 0; i < 31; ++i) a.in[i] = (const float*)d_in[i];
    a.out = (float*)d_out; a.ws = (unsigned char*)d_ws;
#if MK_N_LAUNCHES == 1
    a.ph_lo = 0; a.ph_hi = NPHASE;
    hipLaunchKernelGGL(fwd_kernel, dim3(grid), dim3(NTHREADS), LDS_BYTES, stream, a);
#else
    for (int p = 0; p < NPHASE; ++p) { a.ph_lo = p; a.ph_hi = p + 1; hipLaunchKernelGGL(fwd_kernel, dim3(grid), dim3(NTHREADS), LDS_BYTES, stream, a); }
#endif
}
```

```cpp
#include <hip/hip_runtime.h>
#include <cstdio>
#include <cstdint>
#include <cmath>

#ifndef MK_N_LAUNCHES
#define MK_N_LAUNCHES 1
#endif

#define LAS __attribute__((address_space(3)))
#define GAS __attribute__((address_space(1)))
typedef unsigned short bf16;
typedef short bf16x8 __attribute__((ext_vector_type(8)));
typedef short s16x4 __attribute__((ext_vector_type(4)));
typedef float f32x4 __attribute__((ext_vector_type(4)));
typedef float f32x2 __attribute__((ext_vector_type(2)));
typedef float f32x16 __attribute__((ext_vector_type(16)));
typedef unsigned u32x4 __attribute__((ext_vector_type(4)));
typedef unsigned u32x2 __attribute__((ext_vector_type(2)));

constexpr int M = 16384, D = 1024, DEPTH = 2, CHUNK = 64, NCHUNK = M / CHUNK, MEM_LEN = 256;
constexpr int ZC = 6144, INC = 10240, YC = 2048;
constexpr int Z_AX = 0, Z_AG = 512, Z_BQ = 1024, Z_BK = 1536, Z_BV = 2048, Z_CQ = 2560, Z_CK = 3072, Z_CV = 3584, Z_CG = 4096, Z_DQ = 4608, Z_DK = 5120, Z_DV = 5632;
constexpr int NEXP = 32, DEXP = 512;
constexpr int HROWS = M + 256;
constexpr int MAXSLOT = 41216;
constexpr float NORM_EPS = 1e-6f, GN_EPS = 1e-5f;
constexpr float LOG2E = 1.4426950408889634f;

constexpr size_t MiB = 1u << 20;
constexpr size_t WS_CTL = 0, CTL_ZERO_BYTES = 1 * MiB;
constexpr size_t WS_MEMN = 1 * MiB;
constexpr size_t WS_KMEM = 2 * MiB;
constexpr size_t WS_VMEM = 2 * MiB + 512 * 1024;
constexpr size_t WS_WTR = 3 * MiB;
constexpr size_t WS_LRUW = 3 * MiB + 256 * 1024;
constexpr size_t WS_CARA = 4 * MiB;
constexpr size_t WS_CARH = 4 * MiB + 512 * 1024;
constexpr size_t WS_CARI = 5 * MiB;
constexpr size_t WS_QKN = 5 * MiB + 512 * 1024;
constexpr size_t WS_LSE = 6 * MiB + 512 * 1024;
constexpr size_t WS_TOKE = 6 * MiB;
constexpr size_t WS_TOKP = 6 * MiB + 128 * 1024;
constexpr size_t WS_TOKW = 6 * MiB + 256 * 1024;
constexpr size_t WS_ELIST = 8 * MiB;
constexpr size_t WS_WIN = 10 * MiB;
constexpr size_t WS_WBR = 50 * MiB;
constexpr size_t WS_WOUT = 58 * MiB;
constexpr size_t WS_WMQ = 62 * MiB;
constexpr size_t WS_WMK = 64 * MiB;
constexpr size_t WS_WMV = 66 * MiB;
constexpr size_t WS_WMO = 68 * MiB;
constexpr size_t WS_W13 = 70 * MiB;
constexpr size_t WS_W2 = 134 * MiB;
constexpr size_t WS_H = 166 * MiB;
constexpr size_t WS_Y = 200 * MiB;
constexpr size_t WS_KVT = 264 * MiB;
constexpr size_t WS_RT = 296 * MiB;
constexpr size_t WS_OD = 312 * MiB;
constexpr size_t WS_Z = 344 * MiB;
constexpr size_t WS_G = 344 * MiB;
constexpr size_t WS_MRG = 472 * MiB;
constexpr size_t WS_QB = 504 * MiB;
constexpr size_t WS_OB = 520 * MiB;
constexpr size_t WS_HID = 344 * MiB;
constexpr size_t WS_YMOE = 386 * MiB;
constexpr size_t WS_XS1 = 536 * MiB;
constexpr size_t WS_XS2 = 552 * MiB;
constexpr size_t WS_SS = 568 * MiB;
constexpr size_t WS_END = 569 * MiB;
static_assert(WS_HID + (size_t)MAXSLOT * 512 * 2 <= WS_YMOE && WS_YMOE + (size_t)MAXSLOT * 1024 * 2 <= WS_MRG, "moe overlay");
constexpr int CW_TMO = 0, CW_CODE = 1;
constexpr int CW_BAR = 4096;
constexpr int CW_ECNT = 16384;
constexpr int CW_DQ = 24576;

constexpr int LDS_BYTES = 147456;
constexpr int LDS_MISC = 131072;
constexpr int NWAVES = 8, NTHREADS = 512;

__device__ __forceinline__ unsigned f2bf(float f) { unsigned u = __builtin_bit_cast(unsigned, f); return (u + 0x7fffu + ((u >> 16) & 1u)) >> 16; }
__device__ __forceinline__ unsigned pk2(float lo, float hi) { return f2bf(lo) | (f2bf(hi) << 16); }
__device__ __forceinline__ float bf2f(unsigned short b) { return __builtin_bit_cast(float, ((unsigned)b) << 16); }
__device__ __forceinline__ float bflo(unsigned w) { return __builtin_bit_cast(float, w << 16); }
__device__ __forceinline__ float bfhi(unsigned w) { return __builtin_bit_cast(float, w & 0xffff0000u); }
typedef __bf16 bf16x2_t __attribute__((ext_vector_type(2)));
__device__ __forceinline__ unsigned cvt_pk_bf16(float lo, float hi) { const f32x2 v = {lo, hi}; const bf16x2_t b = __builtin_convertvector(v, bf16x2_t); return __builtin_bit_cast(unsigned, b); }
__device__ __forceinline__ float fexp2(float x) { return __builtin_amdgcn_exp2f(x); }
__device__ __forceinline__ float frcp(float x) { return __builtin_amdgcn_rcpf(x); }
__device__ __forceinline__ float sigmoidf_(float x) { return frcp(1.0f + fexp2(-x * LOG2E)); }
__device__ __forceinline__ float wave_sum(float v) {
#pragma unroll
    for (int o = 1; o < 64; o <<= 1) v += __shfl_xor(v, o);
    return v;
}
#define LDS_WAIT() asm volatile("s_waitcnt lgkmcnt(0)" ::: "memory")
#define VM_WAIT() asm volatile("s_waitcnt vmcnt(0)" ::: "memory")

namespace pg8 {
constexpr int BM = 256, BK = 64, HALF = 128, HTB = HALF * BK * 2, STAGE_BYTES = 8 * HTB, NXCD = 8, WGM = 8;
__host__ __device__ __forceinline__ int lds_byte(int r, int c) { const int st = (r >> 4) * 2 + (c >> 5), rr = r & 15, cc = c & 31, ob = rr * 64 + cc * 2; return st * 1024 + (ob ^ (((ob >> 9) & 1) << 5)); }
__host__ __device__ __forceinline__ void stage_rc(int b, int& R, int& C) { const int st = b / 1024, sb = b % 1024, swz = sb ^ (((sb >> 9) & 1) << 5); R = (st >> 1) * 16 + swz / 64; C = (st & 1) * 32 + (swz % 64) / 2; }
__host__ __device__ __forceinline__ int perm32(int rho) { const int n = rho >> 4, i = rho & 15; return 8 * (i >> 2) + 4 * n + (i & 3); }

struct Unit { int arow, acol, brow, pm, pn, aux, gcnt; const int* gl; };
struct Gemm { const bf16* A; const bf16* Bt; int lda, ldb, K, zrow; const float* ss; };

template <class Epi, class Sched, bool GATHER>
__device__ __forceinline__ void gemm_phase(LAS unsigned char* lds, const Gemm g, const Sched& S, const Epi& E, const int tid) {
    const int wid = __builtin_amdgcn_readfirstlane(tid >> 6), lane = tid & 63, wr = wid >> 2, wc = wid & 3, fr = lane & 15, fq = lane >> 4;
    const int K = g.K, nt = K / BK;
    unsigned voffA[2][2], voffB[2];
#pragma unroll
    for (int i = 0; i < 2; ++i) { int R, C; stage_rc(tid * 16 + i * 8192, R, C); const int Rb = Epi::PERM ? ((R & ~31) + perm32(R & 31)) : R;
        voffA[0][i] = (unsigned)(R * g.lda + C) * 2u; voffA[1][i] = voffA[0][i]; voffB[i] = (unsigned)(Rb * g.ldb + C) * 2u; }
    const size_t kstep = (size_t)(BK * 2);
    const size_t hstepA = GATHER ? (size_t)0 : (size_t)HALF * g.lda * 2;
    const size_t hstepB = (size_t)HALF * g.ldb * 2;
    const unsigned ldsw = (unsigned)wid * 1024u;
    const int aoff = lds_byte(wr * 64 + fr, fq * 8), boff = lds_byte(wc * 32 + fr, fq * 8);
#define PG8_SA(b, h) (((b) * 2 + (h)) * HTB)
#define PG8_SB(b, h) ((4 + (b) * 2 + (h)) * HTB)
#define PG8_STAGE(bufoff, gbase, voff) do { _Pragma("unroll") for (int _i = 0; _i < 2; ++_i) \
        __builtin_amdgcn_global_load_lds((const unsigned*)((const char*)(gbase) + (voff)[_i]), (LAS unsigned*)(lds + (bufoff) + ldsw + _i * 8192), 16, 0, 0); } while (0)
#define PG8_LDA(dst, b, h) do { _Pragma("unroll") for (int m = 0; m < 4; ++m) _Pragma("unroll") for (int k = 0; k < 2; ++k) dst[m][k] = *(const LAS bf16x8*)(lds + PG8_SA(b, h) + aoff + m * 2048 + k * 1024); } while (0)
#define PG8_LDB(dst, b, h) do { _Pragma("unroll") for (int n = 0; n < 2; ++n) _Pragma("unroll") for (int k = 0; k < 2; ++k) dst[n][k] = *(const LAS bf16x8*)(lds + PG8_SB(b, h) + boff + n * 2048 + k * 1024); } while (0)
#define PG8_MMA(ai, bj, At, Bt) do { __builtin_amdgcn_s_setprio(1); _Pragma("unroll") for (int m = 0; m < 4; ++m) _Pragma("unroll") for (int n = 0; n < 2; ++n) _Pragma("unroll") for (int k = 0; k < 2; ++k) \
        acc[ai][bj][m][n] = __builtin_amdgcn_mfma_f32_16x16x32_bf16(Bt[n][k], At[m][k], acc[ai][bj][m][n], 0, 0, 0); __builtin_amdgcn_s_setprio(0); } while (0)
#define PG8_WAIT_V(n) asm volatile("s_waitcnt vmcnt(" #n ")" ::: "memory")
#define PG8_WAIT_L(n) asm volatile("s_waitcnt lgkmcnt(" #n ")" ::: "memory")
#define PG8_BAR __builtin_amdgcn_s_barrier()
#define PG8_SCHED __builtin_amdgcn_sched_barrier(0)
#define PG8_SETA(u) do { if constexpr (GATHER) { _Pragma("unroll") for (int _h = 0; _h < 2; ++_h) _Pragma("unroll") for (int _i = 0; _i < 2; ++_i) { \
        int _R, _C; stage_rc(tid * 16 + _i * 8192, _R, _C); const int _r = _h * HALF + _R; const int _row = (_r < (u).gcnt) ? (u).gl[_r] : g.zrow; \
        voffA[_h][_i] = ((unsigned)_row * (unsigned)g.lda + (unsigned)_C) * 2u; } } } while (0)
#define PG8_ABASE(u) (GATHER ? (const char*)g.A : (const char*)g.A + ((size_t)(u).arow * g.lda + (u).acol) * 2)
    LAS float* rstab = (LAS float*)(lds + STAGE_BYTES + 12288);
#define PG8_RSTAB(u, par) do { if constexpr (Epi::RS) { if (tid < 256) { int _row; if constexpr (GATHER) { _row = (tid < (u).gcnt) ? (u).gl[tid] : -1; } else { _row = (u).arow + tid; } \
        float _v = 0.f; if (_row >= 0) { const f32x4* _p = (const f32x4*)(g.ss + (size_t)_row * 16); const f32x4 _a = _p[0], _b = _p[1], _c = _p[2], _d = _p[3]; \
            const float _s = (((_a[0] + _a[1]) + (_a[2] + _a[3])) + ((_b[0] + _b[1]) + (_b[2] + _b[3]))) + (((_c[0] + _c[1]) + (_c[2] + _c[3])) + ((_d[0] + _d[1]) + (_d[2] + _d[3]))); \
            _v = 1.0f / sqrtf(_s * (1.0f / 1024.0f) + 1e-6f); } \
        rstab[(par) * 256 + tid] = _v; } } } while (0)
    Unit cur, nxt; int ui = 0;
    if (!S.next(0, cur)) return;
    PG8_RSTAB(cur, 0);
    f32x4 acc[2][2][4][2];
#pragma unroll
    for (int a = 0; a < 2; ++a)
#pragma unroll
        for (int b = 0; b < 2; ++b)
#pragma unroll
            for (int m = 0; m < 4; ++m)
#pragma unroll
                for (int n = 0; n < 2; ++n) acc[a][b][m][n] = (f32x4){0.f, 0.f, 0.f, 0.f};
    bf16x8 At[4][2], B0[2][2], B1[2][2];
    PG8_SETA(cur);
    const char* cA = PG8_ABASE(cur);
    const char* cB = (const char*)g.Bt + (size_t)cur.brow * g.ldb * 2;
    PG8_STAGE(PG8_SB(0, 0), cB, voffB); PG8_STAGE(PG8_SB(0, 1), cB + hstepB, voffB); PG8_STAGE(PG8_SA(0, 0), cA, voffA[0]); PG8_STAGE(PG8_SA(0, 1), cA + hstepA, voffA[1]);
    if (wr == 1) PG8_BAR;
    PG8_WAIT_V(2); PG8_BAR;
    PG8_STAGE(PG8_SB(1, 0), cB + kstep, voffB); PG8_STAGE(PG8_SA(1, 0), cA + kstep, voffA[0]); PG8_STAGE(PG8_SB(1, 1), cB + hstepB + kstep, voffB);
    PG8_WAIT_V(6); PG8_BAR;
    for (;;) {
        const bool has_next = S.next(ui + 1, nxt);
        const char* nA = has_next ? PG8_ABASE(nxt) : cA; const char* nB = has_next ? (const char*)g.Bt + (size_t)nxt.brow * g.ldb * 2 : cB;
        for (int t = 0; t < nt; t += 2) {
            const bool last = (t == nt - 2);
            const char* a1 = cA + (size_t)(t + 1) * kstep;
            const char* a2 = last ? nA : cA + (size_t)(t + 2) * kstep; const char* b2 = last ? nB : cB + (size_t)(t + 2) * kstep;
            const char* a3 = a2 + kstep; const char* b3 = b2 + kstep;
            PG8_LDB(B0, 0, 0); PG8_LDB(B1, 0, 1); PG8_SCHED; PG8_LDA(At, 0, 0); PG8_STAGE(PG8_SA(1, 1), a1 + hstepA, voffA[1]);
            if (last && has_next) { PG8_SETA(nxt); }
            PG8_WAIT_V(8); PG8_WAIT_L(0); PG8_BAR; PG8_MMA(0, 0, At, B0); PG8_MMA(0, 1, At, B1); PG8_BAR; PG8_SCHED;
            PG8_LDA(At, 0, 1); PG8_STAGE(PG8_SB(0, 0), b2, voffB); PG8_STAGE(PG8_SB(0, 1), b2 + hstepB, voffB); PG8_STAGE(PG8_SA(0, 0), a2, voffA[0]);
            PG8_WAIT_V(8); PG8_WAIT_L(0); PG8_BAR; PG8_MMA(1, 0, At, B0); PG8_MMA(1, 1, At, B1); PG8_BAR; PG8_SCHED;
            PG8_LDB(B0, 1, 0); PG8_LDB(B1, 1, 1); PG8_SCHED; PG8_LDA(At, 1, 0); PG8_STAGE(PG8_SA(0, 1), a2 + hstepA, voffA[1]);
            PG8_WAIT_V(8); PG8_WAIT_L(0); PG8_BAR; PG8_MMA(0, 0, At, B0); PG8_MMA(0, 1, At, B1); PG8_BAR; PG8_SCHED;
            PG8_LDA(At, 1, 1); PG8_STAGE(PG8_SB(1, 0), b3, voffB); PG8_STAGE(PG8_SB(1, 1), b3 + hstepB, voffB); PG8_STAGE(PG8_SA(1, 0), a3, voffA[0]);
            PG8_WAIT_V(8); PG8_WAIT_L(0); PG8_BAR; PG8_MMA(1, 0, At, B0); PG8_MMA(1, 1, At, B1); PG8_BAR; PG8_SCHED;
        }
        if (wr == 0) PG8_BAR;
        E(acc, cur, wr, wc, fr, fq, rstab + (ui & 1) * 256);
        if (!has_next) break;
        if (!(Epi::CHAIN && nxt.aux != 0)) {
#pragma unroll
        for (int a = 0; a < 2; ++a)
#pragma unroll
            for (int b = 0; b < 2; ++b)
#pragma unroll
                for (int m = 0; m < 4; ++m)
#pragma unroll
                    for (int n = 0; n < 2; ++n) acc[a][b][m][n] = (f32x4){0.f, 0.f, 0.f, 0.f};
        }
        cur = nxt; cA = nA; cB = nB; ++ui;
        PG8_RSTAB(cur, ui & 1);
        if (wr == 1) PG8_BAR;
    }
    PG8_WAIT_V(0);
    PG8_BAR;
#undef PG8_SA
#undef PG8_SB
#undef PG8_STAGE
#undef PG8_LDA
#undef PG8_LDB
#undef PG8_MMA
#undef PG8_WAIT_V
#undef PG8_WAIT_L
#undef PG8_BAR
#undef PG8_SCHED
#undef PG8_SETA
#undef PG8_ABASE
#undef PG8_RSTAB
}

struct GridOrder {
    int nM, nN, nwg, G, c, arow0, acol, brow0;
    __device__ void init(int nM_, int nN_, int G_, int c_, int arow0_ = 0, int acol_ = 0, int brow0_ = 0) { nM = nM_; nN = nN_; nwg = nM * nN; G = G_; c = c_; arow0 = arow0_; acol = acol_; brow0 = brow0_; }
    __device__ __forceinline__ bool next(int i, Unit& u) const {
        const long L = (long)i * G + c; if (L >= nwg) return false;
        int wgid = (int)L; { const int q = nwg / NXCD, r = nwg % NXCD, xcd = wgid % NXCD, off = wgid / NXCD; wgid = (xcd < r ? xcd * (q + 1) : r * (q + 1) + (xcd - r) * q) + off; }
        const int nig = WGM * nN, gid = wgid / nig, fm = gid * WGM, gsz = (nM - fm) < WGM ? (nM - fm) : WGM;
        u.pm = fm + ((wgid % nig) % gsz); u.pn = (wgid % nig) / gsz;
        u.arow = arow0 + u.pm * BM; u.acol = acol; u.brow = brow0 + u.pn * BM; u.aux = 0; u.gcnt = 0; u.gl = nullptr; return true;
    }
};
struct BranchOrder {
    int G, c;
    __device__ __forceinline__ bool next(int i, Unit& u) const {
        const int tile = (i >> 2) * G + c, b = i & 3; if (tile >= 256) return false;
        u.pm = tile >> 2; u.pn = tile & 3; u.arow = u.pm * BM; u.acol = b * 512; u.brow = b * 1024 + u.pn * BM; u.aux = b; u.gcnt = 0; u.gl = nullptr; return true;
    }
};
struct MoeOrder {
    const LAS int* tab; int G, c, nct, brows; const int* elist; const unsigned* ecnt;
    __device__ __forceinline__ bool next(int i, Unit& u) const {
        const int L = i * G + c, nrt = tab[0]; if (L >= nrt * nct) return false;
        const int j = L / nct, ct = L % nct; const int e = tab[16 + 4 * j], rt = tab[16 + 4 * j + 1], st = tab[16 + 4 * j + 2];
        u.pm = st; u.pn = ct; u.arow = st * BM; u.acol = 0; u.brow = e * brows + ct * BM; u.aux = e;
        const int cnt = (int)ecnt[64 * e]; u.gcnt = cnt - rt * BM; u.gl = elist + e * 16384 + rt * BM; return true;
    }
};

template <int ACT  , bool RS_ = false> struct EpiBf16 {
    static constexpr bool PERM = true, RS = RS_, CHAIN = false;
    bf16* O; int ldc;
    __device__ __forceinline__ void operator()(const f32x4 (&acc)[2][2][4][2], const Unit& u, int wr, int wc, int fr, int fq, const LAS float* rst) const {
        const int row0 = u.pm * BM + wr * 64 + fr, col0 = u.pn * BM + wc * 32 + 8 * fq;
#pragma unroll
        for (int ai = 0; ai < 2; ++ai)
#pragma unroll
            for (int m = 0; m < 4; ++m) { bf16* rowp = O + (size_t)(row0 + ai * HALF + m * 16) * ldc + col0;
#pragma unroll
                for (int bj = 0; bj < 2; ++bj) { f32x4 v0 = acc[ai][bj][m][0], v1 = acc[ai][bj][m][1];
                    if (RS_) { const float rs = rst[ai * HALF + wr * 64 + m * 16 + fr]; v0 = v0 * rs; v1 = v1 * rs; }
                    if (ACT == 1) {
#pragma unroll
                        for (int j = 0; j < 4; ++j) { v0[j] = fminf(1.0f + fexp2(-v0[j] * LOG2E), 1.0e30f); v1[j] = fminf(1.0f + fexp2(-v1[j] * LOG2E), 1.0e30f); } }
                    u32x4 w; w.x = cvt_pk_bf16(v0[0], v0[1]); w.y = cvt_pk_bf16(v0[2], v0[3]); w.z = cvt_pk_bf16(v1[0], v1[1]); w.w = cvt_pk_bf16(v1[2], v1[3]);
                    __builtin_nontemporal_store(w, (u32x4*)(rowp + bj * HALF)); } }
    }
};
struct EpiGateChain {
    static constexpr bool PERM = true, RS = false, CHAIN = true;
    const bf16* U; bf16* Mg;
    __device__ __forceinline__ void operator()(f32x4 (&acc)[2][2][4][2], const Unit& u, int wr, int wc, int fr, int fq, const LAS float*) const {
        const int row0 = u.pm * BM + wr * 64 + fr, col0 = u.pn * BM + wc * 32 + 8 * fq, b = u.aux;
        const bf16* __restrict__ up = U + (size_t)row0 * 4096 + b * 1024 + col0;
        if (b < 3) {
            u32x4 ub[2][2][2], un[2][2][2];
#define EGC_LOAD(q, s_) do { _Pragma("unroll") for (int mm = 0; mm < 2; ++mm) _Pragma("unroll") for (int bj = 0; bj < 2; ++bj) { \
                const bf16* p = up + (size_t)(((q) >> 1) * HALF + (2 * ((q) & 1) + mm) * 16) * 4096 + bj * HALF; ub[s_][mm][bj] = *(const u32x4*)p; un[s_][mm][bj] = *(const u32x4*)(p + 1024); } } while (0)
#define EGC_CALC(q, s_) do { _Pragma("unroll") for (int mm = 0; mm < 2; ++mm) _Pragma("unroll") for (int bj = 0; bj < 2; ++bj) { const u32x4 d = ub[s_][mm][bj], n_ = un[s_][mm][bj]; \
                f32x4& v0 = acc[(q) >> 1][bj][2 * ((q) & 1) + mm][0]; f32x4& v1 = acc[(q) >> 1][bj][2 * ((q) & 1) + mm][1]; \
                v0[0] *= bflo(n_.x) * frcp(bflo(d.x)); v0[1] *= bfhi(n_.x) * frcp(bfhi(d.x)); v0[2] *= bflo(n_.y) * frcp(bflo(d.y)); v0[3] *= bfhi(n_.y) * frcp(bfhi(d.y)); \
                v1[0] *= bflo(n_.z) * frcp(bflo(d.z)); v1[1] *= bfhi(n_.z) * frcp(bfhi(d.z)); v1[2] *= bflo(n_.w) * frcp(bflo(d.w)); v1[3] *= bfhi(n_.w) * frcp(bfhi(d.w)); } } while (0)
            EGC_LOAD(0, 0); EGC_LOAD(1, 1); asm volatile("" ::: "memory");
            EGC_CALC(0, 0); asm volatile("" ::: "memory"); EGC_LOAD(2, 0); asm volatile("" ::: "memory");
            EGC_CALC(1, 1); asm volatile("" ::: "memory"); EGC_LOAD(3, 1); asm volatile("" ::: "memory");
            EGC_CALC(2, 0); EGC_CALC(3, 1);
#undef EGC_LOAD
#undef EGC_CALC
        } else {
#pragma unroll
            for (int ai = 0; ai < 2; ++ai) {
                u32x4 ub[4][2];
#pragma unroll
                for (int m = 0; m < 4; ++m)
#pragma unroll
                    for (int bj = 0; bj < 2; ++bj) ub[m][bj] = *(const u32x4*)(up + (size_t)(ai * HALF + m * 16) * 4096 + bj * HALF);
#pragma unroll
                for (int m = 0; m < 4; ++m) { bf16* rowp = Mg + (size_t)(row0 + ai * HALF + m * 16) * 1024 + col0;
#pragma unroll
                    for (int bj = 0; bj < 2; ++bj) { const u32x4 d = ub[m][bj]; const f32x4 v0 = acc[ai][bj][m][0], v1 = acc[ai][bj][m][1]; u32x4 w;
                        w.x = cvt_pk_bf16(v0[0] * frcp(bflo(d.x)), v0[1] * frcp(bfhi(d.x))); w.y = cvt_pk_bf16(v0[2] * frcp(bflo(d.y)), v0[3] * frcp(bfhi(d.y)));
                        w.z = cvt_pk_bf16(v1[0] * frcp(bflo(d.z)), v1[1] * frcp(bfhi(d.z))); w.w = cvt_pk_bf16(v1[2] * frcp(bflo(d.w)), v1[3] * frcp(bfhi(d.w)));
                        __builtin_nontemporal_store(w, (u32x4*)(rowp + bj * HALF)); } } }
        }
    }
};
struct EpiRes16 {
    static constexpr bool PERM = true, RS = false, CHAIN = false;
    const float* base32; bf16* xb; int ldc; float* ss;
    __device__ __forceinline__ void operator()(const f32x4 (&acc)[2][2][4][2], const Unit& u, int wr, int wc, int fr, int fq, const LAS float*) const {
        const int row0 = u.pm * BM + wr * 64 + fr, col0 = u.pn * BM + wc * 32 + 8 * fq;
#pragma unroll
        for (int ai = 0; ai < 2; ++ai) {
            f32x4 b0[4][2], b1[4][2];
#pragma unroll
            for (int m = 0; m < 4; ++m) { const size_t off = (size_t)(row0 + ai * HALF + m * 16) * ldc + col0;
#pragma unroll
                for (int bj = 0; bj < 2; ++bj) {
                    if (base32) { b0[m][bj] = *(const f32x4*)(base32 + off + bj * HALF); b1[m][bj] = *(const f32x4*)(base32 + off + bj * HALF + 4); }
                    else { const u32x4 w = *(const u32x4*)(xb + off + bj * HALF); b0[m][bj] = (f32x4){bflo(w.x), bfhi(w.x), bflo(w.y), bfhi(w.y)}; b1[m][bj] = (f32x4){bflo(w.z), bfhi(w.z), bflo(w.w), bfhi(w.w)}; } } }
#pragma unroll
            for (int m = 0; m < 4; ++m) { const int row = row0 + ai * HALF + m * 16; const size_t off = (size_t)row * ldc + col0; float sq = 0.f;
#pragma unroll
                for (int bj = 0; bj < 2; ++bj) { const f32x4 v0 = b0[m][bj] + acc[ai][bj][m][0], v1 = b1[m][bj] + acc[ai][bj][m][1];
                    u32x4 w; w.x = cvt_pk_bf16(v0[0], v0[1]); w.y = cvt_pk_bf16(v0[2], v0[3]); w.z = cvt_pk_bf16(v1[0], v1[1]); w.w = cvt_pk_bf16(v1[2], v1[3]);
                    __builtin_nontemporal_store(w, (u32x4*)(xb + off + bj * HALF));
                    const float r0 = bflo(w.x), r1 = bfhi(w.x), r2 = bflo(w.y), r3 = bfhi(w.y), r4 = bflo(w.z), r5 = bfhi(w.z), r6 = bflo(w.w), r7 = bfhi(w.w);
                    sq += ((r0 * r0 + r1 * r1) + (r2 * r2 + r3 * r3)) + ((r4 * r4 + r5 * r5) + (r6 * r6 + r7 * r7)); }
                sq += __shfl_xor(sq, 16); sq += __shfl_xor(sq, 32);
                if (fq == 0) ss[(size_t)row * 16 + u.pn * 4 + wc] = sq; }
            asm volatile("" ::: "memory"); }
    }
};
struct EpiSwiGlu {
    static constexpr bool PERM = true, RS = true, CHAIN = false;
    bf16* Hd;
    __device__ __forceinline__ void operator()(const f32x4 (&acc)[2][2][4][2], const Unit& u, int wr, int wc, int fr, int fq, const LAS float* rst) const {
        const int row0 = u.pm * BM + wr * 64 + fr, col0 = u.pn * HALF + wc * 32 + 8 * fq;
#pragma unroll
        for (int ai = 0; ai < 2; ++ai)
#pragma unroll
            for (int m = 0; m < 4; ++m) { bf16* rowp = Hd + (size_t)(row0 + ai * HALF + m * 16) * DEXP + col0;
                f32x4 o0, o1; const float rs = rst[ai * HALF + wr * 64 + m * 16 + fr];
#pragma unroll
                for (int j = 0; j < 4; ++j) { const float a0 = acc[ai][0][m][0][j] * rs, a1 = acc[ai][0][m][1][j] * rs;
                    o0[j] = a0 * sigmoidf_(a0) * (acc[ai][1][m][0][j] * rs); o1[j] = a1 * sigmoidf_(a1) * (acc[ai][1][m][1][j] * rs); }
                u32x4 w; w.x = cvt_pk_bf16(o0[0], o0[1]); w.y = cvt_pk_bf16(o0[2], o0[3]); w.z = cvt_pk_bf16(o1[0], o1[1]); w.w = cvt_pk_bf16(o1[2], o1[3]);
                __builtin_nontemporal_store(w, (u32x4*)rowp); }
    }
};
}

#define XB_TMO      128
#define XB_XCNT(j)  (256  + 64 * (j))
#define XB_XSUB(j)  (1280 + 64 * (j))
#define XB_XGEN(j)  (2304 + 64 * (j))
#define XB_TOP      3328
#define XB_TOPGEN   3392
#define XCD_BAR_WORDS 3456
#define XB_SPIN_CAP (1u << 20)
__device__ __forceinline__ unsigned xb_ld(unsigned* p)              { return __hip_atomic_load(p, __ATOMIC_RELAXED, __HIP_MEMORY_SCOPE_AGENT); }
__device__ __forceinline__ unsigned xb_add(unsigned* p, unsigned v) { return __hip_atomic_fetch_add(p, v, __ATOMIC_RELAXED, __HIP_MEMORY_SCOPE_AGENT); }
__device__ __forceinline__ unsigned xb_xcc_id() { return (unsigned)__builtin_amdgcn_s_getreg((3 << 11) | 20) & 0xFu; }
#define XB_SPIN(cond, bar) do { unsigned _sp = 0; while (cond) { __builtin_amdgcn_s_sleep(1); \
    if ((++_sp & 255u) == 0u) { if (xb_ld(&(bar)[XB_TMO])) break; if (_sp > XB_SPIN_CAP) { atomicAdd(&(bar)[XB_TMO], 1u); break; } } } } while (0)
struct XcdBarrier { unsigned* bar; unsigned x; volatile LAS unsigned* st; };
__device__ __forceinline__ XcdBarrier xcd_barrier_post(unsigned* bar, volatile LAS unsigned* st) {
    XcdBarrier b; b.bar = bar; b.x = xb_xcc_id(); b.st = st;
    if (threadIdx.x == 0) (void)xb_add(&bar[XB_XCNT(b.x)], 1u);
    return b;
}
__device__ __forceinline__ void xcd_barrier_complete(unsigned* bar, unsigned x, unsigned& nloc, unsigned& nx) {
    const unsigned G = gridDim.x * gridDim.y * gridDim.z;
    unsigned sum, cnt, mine, sp = 0u;
    for (;;) {
        sum = 0u; cnt = 0u; mine = 0u;
#pragma unroll
        for (unsigned j = 0; j < 16; ++j) { const unsigned c = xb_ld(&bar[XB_XCNT(j)]); sum += c; cnt += (c > 0u) ? 1u : 0u; mine = (j == x) ? c : mine; }
        if (sum == G) break;
        __builtin_amdgcn_s_sleep(1);
        if ((++sp & 255u) == 0u) { if (xb_ld(&bar[XB_TMO])) break; if (sp > XB_SPIN_CAP) { atomicAdd(&bar[XB_TMO], 1u); break; } }
    }
    nloc = mine > 0u ? mine : 1u; nx = cnt > 0u ? cnt : 1u;
}
__device__ __forceinline__ void xcd_barrier(const XcdBarrier& b) {
    asm volatile("s_waitcnt vmcnt(0)" ::: "memory");
    __syncthreads();
    if (threadIdx.x == 0) {
        unsigned* bar = b.bar;
        __builtin_amdgcn_s_waitcnt(0);
        unsigned nloc = b.st[0], nx = b.st[1];
        if (nloc == 0u) { xcd_barrier_complete(bar, b.x, nloc, nx); b.st[0] = nloc; b.st[1] = nx; }
        const unsigned old = xb_add(&bar[XB_XSUB(b.x)], 1u);
        const unsigned gen = old / nloc;
        if (old + 1u == (gen + 1u) * nloc) {
            __builtin_amdgcn_fence(__ATOMIC_RELEASE, "agent");
            asm volatile("s_waitcnt vmcnt(0)" ::: "memory");
            const unsigned og = xb_add(&bar[XB_TOP], 1u);
            const unsigned tg = og / nx;
            if (og + 1u == (tg + 1u) * nx) xb_add(&bar[XB_TOPGEN], 1u);
            else XB_SPIN(xb_ld(&bar[XB_TOPGEN]) == tg, bar);
            __builtin_amdgcn_fence(__ATOMIC_ACQUIRE, "agent");
            xb_add(&bar[XB_XGEN(b.x)], 1u);
            asm volatile("s_waitcnt vmcnt(0)" ::: "memory");
        } else {
            XB_SPIN(xb_ld(&bar[XB_XGEN(b.x)]) == gen, bar);
            __builtin_amdgcn_fence(__ATOMIC_ACQUIRE, "agent");
            asm volatile("s_waitcnt vmcnt(0)" ::: "memory");
        }
    }
    __syncthreads();
}

struct Args {
    const float* in[31]; float* out; unsigned char* ws; int ph_lo, ph_hi;
};
enum InIdx { I_X = 0, I_MEM, I_NORM_MIX, I_W_IN, I_CONV_W, I_CONV_B, I_LRU_WA, I_LRU_BA, I_LRU_WX, I_LRU_BX, I_LRU_LAMBDA, I_CA_REL, I_DIFF_LAMBDA, I_DIFF_SUBLN,
             I_W_BRANCH, I_W_OUT, I_NORM_MEM, I_MEM_NORM, I_W_MQ, I_W_MK, I_W_MV, I_W_MO, I_NORM_FFN, I_W_GROUP, I_B_GROUP, I_W_ROUTER, I_B_ROUTER, I_W1, I_W3, I_W2, I_FINAL_NORM };

struct TrIt { const float* W; bf16* WT; const float* gk; int K, N, row_off, item; float sc; };
__device__ __forceinline__ void tr_load(const TrIt& t, int lane, f32x4 (&v)[8]) {
    const int nblk = t.N / 32, kb = t.item / nblk, nb = t.item % nblk, k0 = 64 * kb, n0 = 32 * nb, c = lane & 7;
#pragma unroll
    for (int i = 0; i < 8; ++i) v[i] = __builtin_nontemporal_load((const f32x4*)(t.W + (size_t)(k0 + 8 * i + (lane >> 3)) * t.N + n0 + 4 * c));
}
__device__ __forceinline__ void tr_finish(const TrIt& t, const f32x4 (&v)[8], LAS float* scr, int lane) {
    const int nblk = t.N / 32, kb = t.item / nblk, nb = t.item % nblk, k0 = 64 * kb, n0 = 32 * nb, c = lane & 7;
    f32x4 g0 = (f32x4){t.sc, t.sc, t.sc, t.sc}, g1 = g0;
    if (t.gk) { g0 = *(const f32x4*)(t.gk + k0 + 8 * c) * t.sc; g1 = *(const f32x4*)(t.gk + k0 + 8 * c + 4) * t.sc; }
#pragma unroll
    for (int i = 0; i < 8; ++i) { LAS float* d = scr + (8 * i + (lane >> 3)) * 33 + 4 * c; d[0] = v[i].x; d[1] = v[i].y; d[2] = v[i].z; d[3] = v[i].w; }
    LDS_WAIT(); asm volatile("" ::: "memory");
#pragma unroll
    for (int j = 0; j < 4; ++j) { const int n = (lane >> 3) + 8 * j; const LAS float* s = scr + (8 * c) * 33 + n;
        u32x4 o; o.x = pk2(s[0 * 33] * g0[0], s[1 * 33] * g0[1]); o.y = pk2(s[2 * 33] * g0[2], s[3 * 33] * g0[3]); o.z = pk2(s[4 * 33] * g1[0], s[5 * 33] * g1[1]); o.w = pk2(s[6 * 33] * g1[2], s[7 * 33] * g1[3]);
        __builtin_nontemporal_store(o, (u32x4*)(t.WT + (size_t)(t.row_off + n0 + n) * t.K + k0 + 8 * c)); }
    LDS_WAIT(); asm volatile("" ::: "memory");
}
__device__ __forceinline__ void rms_row_to_bf16(const float* xrow, const float* g, bf16* orow, int lane) {
    const f32x4* xr = (const f32x4*)xrow + lane; const f32x4* gr = (const f32x4*)g + lane;
    f32x4 v[4]; float s = 0.f;
#pragma unroll
    for (int j = 0; j < 4; ++j) { v[j] = xr[64 * j]; s += (v[j].x * v[j].x + v[j].y * v[j].y) + (v[j].z * v[j].z + v[j].w * v[j].w); }
    const float rstd = 1.f / sqrtf(wave_sum(s) * (1.f / D) + NORM_EPS);
    unsigned long long* o8 = (unsigned long long*)orow + lane;
#pragma unroll
    for (int j = 0; j < 4; ++j) { const f32x4 gg = gr[64 * j];
        o8[64 * j] = (unsigned long long)pk2(v[j].x * rstd * gg.x, v[j].y * rstd * gg.y) | ((unsigned long long)pk2(v[j].z * rstd * gg.z, v[j].w * rstd * gg.w) << 32); }
}
__device__ __forceinline__ TrIt expert_item(const float* w1, const float* w3, const float* w2, const float* gk, bf16* W13, bf16* W2T, int it) {
    constexpr int I_13 = (D / 64) * (DEXP / 32);
    constexpr int I_2 = (DEXP / 64) * (D / 32);
    const int e = it / (2 * I_13 + I_2); int r = it % (2 * I_13 + I_2);
    if (r < 2 * I_13) { const int which = r / I_13; r %= I_13; const int nb = r % (DEXP / 32), n0 = nb * 32;
        const int row_off = (n0 / 128) * 256 + which * 128 + (n0 % 128) - n0;
        return TrIt{(which ? w3 : w1) + (size_t)e * D * DEXP, W13 + (size_t)e * 1024 * 1024, gk, D, DEXP, row_off, r, 1.0f}; }
    r -= 2 * I_13; return TrIt{w2 + (size_t)e * DEXP * D, W2T + (size_t)e * 1024 * 512, nullptr, DEXP, D, 0, r, 1.0f};
}
constexpr int CVT_ITEMS = NEXP * 768, CVT_PER_UNIT = 24, CVT_UNITS = CVT_ITEMS / CVT_PER_UNIT;

namespace att {
typedef short v4i16_t __attribute__((ext_vector_type(4)));
__device__ __forceinline__ s16x4 vtr(const LAS char* p) { return __builtin_bit_cast(s16x4, __builtin_amdgcn_ds_read_tr16_b64_v4i16((LAS v4i16_t*)p)); }
__device__ __forceinline__ int crow(int r, int hi) { return (r & 3) + 8 * (r >> 2) + 4 * hi; }
__device__ __forceinline__ float xmax(float v) { auto rr = __builtin_amdgcn_permlane32_swap(__float_as_uint(v), __float_as_uint(v), false, false); return fmaxf(__uint_as_float(rr[0]), __uint_as_float(rr[1])); }
__device__ __forceinline__ float xsum(float v) { auto rr = __builtin_amdgcn_permlane32_swap(__float_as_uint(v), __float_as_uint(v), false, false); return __uint_as_float(rr[0]) + __uint_as_float(rr[1]); }
__device__ __forceinline__ bf16x8 vfrag(const LAS char* p) { const s16x4 lo = vtr(p), hi = vtr(p + 512); return (bf16x8){lo[0], lo[1], lo[2], lo[3], hi[0], hi[1], hi[2], hi[3]}; }
__device__ __forceinline__ int vbase(int lane) { const int hi = lane >> 5; return ((lane >> 4) & 1) * 32 + (lane & 3) * 8 + (4 * hi + ((lane & 15) >> 2)) * 64; }
__device__ __forceinline__ bf16x8 pack8(const f32x16& p, int r0) {
    u32x4 w; w.x = cvt_pk_bf16(p[r0], p[r0 + 1]); w.y = cvt_pk_bf16(p[r0 + 2], p[r0 + 3]); w.z = cvt_pk_bf16(p[r0 + 4], p[r0 + 5]); w.w = cvt_pk_bf16(p[r0 + 6], p[r0 + 7]);
    return __builtin_bit_cast(bf16x8, w);
}

struct AttnP {
    const bf16* Q; const bf16* K; const bf16* V; bf16* O; int ldq, ldk, ldv, ldo;
    int q0;
    int t_begin, t_end;
    float slope2;
    int dmax;
    const LAS float* tab;
    float* lse;
};
template <int DQK, int DV, int MODE> struct Lay { static constexpr int KCH = DQK / 8 + (MODE == 2 ? 1 : 0), KB = KCH * 1024, VB = DV * 128, K0 = 0, V0 = 3 * KB, WSF = V0 + 3 * VB, END = WSF + 8 * 64 * 4; };

template <int DQK, int DV, int MODE>
__device__ __forceinline__ void attn_unit(LAS char* lds, const AttnP& P, const int tid) {
    typedef Lay<DQK, DV, MODE> L;
    constexpr int NKP = DQK / 64, NVP = DV / 64, NQ0 = DQK / 16, ND0 = NQ0 + (MODE == 2 ? 1 : 0), NDB = DV / 32;
    const int lane = tid & 63, r32 = lane & 31, hi = lane >> 5; const int wid = __builtin_amdgcn_readfirstlane(tid >> 6);
    const int qrow0 = P.q0 + 32 * wid;
    const int cq = qrow0 >> 6;
    int wlo = P.t_begin, whi = P.t_end - 1;
    if (MODE == 1) { wlo = cq - 8 < 0 ? 0 : cq - 8; whi = cq; }
    if (MODE == 2) { const int a = qrow0 - P.dmax; wlo = a > 0 ? (a >> 6) : 0; if (wlo < P.t_begin) wlo = P.t_begin; whi = cq; }
    LAS float* wsf = (LAS float*)(lds + L::WSF) + wid * 64;
    bf16x8 qr[ND0];
#pragma unroll
    for (int d0 = 0; d0 < NQ0; ++d0) qr[d0] = *(const bf16x8*)(P.Q + (size_t)(qrow0 + r32) * P.ldq + d0 * 16 + hi * 8);
    if (MODE == 2) { const u32x4 one = (u32x4){hi == 0 ? 0x3f803f80u : 0u, 0u, 0u, 0u}; qr[ND0 - 1] = __builtin_bit_cast(bf16x8, one);
        if (tid < 192) { const int b = tid >> 6, key = tid & 63; const float bv = P.slope2 * (float)key; const unsigned bh = f2bf(bv); const unsigned bl = f2bf(bv - bflo(bh));
            *(LAS u32x4*)(lds + L::K0 + b * L::KB + 8 * 1024 + key * 16) = (u32x4){bh | (bl << 16), 0u, 0u, 0u}; } }
    f32x16 o[NDB];
#pragma unroll
    for (int db = 0; db < NDB; ++db) o[db] = (f32x16){};
    float mrun = 0.f, lrun = 0.f; bool first = true;
    const int qpos = qrow0 + r32;
    constexpr int NP = NKP + NVP;
#define ATT_DMA(t, buf) do { _Pragma("unroll") for (int i_ = 0; i_ < NKP; ++i_) \
            __builtin_amdgcn_global_load_lds((const unsigned*)(P.K + (size_t)(64 * (t) + lane) * P.ldk + (wid + 8 * i_) * 8), (LAS unsigned*)(lds + L::K0 + (buf) * L::KB + (wid + 8 * i_) * 1024), 16, 0, 0); \
        _Pragma("unroll") for (int i_ = 0; i_ < NVP; ++i_) { const int p_ = wid + 8 * i_, db_ = p_ >> 2, rg_ = p_ & 3; \
            __builtin_amdgcn_global_load_lds((const unsigned*)(P.V + (size_t)(64 * (t) + 16 * rg_ + (lane >> 2)) * P.ldv + 32 * db_ + (lane & 3) * 8), (LAS unsigned*)(lds + L::V0 + (buf) * L::VB + p_ * 1024), 16, 0, 0); } } while (0)
    const int NT = P.t_end - P.t_begin;
    ATT_DMA(P.t_begin, 0);
    if (NT > 1) ATT_DMA(P.t_begin + 1, 1);
    const int vb = vbase(lane);
    int buf = 0;
    for (int rel = 0; rel < NT; ++rel) {
        const int t = P.t_begin + rel;
        if (rel + 1 < NT) { if (NP == 2) asm volatile("s_waitcnt vmcnt(2) lgkmcnt(0)\n\ts_barrier" ::: "memory"); else if (NP == 3) asm volatile("s_waitcnt vmcnt(3) lgkmcnt(0)\n\ts_barrier" ::: "memory"); else asm volatile("s_waitcnt vmcnt(4) lgkmcnt(0)\n\ts_barrier" ::: "memory"); }
        else asm volatile("s_waitcnt vmcnt(0) lgkmcnt(0)\n\ts_barrier" ::: "memory");
        if (rel + 2 < NT) { const int nb = buf == 0 ? 2 : buf - 1; ATT_DMA(t + 2, nb); }
        if (t >= wlo && t <= whi) {
            const LAS char* kp = lds + L::K0 + buf * L::KB + hi * 1024 + r32 * 16;
            const LAS char* vp = lds + L::V0 + buf * L::VB + vb;
            const int jrel = t - (cq - 8);
            float cin = -mrun;
            if (MODE == 1) { if (jrel <= 5) cin += P.tab[256]; }
            if (MODE == 2) cin += P.slope2 * (float)(64 * t - qpos);
            f32x16 p0, p1;
#pragma unroll
            for (int r = 0; r < 16; ++r) { p0[r] = cin; p1[r] = cin; }
#pragma unroll
            for (int d0 = 0; d0 < ND0; ++d0) {
                const LAS char* kq = (MODE == 2 && d0 == ND0 - 1) ? kp - hi * 1024 : kp;
                const bf16x8 b0 = *(const LAS bf16x8*)(kq + d0 * 2048), b1 = *(const LAS bf16x8*)(kq + d0 * 2048 + 512);
                p0 = __builtin_amdgcn_mfma_f32_32x32x16_bf16(b0, qr[d0], p0, 0, 0, 0);
                p1 = __builtin_amdgcn_mfma_f32_32x32x16_bf16(b1, qr[d0], p1, 0, 0, 0);
            }
            if (MODE == 1) { if (jrel > 5) {
                    const int dbase = qpos - 64 * t - 4 * hi;
#pragma unroll
                    for (int r = 0; r < 16; ++r) { const int d0_ = dbase - ((r & 3) + 8 * (r >> 2)), d1_ = d0_ - 32;
                        const int i0 = (d0_ < -128 ? -128 : (d0_ > 128 ? 128 : d0_)) + 128, i1 = (d1_ < -128 ? -128 : (d1_ > 128 ? 128 : d1_)) + 128;
                        p0[r] += P.tab[i0]; p1[r] += P.tab[i1]; } } }
            if (MODE == 2) { if (t == cq) {
                    const float xb = (float)(64 * t + 4 * hi - qpos), s2 = -2.0f * P.slope2;
#pragma unroll
                    for (int r = 0; r < 16; ++r) { const float x0 = xb + (float)((r & 3) + 8 * (r >> 2)), x1 = x0 + 32.f;
                        p0[r] = fmaf(s2, fmaxf(x0, 0.f), p0[r]); p1[r] = fmaf(s2, fmaxf(x1, 0.f), p1[r]); } } }
            float rm = fmaxf(p0[0], p1[0]);
#pragma unroll
            for (int r = 1; r < 16; ++r) rm = fmaxf(rm, fmaxf(p0[r], p1[r]));
            rm = xmax(rm);
            if (first || __any(rm > 8.f)) {
                const float dl = first ? rm : fmaxf(rm, 0.f), al = first ? 0.f : fexp2(-dl); mrun += dl; lrun *= al; first = false;
#pragma unroll
                for (int r = 0; r < 16; ++r) { p0[r] -= dl; p1[r] -= dl; }
                if (hi == 0) wsf[r32] = al;
                LDS_WAIT();
#pragma unroll
                for (int r = 0; r < 16; ++r) { const float a = wsf[crow(r, hi)];
#pragma unroll
                    for (int db = 0; db < NDB; ++db) o[db][r] *= a; }
            }
            float ls = 0.f;
#pragma unroll
            for (int r = 0; r < 16; ++r) { p0[r] = fexp2(p0[r]); p1[r] = fexp2(p1[r]); ls += p0[r] + p1[r]; }
            lrun += ls;
            const bf16x8 pw0 = pack8(p0, 0), pw1 = pack8(p0, 8), pw2 = pack8(p1, 0), pw3 = pack8(p1, 8);
            bf16x8 fa0, fa1, fa2, fa3, fb0, fb1, fb2, fb3;
#define ATT_VLD(f, db_) do { f##0 = vfrag(vp + (db_) * 4096 + 0 * 1024); f##1 = vfrag(vp + (db_) * 4096 + 1 * 1024); f##2 = vfrag(vp + (db_) * 4096 + 2 * 1024); f##3 = vfrag(vp + (db_) * 4096 + 3 * 1024); } while (0)
#define ATT_PV(f, db_) do { o[db_] = __builtin_amdgcn_mfma_f32_32x32x16_bf16(pw0, f##0, o[db_], 0, 0, 0); o[db_] = __builtin_amdgcn_mfma_f32_32x32x16_bf16(pw1, f##1, o[db_], 0, 0, 0); \
                o[db_] = __builtin_amdgcn_mfma_f32_32x32x16_bf16(pw2, f##2, o[db_], 0, 0, 0); o[db_] = __builtin_amdgcn_mfma_f32_32x32x16_bf16(pw3, f##3, o[db_], 0, 0, 0); } while (0)
            ATT_VLD(fa, 0); __builtin_amdgcn_sched_barrier(0);
            if (NDB > 1) { ATT_VLD(fb, 1); } ATT_PV(fa, 0); __builtin_amdgcn_sched_barrier(0);
            if (NDB > 2) { ATT_VLD(fa, 2); } if (NDB > 1) { ATT_PV(fb, 1); } __builtin_amdgcn_sched_barrier(0);
            if (NDB > 3) { ATT_VLD(fb, 3); } if (NDB > 2) { ATT_PV(fa, 2); } __builtin_amdgcn_sched_barrier(0);
            if (NDB > 3) { ATT_PV(fb, 3); }
#undef ATT_VLD
#undef ATT_PV
        }
        buf = buf == 2 ? 0 : buf + 1;
    }
    asm volatile("s_waitcnt lgkmcnt(0)\n\ts_barrier" ::: "memory");
#undef ATT_DMA
    const float lt = xsum(lrun);
    if (hi == 0) wsf[r32] = lt > 0.f ? 1.0f / lt : 0.f;
    if (MODE == 2) { if (hi == 0) P.lse[(size_t)(qrow0 + r32) * 8] = lt > 0.f ? mrun + log2f(lt) : -1.0e30f; }
    LDS_WAIT();
#pragma unroll
    for (int r = 0; r < 16; ++r) { const int qr_ = crow(r, hi); const float inv = wsf[qr_];
        bf16* orow = P.O + (size_t)(qrow0 + qr_) * P.ldo + r32;
#pragma unroll
        for (int db = 0; db < NDB; ++db) orow[db * 32] = (bf16)f2bf(o[db][r] * inv); }
    LDS_WAIT();
}
}

namespace ret {
using att::crow; using att::vfrag; using att::vbase; using att::pack8; using att::xsum;
__device__ __forceinline__ float gamma_log2(int h) { return log2f(1.0f - exp2f(-5.0f - (float)h)); }
template <bool SCALE>
__device__ __forceinline__ void stage_tile(LAS char* dst, const bf16* src, int ld, int lane, float lg2, float mul) {
#pragma unroll
    for (int p = 0; p < 8; ++p) { const int db = p >> 2, rg = p & 3, row = 16 * rg + (lane >> 2), col = 32 * db + (lane & 3) * 8;
        u32x4 v = *(const u32x4*)(src + (size_t)row * ld + col);
        if (SCALE) { const float s = fexp2(lg2 * (float)(63 - row)) * mul;
            v.x = cvt_pk_bf16(bflo(v.x) * s, bfhi(v.x) * s); v.y = cvt_pk_bf16(bflo(v.y) * s, bfhi(v.y) * s); v.z = cvt_pk_bf16(bflo(v.z) * s, bfhi(v.z) * s); v.w = cvt_pk_bf16(bflo(v.w) * s, bfhi(v.w) * s); }
        *(LAS u32x4*)(dst + p * 1024 + lane * 16) = v; }
}
__device__ __forceinline__ void kv_unit(LAS char* wl, const bf16* z, float* kvT, int c, int h, int lane) {
    const int hi = lane >> 5, r32 = lane & 31;
    const bf16* kp = z + (size_t)(c * CHUNK) * ZC + Z_CK + h * 64; const bf16* vp = z + (size_t)(c * CHUNK) * ZC + Z_CV + h * 64;
    stage_tile<true>(wl, kp, ZC, lane, gamma_log2(h), 0.125f);
    stage_tile<false>(wl + 8192, vp, ZC, lane, 0.f, 1.f);
    LDS_WAIT();
    const int vb = vbase(lane);
    f32x16 acc[2][2];
#pragma unroll
    for (int dt = 0; dt < 2; ++dt)
#pragma unroll
        for (int et = 0; et < 2; ++et) { acc[dt][et] = (f32x16){};
#pragma unroll
            for (int ks = 0; ks < 4; ++ks) acc[dt][et] = __builtin_amdgcn_mfma_f32_32x32x16_bf16(vfrag(wl + vb + dt * 4096 + ks * 1024), vfrag(wl + 8192 + vb + et * 4096 + ks * 1024), acc[dt][et], 0, 0, 0); }
    float* ob = kvT + ((size_t)(c * 8 + h) * 64) * 64;
#pragma unroll
    for (int dt = 0; dt < 2; ++dt)
#pragma unroll
        for (int et = 0; et < 2; ++et)
#pragma unroll
            for (int g4 = 0; g4 < 4; ++g4)
                *(f32x4*)(ob + (size_t)(32 * et + r32) * 64 + 32 * dt + 8 * g4 + 4 * hi) = (f32x4){acc[dt][et][4 * g4], acc[dt][et][4 * g4 + 1], acc[dt][et][4 * g4 + 2], acc[dt][et][4 * g4 + 3]};
    LDS_WAIT();
}
__device__ __forceinline__ void out_unit(LAS char* wl, const bf16* __restrict__ z, const bf16* __restrict__ rT, bf16* __restrict__ y, int c, int h, int lane) {
    const int hi = lane >> 5, r32 = lane & 31;
    const size_t row0 = (size_t)c * CHUNK;
    const bf16* qp = z + row0 * ZC + Z_CQ + h * 64; const bf16* kp = z + row0 * ZC + Z_CK + h * 64; const bf16* vp = z + row0 * ZC + Z_CV + h * 64; const bf16* gp = z + row0 * ZC + Z_CG + h * 64;
    const bf16* rp = rT + ((size_t)(c * 8 + h) * 64) * 64;
    bf16x8 kf[2][4], rf[2][4], qf[2][4];
#pragma unroll
    for (int nt = 0; nt < 2; ++nt)
#pragma unroll
        for (int s = 0; s < 4; ++s) qf[nt][s] = *(const bf16x8*)(qp + (size_t)(32 * nt + r32) * ZC + 16 * s + 8 * hi);
#pragma unroll
    for (int et = 0; et < 2; ++et)
#pragma unroll
        for (int s = 0; s < 4; ++s) rf[et][s] = *(const bf16x8*)(rp + (size_t)(32 * et + r32) * 64 + 16 * s + 8 * hi);
#pragma unroll
    for (int mt = 0; mt < 2; ++mt)
#pragma unroll
        for (int s = 0; s < 4; ++s) kf[mt][s] = *(const bf16x8*)(kp + (size_t)(32 * mt + r32) * ZC + 16 * s + 8 * hi);
    stage_tile<false>(wl, vp, ZC, lane, 0.f, 1.f);
    const float lg2 = gamma_log2(h);
    LDS_WAIT();
    const int vb = vbase(lane);
    bf16* yo = y + row0 * YC + 1024 + h * 64;
#pragma unroll
    for (int nt = 0; nt < 2; ++nt) {
        int i = 32 * nt + r32; asm volatile("" : "+v"(i));
        u32x2 gv[2][4];
#pragma unroll
        for (int et = 0; et < 2; ++et)
#pragma unroll
            for (int g4 = 0; g4 < 4; ++g4) gv[et][g4] = *(const u32x2*)(gp + (size_t)i * ZC + 32 * et + 8 * g4 + 4 * hi);
        f32x16 oT[2], cr[2];
#pragma unroll
        for (int et = 0; et < 2; ++et) { oT[et] = (f32x16){}; cr[et] = (f32x16){};
#pragma unroll
            for (int s = 0; s < 4; ++s) cr[et] = __builtin_amdgcn_mfma_f32_32x32x16_bf16(rf[et][s], qf[nt][s], cr[et], 0, 0, 0); }
#pragma unroll
        for (int mt = 0; mt < 2; ++mt) {
            f32x16 st = (f32x16){};
#pragma unroll
            for (int s = 0; s < 4; ++s) st = __builtin_amdgcn_mfma_f32_32x32x16_bf16(kf[mt][s], qf[nt][s], st, 0, 0, 0);
            { int i2 = i; asm volatile("" : "+v"(i2));
#pragma unroll
            for (int r = 0; r < 16; ++r) { const int j = 32 * mt + crow(r, hi); const float w = (i2 >= j) ? fexp2(lg2 * (float)(i2 - j)) * 0.125f : 0.f; st[r] *= w; } }
            const bf16x8 pA = pack8(st, 0), pB = pack8(st, 8);
#pragma unroll
            for (int et = 0; et < 2; ++et) {
                oT[et] = __builtin_amdgcn_mfma_f32_32x32x16_bf16(vfrag(wl + vb + et * 4096 + (2 * mt) * 1024), pA, oT[et], 0, 0, 0);
                oT[et] = __builtin_amdgcn_mfma_f32_32x32x16_bf16(vfrag(wl + vb + et * 4096 + (2 * mt + 1) * 1024), pB, oT[et], 0, 0, 0); }
        }
        const float xi = fexp2(lg2 * (float)(i + 1));
        float s1 = 0.f;
#pragma unroll
        for (int et = 0; et < 2; ++et)
#pragma unroll
            for (int r = 0; r < 16; ++r) { oT[et][r] = fmaf(xi, cr[et][r], oT[et][r]); s1 += oT[et][r]; }
        const float mean = xsum(s1) * (1.f / 64.f);
        float s2 = 0.f;
#pragma unroll
        for (int et = 0; et < 2; ++et)
#pragma unroll
            for (int r = 0; r < 16; ++r) { oT[et][r] -= mean; s2 += oT[et][r] * oT[et][r]; }
        const float rstd = 1.0f / sqrtf(xsum(s2) * (1.f / 64.f) + GN_EPS);
#pragma unroll
        for (int et = 0; et < 2; ++et)
#pragma unroll
            for (int g4 = 0; g4 < 4; ++g4) { const int e = 32 * et + 8 * g4 + 4 * hi;
                const u32x2 gw = gv[et][g4];
                const float g0 = bflo(gw.x), g1 = bfhi(gw.x), g2 = bflo(gw.y), g3 = bfhi(gw.y);
                u32x2 w; w.x = cvt_pk_bf16(g0 * sigmoidf_(g0) * oT[et][4 * g4] * rstd, g1 * sigmoidf_(g1) * oT[et][4 * g4 + 1] * rstd);
                w.y = cvt_pk_bf16(g2 * sigmoidf_(g2) * oT[et][4 * g4 + 2] * rstd, g3 * sigmoidf_(g3) * oT[et][4 * g4 + 3] * rstd);
                *(u32x2*)(yo + (size_t)i * YC + e) = w; }
    }
    LDS_WAIT();
}
}

namespace lru {
struct LruP { const bf16* z; const float *conv_w, *conv_b; const bf16* wfrag; const float *ba, *bx, *lam; float *carA, *carH; const float* carI; bf16* y; unsigned* au; };
constexpr int XS = 144;
template <bool FINAL>
__device__ __forceinline__ void unit(LAS char* wl, const LruP& P, int seg, int k, int lane) {
    const int r32 = lane & 31, hi = lane >> 5;
    LAS float* tb = (LAS float*)(wl + 10240);
    { const int ch = k * 64 + lane;
      tb[0 * 64 + lane] = P.conv_w[ch]; tb[1 * 64 + lane] = P.conv_w[512 + ch]; tb[2 * 64 + lane] = P.conv_w[1024 + ch]; tb[3 * 64 + lane] = P.conv_w[1536 + ch];
      tb[4 * 64 + lane] = P.conv_b[ch]; tb[5 * 64 + lane] = P.ba[ch]; tb[6 * 64 + lane] = P.bx[ch]; tb[7 * 64 + lane] = 8.0f * log1pf(expf(-P.lam[ch])); }
    { u32x4 xv[9];
#pragma unroll
      for (int i = 0; i < 9; ++i) { const int rr = i * 8 + (lane >> 3); const int t = seg * 64 - 3 + rr; xv[i] = (u32x4){0u, 0u, 0u, 0u};
          if (rr < 67 && t >= 0) xv[i] = *(const u32x4*)(P.z + (size_t)t * ZC + Z_AX + k * 64 + (lane & 7) * 8); }
#pragma unroll
      for (int i = 0; i < 9; ++i) { const int rr = i * 8 + (lane >> 3); if (rr < 67) *(LAS u32x4*)(wl + rr * XS + (lane & 7) * 16) = xv[i]; } }
    LDS_WAIT();
#pragma unroll 1
    for (int mt = 0; mt < 2; ++mt) {
        bf16x8 WA[4], WX[4];
#pragma unroll
        for (int s = 0; s < 4; ++s) { const bf16* fp = P.wfrag + ((size_t)(((k * 2 + mt) * 4 + s) * 2) * 64 + lane) * 8; WA[s] = *(const bf16x8*)fp; WX[s] = *(const bf16x8*)(fp + 512); }
        f32x16 hin, apr;
#pragma unroll
        for (int g4 = 0; g4 < 4; ++g4) { f32x4 c4 = (f32x4){0.f, 0.f, 0.f, 0.f};
            if (FINAL) c4 = *(const f32x4*)(P.carI + (size_t)seg * 512 + k * 64 + 32 * mt + 8 * g4 + 4 * hi);
#pragma unroll
            for (int j = 0; j < 4; ++j) { hin[4 * g4 + j] = c4[j]; apr[4 * g4 + j] = 1.f; } }
#pragma unroll 1
        for (int half = 0; half < 2; ++half) {
            const int t0 = seg * 64 + half * 32;
            f32x16 aA = (f32x16){}, aX = (f32x16){}, aI = (f32x16){};
#pragma unroll
            for (int s = 0; s < 4; ++s) {
                const int c0 = 16 * s + 8 * hi; float xc[8];
                { const f32x4 b0 = *(const LAS f32x4*)(tb + 4 * 64 + c0), b1 = *(const LAS f32x4*)(tb + 4 * 64 + c0 + 4);
                  xc[0] = b0[0]; xc[1] = b0[1]; xc[2] = b0[2]; xc[3] = b0[3]; xc[4] = b1[0]; xc[5] = b1[1]; xc[6] = b1[2]; xc[7] = b1[3]; }
#pragma unroll
                for (int jr = 0; jr < 4; ++jr) { const u32x4 xv = *(const LAS u32x4*)(wl + (half * 32 + r32 + jr) * XS + (2 * s + hi) * 16);
                    const f32x4 w0 = *(const LAS f32x4*)(tb + jr * 64 + c0), w1 = *(const LAS f32x4*)(tb + jr * 64 + c0 + 4);
                    xc[0] = fmaf(w0[0], bflo(xv.x), xc[0]); xc[1] = fmaf(w0[1], bfhi(xv.x), xc[1]); xc[2] = fmaf(w0[2], bflo(xv.y), xc[2]); xc[3] = fmaf(w0[3], bfhi(xv.y), xc[3]);
                    xc[4] = fmaf(w1[0], bflo(xv.z), xc[4]); xc[5] = fmaf(w1[1], bfhi(xv.z), xc[5]); xc[6] = fmaf(w1[2], bflo(xv.w), xc[6]); xc[7] = fmaf(w1[3], bfhi(xv.w), xc[7]); }
                u32x4 pw; pw.x = pk2(xc[0], xc[1]); pw.y = pk2(xc[2], xc[3]); pw.z = pk2(xc[4], xc[5]); pw.w = pk2(xc[6], xc[7]);
                const bf16x8 xb = __builtin_bit_cast(bf16x8, pw);
                aA = __builtin_amdgcn_mfma_f32_32x32x16_bf16(WA[s], xb, aA, 0, 0, 0);
                aX = __builtin_amdgcn_mfma_f32_32x32x16_bf16(WX[s], xb, aX, 0, 0, 0);
                u32x4 idw;
                { const int d = 32 * mt + r32 - 16 * s - 8 * hi;
                  idw.x = (d == 0 ? 0x3f80u : 0u) | (d == 1 ? 0x3f800000u : 0u); idw.y = (d == 2 ? 0x3f80u : 0u) | (d == 3 ? 0x3f800000u : 0u);
                  idw.z = (d == 4 ? 0x3f80u : 0u) | (d == 5 ? 0x3f800000u : 0u); idw.w = (d == 6 ? 0x3f80u : 0u) | (d == 7 ? 0x3f800000u : 0u); }
                aI = __builtin_amdgcn_mfma_f32_32x32x16_bf16(__builtin_bit_cast(bf16x8, idw), xb, aI, 0, 0, 0);
            }
#pragma unroll
            for (int g4 = 0; g4 < 4; ++g4) { const int cb_ = 32 * mt + 8 * g4 + 4 * hi;
                const f32x4 vba = *(const LAS f32x4*)(tb + 5 * 64 + cb_), vbx = *(const LAS f32x4*)(tb + 6 * 64 + cb_), vsp = *(const LAS f32x4*)(tb + 7 * 64 + cb_);
#pragma unroll
                for (int j = 0; j < 4; ++j) { const int r = 4 * g4 + j;
                    const float rg = sigmoidf_(aA[r] + vba[j]), ig = sigmoidf_(aX[r] + vbx[j]);
                    const float la = -rg * vsp[j];
                    aA[r] = fexp2(la * LOG2E);
                    const float a_ = aA[r]; aX[r] = __builtin_amdgcn_sqrtf(fmaxf(fmaf(-a_, a_, 1.0f), 0.f)) * (ig * aI[r]); } }
#pragma unroll
            for (int r = 0; r < 16; ++r) { float a = aA[r], u = aX[r];
#pragma unroll
                for (int d = 1; d < 32; d <<= 1) { const float a2 = __shfl_up(a, d, 32), u2 = __shfl_up(u, d, 32); if (r32 >= d) { u = fmaf(a, u2, u); a *= a2; } }
                aA[r] = a; aX[r] = u; }
            if (FINAL) {
#pragma unroll
                for (int r = 0; r < 16; ++r) { const float h = fmaf(aA[r], hin[r], aX[r]); aX[r] = h; hin[r] = __shfl(h, 31, 32); }
#pragma unroll
                for (int g4 = 0; g4 < 4; ++g4) { const int cb_ = k * 64 + 32 * mt + 8 * g4 + 4 * hi;
                    const u32x2 gw = *(const u32x2*)(P.z + (size_t)(t0 + r32) * ZC + Z_AG + cb_);
                    float gv[4] = {bflo(gw.x), bfhi(gw.x), bflo(gw.y), bfhi(gw.y)}, o4[4];
#pragma unroll
                    for (int j = 0; j < 4; ++j) { const float g = gv[j]; o4[j] = aX[4 * g4 + j] * g * frcp(1.0f + fexp2(-1.5957691216f * LOG2E * (g + 0.044715f * g * g * g))); }
                    u32x2 w; w.x = pk2(o4[0], o4[1]); w.y = pk2(o4[2], o4[3]);
                    *(u32x2*)(P.y + (size_t)(t0 + r32) * YC + cb_) = w; }
            } else {
                u32x4* aup = (u32x4*)(P.au + ((size_t)((((seg * 8 + k) * 2 + mt) * 2 + half) * 64 + lane)) * 16);
#pragma unroll
                for (int g4 = 0; g4 < 4; ++g4) aup[g4] = (u32x4){pk2(aA[4 * g4], aX[4 * g4]), pk2(aA[4 * g4 + 1], aX[4 * g4 + 1]), pk2(aA[4 * g4 + 2], aX[4 * g4 + 2]), pk2(aA[4 * g4 + 3], aX[4 * g4 + 3])};
#pragma unroll
                for (int r = 0; r < 16; ++r) { const float a31 = __shfl(aA[r], 31, 32), u31 = __shfl(aX[r], 31, 32); hin[r] = fmaf(a31, hin[r], u31); apr[r] *= a31; }
            }
            LDS_WAIT();
        }
        if (!FINAL) { if (r32 == 0) {
#pragma unroll
            for (int g4 = 0; g4 < 4; ++g4) { const size_t o = (size_t)seg * 512 + k * 64 + 32 * mt + 8 * g4 + 4 * hi;
                *(f32x4*)(P.carA + o) = (f32x4){apr[4 * g4], apr[4 * g4 + 1], apr[4 * g4 + 2], apr[4 * g4 + 3]};
                *(f32x4*)(P.carH + o) = (f32x4){hin[4 * g4], hin[4 * g4 + 1], hin[4 * g4 + 2], hin[4 * g4 + 3]}; } } }
    }
}
__device__ __forceinline__ void unit1(LAS char* wl, const LruP& P, int seg, int k, int lane) {
    const int r32 = lane & 31, hi = lane >> 5;
    LAS float* tb = (LAS float*)(wl + 9728);
    LAS unsigned* tt = (LAS unsigned*)(wl + 11776);
    { const int ch = k * 64 + lane;
      tb[0 * 64 + lane] = P.conv_w[ch]; tb[1 * 64 + lane] = P.conv_w[512 + ch]; tb[2 * 64 + lane] = P.conv_w[1024 + ch]; tb[3 * 64 + lane] = P.conv_w[1536 + ch];
      tb[4 * 64 + lane] = P.conv_b[ch]; tb[5 * 64 + lane] = P.ba[ch]; tb[6 * 64 + lane] = P.bx[ch]; tb[7 * 64 + lane] = 8.0f * log1pf(expf(-P.lam[ch])); }
    { u32x4 xv[9];
#pragma unroll
      for (int i = 0; i < 9; ++i) { const int rr = i * 8 + (lane >> 3); const int t = seg * 64 - 3 + rr; xv[i] = (u32x4){0u, 0u, 0u, 0u};
          if (rr < 67 && t >= 0) xv[i] = *(const u32x4*)(P.z + (size_t)t * ZC + Z_AX + k * 64 + (lane & 7) * 8); }
#pragma unroll
      for (int i = 0; i < 9; ++i) { const int rr = i * 8 + (lane >> 3); if (rr < 67) *(LAS u32x4*)(wl + rr * XS + (lane & 7) * 16) = xv[i]; } }
    LDS_WAIT();
#pragma unroll 1
    for (int mt = 0; mt < 2; ++mt) {
        bf16x8 WA[4], WX[4];
#pragma unroll
        for (int s = 0; s < 4; ++s) { const bf16* fp = P.wfrag + ((size_t)(((k * 2 + mt) * 4 + s) * 2) * 64 + lane) * 8; WA[s] = *(const bf16x8*)fp; WX[s] = *(const bf16x8*)(fp + 512); }
        const float vba = tb[5 * 64 + 32 * mt + r32], vbx = tb[6 * 64 + 32 * mt + r32], vsp = tb[7 * 64 + 32 * mt + r32];
        float hin = 0.f, apr = 1.f;
#pragma unroll 1
        for (int half = 0; half < 2; ++half) {
            f32x16 aA = (f32x16){}, aX = (f32x16){}, aI = (f32x16){};
#pragma unroll
            for (int s = 0; s < 4; ++s) {
                const int c0 = 16 * s + 8 * hi; float xc[8];
                { const f32x4 b0 = *(const LAS f32x4*)(tb + 4 * 64 + c0), b1 = *(const LAS f32x4*)(tb + 4 * 64 + c0 + 4);
                  xc[0] = b0[0]; xc[1] = b0[1]; xc[2] = b0[2]; xc[3] = b0[3]; xc[4] = b1[0]; xc[5] = b1[1]; xc[6] = b1[2]; xc[7] = b1[3]; }
#pragma unroll
                for (int jr = 0; jr < 4; ++jr) { const u32x4 xv = *(const LAS u32x4*)(wl + (half * 32 + r32 + jr) * XS + (2 * s + hi) * 16);
                    const f32x4 w0 = *(const LAS f32x4*)(tb + jr * 64 + c0), w1 = *(const LAS f32x4*)(tb + jr * 64 + c0 + 4);
                    xc[0] = fmaf(w0[0], bflo(xv.x), xc[0]); xc[1] = fmaf(w0[1], bfhi(xv.x), xc[1]); xc[2] = fmaf(w0[2], bflo(xv.y), xc[2]); xc[3] = fmaf(w0[3], bfhi(xv.y), xc[3]);
                    xc[4] = fmaf(w1[0], bflo(xv.z), xc[4]); xc[5] = fmaf(w1[1], bfhi(xv.z), xc[5]); xc[6] = fmaf(w1[2], bflo(xv.w), xc[6]); xc[7] = fmaf(w1[3], bfhi(xv.w), xc[7]); }
                u32x4 pw; pw.x = pk2(xc[0], xc[1]); pw.y = pk2(xc[2], xc[3]); pw.z = pk2(xc[4], xc[5]); pw.w = pk2(xc[6], xc[7]);
                const bf16x8 xb = __builtin_bit_cast(bf16x8, pw);
                aA = __builtin_amdgcn_mfma_f32_32x32x16_bf16(xb, WA[s], aA, 0, 0, 0);
                aX = __builtin_amdgcn_mfma_f32_32x32x16_bf16(xb, WX[s], aX, 0, 0, 0);
                u32x4 idw;
                { const int d = 32 * mt + r32 - 16 * s - 8 * hi;
                  idw.x = (d == 0 ? 0x3f80u : 0u) | (d == 1 ? 0x3f800000u : 0u); idw.y = (d == 2 ? 0x3f80u : 0u) | (d == 3 ? 0x3f800000u : 0u);
                  idw.z = (d == 4 ? 0x3f80u : 0u) | (d == 5 ? 0x3f800000u : 0u); idw.w = (d == 6 ? 0x3f80u : 0u) | (d == 7 ? 0x3f800000u : 0u); }
                aI = __builtin_amdgcn_mfma_f32_32x32x16_bf16(xb, __builtin_bit_cast(bf16x8, idw), aI, 0, 0, 0);
            }
#pragma unroll
            for (int r = 0; r < 16; ++r) {
                const float rg = sigmoidf_(aA[r] + vba), ig = sigmoidf_(aX[r] + vbx);
                const float la = -rg * vsp;
                aA[r] = fexp2(la * LOG2E);
                const float a_ = aA[r]; aX[r] = __builtin_amdgcn_sqrtf(fmaxf(fmaf(-a_, a_, 1.0f), 0.f)) * (ig * aI[r]); }
#pragma unroll
            for (int g = 0; g < 4; ++g)
#pragma unroll
                for (int j = 1; j < 4; ++j) { aX[4 * g + j] = fmaf(aA[4 * g + j], aX[4 * g + j - 1], aX[4 * g + j]); aA[4 * g + j] *= aA[4 * g + j - 1]; }
            float cA[4], cU[4], ca = 1.f, cu = 0.f;
#pragma unroll
            for (int g = 0; g < 4; ++g) {
                const auto ta = __builtin_amdgcn_permlane32_swap(__float_as_uint(aA[4 * g + 3]), __float_as_uint(aA[4 * g + 3]), false, false);
                const auto tu = __builtin_amdgcn_permlane32_swap(__float_as_uint(aX[4 * g + 3]), __float_as_uint(aX[4 * g + 3]), false, false);
                const float a_lo = __uint_as_float(ta[0]), a_hi = __uint_as_float(ta[1]), u_lo = __uint_as_float(tu[0]), u_hi = __uint_as_float(tu[1]);
                const float ca1 = a_lo * ca, cu1 = fmaf(a_lo, cu, u_lo);
                cA[g] = hi ? ca1 : ca; cU[g] = hi ? cu1 : cu;
                ca = a_hi * ca1; cu = fmaf(a_hi, cu1, u_hi); }
#pragma unroll
            for (int r = 0; r < 16; ++r) { aX[r] = fmaf(aA[r], cU[r >> 2], aX[r]); aA[r] *= cA[r >> 2]; }
            hin = fmaf(ca, hin, cu); apr *= ca;
#pragma unroll
            for (int r = 0; r < 16; ++r) tt[att::crow(r, hi) * 36 + r32] = pk2(aA[r], aX[r]);
            LDS_WAIT();
            u32x4* aup = (u32x4*)(P.au + ((size_t)((((seg * 8 + k) * 2 + mt) * 2 + half) * 64 + lane)) * 16);
#pragma unroll
            for (int g4 = 0; g4 < 4; ++g4) aup[g4] = *(const LAS u32x4*)(tt + r32 * 36 + 8 * g4 + 4 * hi);
            LDS_WAIT();
        }
        if (hi == 0) { const size_t o = (size_t)seg * 512 + k * 64 + 32 * mt + r32; P.carA[o] = apr; P.carH[o] = hin; }
    }
}
__device__ __forceinline__ void fin_unit(const LruP& P, int seg, int k, int lane) {
    const int r32 = lane & 31, hi = lane >> 5;
    u32x4 w[2][2][4]; u32x2 gw[2][2][4]; f32x4 c4[2][4];
#pragma unroll
    for (int mt = 0; mt < 2; ++mt)
#pragma unroll
        for (int half = 0; half < 2; ++half) { const u32x4* aup = (const u32x4*)(P.au + ((size_t)((((seg * 8 + k) * 2 + mt) * 2 + half) * 64 + lane)) * 16);
#pragma unroll
            for (int g4 = 0; g4 < 4; ++g4) { w[mt][half][g4] = aup[g4];
                gw[mt][half][g4] = *(const u32x2*)(P.z + (size_t)(seg * 64 + half * 32 + r32) * ZC + Z_AG + k * 64 + 32 * mt + 8 * g4 + 4 * hi); } }
#pragma unroll
    for (int mt = 0; mt < 2; ++mt)
#pragma unroll
        for (int g4 = 0; g4 < 4; ++g4) c4[mt][g4] = *(const f32x4*)(P.carI + (size_t)seg * 512 + k * 64 + 32 * mt + 8 * g4 + 4 * hi);
#pragma unroll
    for (int mt = 0; mt < 2; ++mt) {
        float hin[16];
#pragma unroll
        for (int g4 = 0; g4 < 4; ++g4)
#pragma unroll
            for (int j = 0; j < 4; ++j) hin[4 * g4 + j] = c4[mt][g4][j];
#pragma unroll
        for (int half = 0; half < 2; ++half) {
            const int t0 = seg * 64 + half * 32;
#pragma unroll
            for (int g4 = 0; g4 < 4; ++g4) { const int cb_ = k * 64 + 32 * mt + 8 * g4 + 4 * hi; const u32x4 wv = w[mt][half][g4];
                const unsigned wr_[4] = {wv.x, wv.y, wv.z, wv.w};
                float gv[4] = {bflo(gw[mt][half][g4].x), bfhi(gw[mt][half][g4].x), bflo(gw[mt][half][g4].y), bfhi(gw[mt][half][g4].y)}, o4[4];
#pragma unroll
                for (int j = 0; j < 4; ++j) { const int r = 4 * g4 + j; const float h = fmaf(bflo(wr_[j]), hin[r], bfhi(wr_[j])); hin[r] = __shfl(h, 31, 32);
                    const float g = gv[j]; o4[j] = h * g * frcp(1.0f + fexp2(-1.5957691216f * LOG2E * (g + 0.044715f * g * g * g))); }
                u32x2 wo; wo.x = pk2(o4[0], o4[1]); wo.y = pk2(o4[2], o4[3]);
                *(u32x2*)(P.y + (size_t)(t0 + r32) * YC + cb_) = wo; }
        }
    }
}
}

constexpr int NPH_LAYER = 14, NPHASE = 1 + DEPTH * NPH_LAYER;

__global__ void __launch_bounds__(NTHREADS, 2) fwd_kernel(Args args) {
    extern __shared__ __attribute__((aligned(16))) unsigned char lds_raw[];
    LAS unsigned char* lds = (LAS unsigned char*)lds_raw;
    const int G = gridDim.x; const int bx = blockIdx.x;
    const int vcu = (G % 8 == 0) ? (bx % 8) * (G / 8) + bx / 8 : bx;
    const int NGW = G * NWAVES;
    typedef const __attribute__((address_space(4))) Args* KArgs;
#define PH_PTRS KArgs KA = (KArgs)__builtin_amdgcn_kernarg_segment_ptr(); asm volatile("" : "+s"(KA)); unsigned char* const ws = KA->ws; (void)ws; \
    int tid = threadIdx.x; asm volatile("" : "+v"(tid)); const int lane = tid & 63; const int wid = __builtin_amdgcn_readfirstlane(tid >> 6); const int gw = vcu * NWAVES + wid; (void)lane; (void)gw
#define ctl ((unsigned*)(ws + WS_CTL))
#define memn ((bf16*)(ws + WS_MEMN))
#define kvmem ((bf16*)(ws + WS_KMEM))
#define wtr ((bf16*)(ws + WS_WTR))
#define lruw ((bf16*)(ws + WS_LRUW))
#define carA ((float*)(ws + WS_CARA))
#define carH ((float*)(ws + WS_CARH))
#define carI ((float*)(ws + WS_CARI))
#define qknrm ((float*)(ws + WS_QKN))
#define lseb ((float*)(ws + WS_LSE))
#define tokE ((int*)(ws + WS_TOKE))
#define tokP ((int*)(ws + WS_TOKP))
#define tokW ((float*)(ws + WS_TOKW))
#define elist ((int*)(ws + WS_ELIST))
#define wt_in ((bf16*)(ws + WS_WIN))
#define wt_br ((bf16*)(ws + WS_WBR))
#define wt_out ((bf16*)(ws + WS_WOUT))
#define wt_mq ((bf16*)(ws + WS_WMQ))
#define wt_mk ((bf16*)(ws + WS_WMK))
#define wt_mv ((bf16*)(ws + WS_WMV))
#define wt_mo ((bf16*)(ws + WS_WMO))
#define w13 ((bf16*)(ws + WS_W13))
#define w2t ((bf16*)(ws + WS_W2))
#define hb ((bf16*)(ws + WS_H))
#define yb ((bf16*)(ws + WS_Y))
#define kvT ((float*)(ws + WS_KVT))
#define rT ((bf16*)(ws + WS_RT))
#define odb ((bf16*)(ws + WS_OD))
#define zb ((bf16*)(ws + WS_Z))
#define gtb ((bf16*)(ws + WS_G))
#define mrg ((bf16*)(ws + WS_MRG))
#define qb ((bf16*)(ws + WS_QB))
#define obf ((bf16*)(ws + WS_OB))
#define hid ((bf16*)(ws + WS_HID))
#define ymoe ((bf16*)(ws + WS_YMOE))
#define ssb ((float*)(ws + WS_SS))
#define xs1 ((bf16*)(ws + WS_XS1))
#define xs2 ((bf16*)(ws + WS_XS2))
#define xin (KA->in[I_X])
#define xout (KA->out)
    volatile LAS unsigned* MISC = (volatile LAS unsigned*)(lds + LDS_MISC);
    if (threadIdx.x < 64) MISC[threadIdx.x] = 0u;
    __syncthreads();
    const int lo = args.ph_lo, hi_ph = args.ph_hi;
    XcdBarrier bar; bar.x = 0; bar.st = nullptr; bar.bar = nullptr;
    { PH_PTRS; bar.bar = ctl + CW_BAR; if (hi_ph - lo > 1) bar = xcd_barrier_post(ctl + CW_BAR, MISC + 8); }
#ifndef PH_EN
#define PH_EN 0xFFFFFFFFu
#endif
#define EN(p) (((PH_EN) >> (p)) & 1u)
#define IN(k) (lo <= (k) && (k) < hi_ph)
#ifdef PROBE_MASK
    unsigned long long pr_acc = 0ull, pr_t0 = 0ull;
#define PR_BEGIN(p) do { if (((PROBE_MASK) >> (p)) & 1ull) pr_t0 = __builtin_amdgcn_s_memrealtime(); } while (0)
#define PR_END(p) do { if (((PROBE_MASK) >> (p)) & 1ull) pr_acc += __builtin_amdgcn_s_memrealtime() - pr_t0; } while (0)
#else
#define PR_BEGIN(p) do { } while (0)
#define PR_END(p) do { } while (0)
#endif
#define SEAM(k) do { if (IN(k) && IN((k) + 1)) xcd_barrier(bar); } while (0)

    PR_BEGIN(16);
    if (EN(19) && IN(0)) { PH_PTRS;
        LAS float* scr = (LAS float*)(lds + wid * 16384);
#define WT_CONSTS constexpr int I_IN = (D / 64) * (INC / 32), I_BR = (512 / 64) * (D / 32), I_OUT = (D / 64) * (D / 32), I_MQ = (D / 64) * (512 / 32), I_MO = (512 / 64) * (D / 32); \
          constexpr int NIT = I_IN + 4 * I_BR + I_OUT + 3 * I_MQ + I_MO, KV0 = I_IN + 4 * I_BR + I_OUT + I_MQ; (void)KV0
#define WT_DECODE auto decode = [&](int it) -> TrIt { const int l = it / NIT; int r = it % NIT; \
              if (r < I_IN) { const int n0_ = (r % (INC / 32)) * 32; const float sc_ = ((n0_ >= Z_BQ && n0_ < Z_BK) || (n0_ >= Z_DQ && n0_ < Z_DK)) ? 0.125f * LOG2E : 1.0f;     \
                  return TrIt{KA->in[I_W_IN] + (size_t)l * D * INC, wt_in + (size_t)l * INC * D, KA->in[I_NORM_MIX] + l * D, D, INC, 0, r, sc_}; } r -= I_IN; \
              if (r < 4 * I_BR) { const int b = r / I_BR; return TrIt{KA->in[I_W_BRANCH] + (size_t)(l * 4 + b) * 512 * D, wt_br + (size_t)(l * 4 + b) * D * 512, nullptr, 512, D, 0, r % I_BR, 1.0f}; } r -= 4 * I_BR; \
              if (r < I_OUT) return TrIt{KA->in[I_W_OUT] + (size_t)l * D * D, wt_out + (size_t)l * D * D, nullptr, D, D, 0, r, 1.0f}; r -= I_OUT; \
              if (r < I_MQ) return TrIt{KA->in[I_W_MQ] + (size_t)l * D * 512, wt_mq + (size_t)l * 512 * D, KA->in[I_NORM_MEM] + l * D, D, 512, 0, r, 0.08838834764831845f * LOG2E}; r -= I_MQ; \
              if (r < I_MQ) return TrIt{KA->in[I_W_MK] + (size_t)l * D * 512, wt_mk + (size_t)l * 512 * D, nullptr, D, 512, 0, r, 1.0f}; r -= I_MQ; \
              if (r < I_MQ) return TrIt{KA->in[I_W_MV] + (size_t)l * D * 512, wt_mv + (size_t)l * 512 * D, nullptr, D, 512, 0, r, 1.0f}; r -= I_MQ; \
              return TrIt{KA->in[I_W_MO] + (size_t)l * 512 * D, wt_mo + (size_t)l * D * 512, nullptr, 512, D, 0, r, 1.0f}; }
        { WT_CONSTS; WT_DECODE;
          constexpr int NPRO = NIT + (DEPTH - 1) * 2 * I_MQ;
          auto pro = [&](int j) -> int { return j < NIT ? j : NIT * (1 + (j - NIT) / (2 * I_MQ)) + KV0 + (j - NIT) % (2 * I_MQ); };
          TrIt cur = decode(pro(gw < NPRO ? gw : 0)); f32x4 v[8]; tr_load(cur, lane, v);
          for (int j = gw; j < NPRO; j += NGW) { const bool hn = j + NGW < NPRO; const TrIt nx = decode(pro(hn ? j + NGW : j)); f32x4 vn[8]; tr_load(nx, lane, vn);
              tr_finish(cur, v, scr, lane); cur = nx;
#pragma unroll
              for (int i = 0; i < 8; ++i) v[i] = vn[i]; } }
        for (int i = gw * 64 + lane; i < DEPTH * 8 * 2 * 4 * 2 * 64; i += NGW * 64) { const int ln = i & 63, mat = (i >> 6) & 1, s_ = (i >> 7) & 3, mt = (i >> 9) & 1, k = (i >> 10) & 7, l = i >> 13;
            const float* w = KA->in[mat ? I_LRU_WX : I_LRU_WA] + (size_t)l * 32768 + (size_t)(k * 64 + 16 * s_ + 8 * (ln >> 5)) * 64 + 32 * mt + (ln & 31);
            u32x4 o; o.x = pk2(w[0], w[64]); o.y = pk2(w[128], w[192]); o.z = pk2(w[256], w[320]); o.w = pk2(w[384], w[448]);
            *(u32x4*)(lruw + (size_t)i * 8) = o; }
        for (int i = gw * 64 + lane; i < DEPTH * 64 * D; i += NGW * 64) { const int l = i / (64 * D), n = (i / D) % 64, k = i % D; float v = 0.f;
            if (n < 4) v = KA->in[I_W_GROUP][(size_t)(l * D + k) * 4 + n]; else if (n < 36) v = KA->in[I_W_ROUTER][(size_t)(l * D + k) * 32 + (n - 4)];
            wtr[i] = (bf16)f2bf(v * KA->in[I_NORM_FFN][l * D + k]); }
        for (int m = gw; m < MEM_LEN; m += NGW) rms_row_to_bf16(KA->in[I_MEM] + (size_t)m * D, KA->in[I_MEM_NORM], memn + (size_t)m * D, lane);
        for (int i = gw * 64 + lane; i < 256 * D / 8; i += NGW * 64) ((u32x4*)(hb + (size_t)M * D))[i] = (u32x4){0u, 0u, 0u, 0u};
        { const float* __restrict__ xi_r = xin; bf16* __restrict__ hb_r = hb; float* __restrict__ ss_r = ssb;
          for (int m0 = gw; m0 < M; m0 += 4 * NGW) { f32x4 v[4][4];
#pragma unroll
              for (int q = 0; q < 4; ++q)
#pragma unroll
                  for (int j = 0; j < 2; ++j) { const int mq = (m0 + q * NGW < M) ? m0 + q * NGW : m0; const f32x4* p = (const f32x4*)(xi_r + (size_t)mq * D) + 2 * (lane + 64 * j); v[q][2 * j] = p[0]; v[q][2 * j + 1] = p[1]; }
#pragma unroll
              for (int q = 0; q < 4; ++q) { const int m = m0 + q * NGW; float ssq = 0.f; if (m >= M) break;
#pragma unroll
                  for (int j = 0; j < 2; ++j) { const f32x4 a = v[q][2 * j], c = v[q][2 * j + 1]; ssq += ((a.x * a.x + a.y * a.y) + (a.z * a.z + a.w * a.w)) + ((c.x * c.x + c.y * c.y) + (c.z * c.z + c.w * c.w));
                      ((u32x4*)(hb_r + (size_t)m * D))[lane + 64 * j] = (u32x4){pk2(a.x, a.y), pk2(a.z, a.w), pk2(c.x, c.y), pk2(c.z, c.w)}; }
                  ssq = wave_sum(ssq); if (lane < 16) ss_r[(size_t)m * 16 + lane] = lane == 0 ? ssq : 0.f; } } }
    }
    SEAM(0);
    PR_END(16);

    for (int l = 0; l < DEPTH; ++l) {
        const int pb = 1 + l * NPH_LAYER;
        PR_BEGIN(0);
        if (EN(0) && IN(pb + 0)) { PH_PTRS;
            { pg8::Gemm g{hb, wt_in + (size_t)l * INC * D, D, D, D, M, ssb}; pg8::GridOrder S; S.init(M / 256, ZC / 256, G, bx);
              pg8::EpiBf16<0, true> E{zb, ZC}; pg8::gemm_phase<pg8::EpiBf16<0, true>, pg8::GridOrder, false>(lds, g, S, E, tid); }
        }
        SEAM(pb + 0);
        PR_END(0); PR_BEGIN(1);
#define LRU_P lru::LruP LP{zb, KA->in[I_CONV_W] + l * 2048, KA->in[I_CONV_B] + l * 512, lruw + (size_t)l * 65536, KA->in[I_LRU_BA] + l * 512, \
                     KA->in[I_LRU_BX] + l * 512, KA->in[I_LRU_LAMBDA] + l * 512, carA, carH, carI, yb, (unsigned*)xout}
        if (EN(1) && IN(pb + 1)) { PH_PTRS; LRU_P;
            for (int u = gw; u < 2048; u += NGW) lru::unit1((LAS char*)lds + wid * 16384, LP, u >> 3, u & 7, lane);
            for (int u = gw; u < 2048; u += NGW) ret::kv_unit((LAS char*)lds + wid * 16384, zb, kvT, u >> 3, u & 7, lane);
            { float mx = 0.f;
#pragma unroll 4
              for (int m = gw; m < M; m += NGW) { const u32x4 v0 = *(const u32x4*)(zb + (size_t)m * ZC + Z_DQ + lane * 16), v1 = *(const u32x4*)(zb + (size_t)m * ZC + Z_DQ + lane * 16 + 8);
                  float ss = bflo(v0.x) * bflo(v0.x) + bfhi(v0.x) * bfhi(v0.x) + bflo(v0.y) * bflo(v0.y) + bfhi(v0.y) * bfhi(v0.y) + bflo(v0.z) * bflo(v0.z) + bfhi(v0.z) * bfhi(v0.z) + bflo(v0.w) * bflo(v0.w) + bfhi(v0.w) * bfhi(v0.w)
                           + bflo(v1.x) * bflo(v1.x) + bfhi(v1.x) * bfhi(v1.x) + bflo(v1.y) * bflo(v1.y) + bfhi(v1.y) * bfhi(v1.y) + bflo(v1.z) * bflo(v1.z) + bfhi(v1.z) * bfhi(v1.z) + bflo(v1.w) * bflo(v1.w) + bfhi(v1.w) * bfhi(v1.w);
                  ss += __shfl_xor(ss, 1); ss += __shfl_xor(ss, 2); mx = fmaxf(mx, ss); }
              LAS float* wm = (LAS float*)(lds + LDS_MISC + 4096);
              __syncthreads();
              if ((lane & 3) == 0) wm[wid * 16 + (lane >> 2)] = mx;
              __syncthreads();
              if (tid < 16) { float v = wm[tid]; for (int w = 1; w < 8; ++w) v = fmaxf(v, wm[w * 16 + tid]); qknrm[vcu * 16 + tid] = sqrtf(v); } }
        }
        SEAM(pb + 1);
        PR_END(1); PR_BEGIN(2);
#define DQ_SETUP LAS float* qkm = (LAS float*)(lds + LDS_MISC + 4096);   \
            { float v = 0.f; const int idx = wid * 2 + (lane >> 5); for (int j = (lane & 31); j < G; j += 32) v = fmaxf(v, qknrm[j * 16 + idx]); \
              for (int o_ = 1; o_ < 32; o_ <<= 1) v = fmaxf(v, __shfl_xor(v, o_)); if ((lane & 31) == 0) qkm[idx] = v; } \
            __syncthreads()
#define DQ_DMAX(hm_) ((int)((70.0f + 2.02f * qkm[(hm_)] * qkm[8 + (hm_)]) / (exp2f(-2.0f * (float)(((hm_) >> 1) + 1)) * LOG2E)) + 2)
        if (EN(2) && IN(pb + 2)) { PH_PTRS;
            if (l == 0) { pg8::Gemm g{memn, wt_mk, D, D, D, 0, nullptr}; pg8::GridOrder S; S.init(1, 8, G, bx);
                pg8::EpiBf16<0> E{kvmem, 2048}; pg8::gemm_phase<pg8::EpiBf16<0>, pg8::GridOrder, false>(lds, g, S, E, tid); __syncthreads(); }
            DQ_SETUP;
            LAS unsigned short* dord = (LAS unsigned short*)(lds + LDS_MISC + 8192);
            LAS int* dq = (LAS int*)(lds + LDS_MISC + 4096 + 128);
            {
              const int hdesc = tid >> 7, j = tid & 127, qblk = 63 - (j >> 1), hm = (3 - hdesc) * 2 + (j & 1);
              const int a = qblk * 256 - DQ_DMAX(hm); const int tlo = a > 0 ? (a >> 6) : 0, ntile = 4 * qblk + 4 - tlo, nseg = hm < 4 ? 1 : (ntile + 85) / 86;
              int inc = nseg;
#pragma unroll
              for (int o_ = 1; o_ < 64; o_ <<= 1) { const int v = __shfl_up(inc, o_); if (lane >= o_) inc += v; }
              if (lane == 63) dq[8 + wid] = inc;
              __syncthreads();
              int base = 0; for (int w = 0; w < wid; ++w) base += dq[8 + w];
              if (tid == NTHREADS - 1) dq[0] = base + inc;
              for (int sg = 0; sg < nseg; ++sg) dord[base + inc - nseg + sg] = (unsigned short)(((hm * 64 + qblk) << 2) | sg);
              __syncthreads(); }
            { const int gt = vcu * NTHREADS + tid;
              if (gt < 32768) { const int hh = gt >> 12; const float gch = exp2f(64.0f * ret::gamma_log2(hh)); float S = 0.f;
                  const float* __restrict__ kv_r = kvT; bf16* __restrict__ rt_r = rT;
                  for (int c0 = 0; c0 < NCHUNK; c0 += 32) { float kv[32];
#pragma unroll
                      for (int c = 0; c < 32; ++c) kv[c] = kv_r[(size_t)(c0 + c) * 32768 + gt];
#pragma unroll
                      for (int c = 0; c < 32; ++c) { rt_r[(size_t)(c0 + c) * 32768 + gt] = (bf16)f2bf(S); S = fmaf(gch, S, kv[c]); } }
              } else if (gt < 32768 + 512) { const int ch = gt - 32768; float hc = 0.f;
                  const float* __restrict__ ca_r = carA; const float* __restrict__ ch_r = carH; float* __restrict__ ci_r = carI;
                  for (int s0 = 0; s0 < 256; s0 += 16) { float ca[16], chh[16];
#pragma unroll
                      for (int sg2 = 0; sg2 < 16; ++sg2) { ca[sg2] = ca_r[(s0 + sg2) * 512 + ch]; chh[sg2] = ch_r[(s0 + sg2) * 512 + ch]; }
#pragma unroll
                      for (int sg2 = 0; sg2 < 16; ++sg2) { ci_r[(s0 + sg2) * 512 + ch] = hc; hc = fmaf(ca[sg2], hc, chh[sg2]); } } } }
#ifndef NO_DQ
            const int nd = dq[0];
            unsigned* qctr = ctl + CW_DQ + l * 256;
            __syncthreads();
            if (tid == 0) dq[1] = (int)__hip_atomic_fetch_add(qctr, 1u, __ATOMIC_RELAXED, __HIP_MEMORY_SCOPE_AGENT);
            for (;;) {
                __syncthreads();
                const int n = dq[1]; if (n >= nd) break;
                unsigned nxc = 0u; if (tid == 0) nxc = __hip_atomic_fetch_add(qctr, 1u, __ATOMIC_RELAXED, __HIP_MEMORY_SCOPE_AGENT);
                const int id = dord[n], sg = id & 3, qblk = (id >> 2) & 63, hm = id >> 8, head = hm >> 1, mp = hm & 1;
                const int dmx = DQ_DMAX(hm); const int a = qblk * 256 - dmx; const int tlo = a > 0 ? (a >> 6) : 0, thi = 4 * qblk + 4, ntile = thi - tlo, nseg = hm < 4 ? 1 : (ntile + 85) / 86, len = (ntile + nseg - 1) / nseg;
                const int t0 = tlo + sg * len, t1 = (t0 + len < thi) ? t0 + len : thi;
                bf16* ob_ = sg == 0 ? odb + hm * 128 : (sg == 1 ? xs1 : xs2) + (hm - 4) * 128;
                att::AttnP P{zb + Z_DQ + head * 128 + mp * 64, zb + Z_DK + head * 128 + mp * 64, zb + Z_DV + head * 128, ob_, ZC, ZC, ZC, sg == 0 ? 1024 : 512,
                             qblk * 256, t0, t1, exp2f(-2.0f * (float)(head + 1)) * LOG2E, dmx, nullptr, lseb + (size_t)sg * M * 8 + hm};
                int tid_u = tid; asm volatile("" : "+v"(tid_u));
                att::attn_unit<64, 128, 2>((LAS char*)lds, P, tid_u);
                if (tid == 0) dq[1] = (int)nxc;
            }
#endif
#ifndef NO_BQ
            LAS float* tab = (LAS float*)(lds + 65536);
            unsigned* bctr = ctl + CW_DQ + l * 256 + 64;
            __syncthreads();
            if (tid == 0) dq[2] = (int)__hip_atomic_fetch_add(bctr, 1u, __ATOMIC_RELAXED, __HIP_MEMORY_SCOPE_AGENT);
            for (;;) {
                __syncthreads();
                const int u = dq[2]; if (u >= 512) break;
                unsigned nxc = 0u; if (tid == 0) nxc = __hip_atomic_fetch_add(bctr, 1u, __ATOMIC_RELAXED, __HIP_MEMORY_SCOPE_AGENT);
                const int head = u & 7, qblk = u >> 3;
                if (tid < 257) tab[tid] = KA->in[I_CA_REL][(size_t)(l * 8 + head) * 257 + tid] * LOG2E;
                __syncthreads();
                att::AttnP P{zb + Z_BQ + head * 64, zb + Z_BK + head * 64, zb + Z_BV + head * 64, yb + 512 + head * 64, ZC, ZC, ZC, YC,
                             qblk * 256, (4 * qblk - 8 < 0 ? 0 : 4 * qblk - 8), 4 * qblk + 4, 0.f, 0, tab, nullptr};
                int tid_u = tid; asm volatile("" : "+v"(tid_u));
                att::attn_unit<64, 64, 1>((LAS char*)lds, P, tid_u);
                if (tid == 0) dq[2] = (int)nxc;
            }
#endif
            unsigned* cctr = ctl + CW_DQ + l * 256 + 128;
            __syncthreads();
            if (tid == 0) dq[3] = (int)__hip_atomic_fetch_add(cctr, 1u, __ATOMIC_RELAXED, __HIP_MEMORY_SCOPE_AGENT);
            for (;;) {
                __syncthreads();
                const int u = dq[3]; if (u >= CVT_UNITS) break;
                unsigned nxc = 0u; if (tid == 0) nxc = __hip_atomic_fetch_add(cctr, 1u, __ATOMIC_RELAXED, __HIP_MEMORY_SCOPE_AGENT);
                { const int it0 = u * CVT_PER_UNIT + wid * (CVT_PER_UNIT / NWAVES);
#define EX_IT(j_) expert_item(KA->in[I_W1] + (size_t)l * NEXP * D * DEXP, KA->in[I_W3] + (size_t)l * NEXP * D * DEXP, KA->in[I_W2] + (size_t)l * NEXP * DEXP * D, KA->in[I_NORM_FFN] + l * D, w13, w2t, it0 + (j_))
                  const TrIt t0_ = EX_IT(0), t1_ = EX_IT(1), t2_ = EX_IT(2); f32x4 va[8], vb_[8];
                  tr_load(t0_, lane, va); tr_load(t1_, lane, vb_);
                  tr_finish(t0_, va, (LAS float*)(lds + wid * 16384), lane); tr_load(t2_, lane, va);
                  tr_finish(t1_, vb_, (LAS float*)(lds + wid * 16384), lane);
                  tr_finish(t2_, va, (LAS float*)(lds + wid * 16384), lane);
#undef EX_IT
                }
                if (tid == 0) dq[3] = (int)nxc;
            }
        }
        SEAM(pb + 2);
        PR_END(2); PR_BEGIN(3);
        if (EN(3) && IN(pb + 3)) { PH_PTRS; LRU_P;
            for (int u = gw; u < 2048; u += NGW) lru::fin_unit(LP, u >> 3, u & 7, lane);
            for (int u = gw; u < 2048; u += NGW) ret::out_unit((LAS char*)lds + wid * 16384, zb, rT, yb, u >> 3, u & 7, lane);
        }
        if (EN(3) && IN(pb + 3)) { PH_PTRS; const float lam_init = 0.8f - 0.6f * expf(-0.3f * (float)l);
            asm volatile("" ::: "memory");
            DQ_SETUP;
            const int lane_m = lane;
            const float* dl = KA->in[I_DIFF_LAMBDA] + l * 256;
            const float lam = expf(wave_sum(dl[lane_m] * dl[64 + lane_m])) - expf(wave_sum(dl[128 + lane_m] * dl[192 + lane_m])) + lam_init;
            const int head = lane_m >> 4, sub = lane_m & 15; const float* sg_ = KA->in[I_DIFF_SUBLN] + l * 128 + sub * 8;
            float gsc[8];
#pragma unroll
            for (int j = 0; j < 8; ++j) gsc[j] = sg_[j] * (1.0f - lam_init);
            const int dm0 = DQ_DMAX(head * 2), dm1 = DQ_DMAX(head * 2 + 1);
            const float* __restrict__ lse_r = lseb; const bf16* __restrict__ od_r = odb; const bf16* __restrict__ x1_r = xs1; const bf16* __restrict__ x2_r = xs2; bf16* __restrict__ y_r = yb;
#pragma unroll 4
            for (int m = gw; m < M; m += NGW) {
                const int qblk = m >> 8; float om[2][8];
#pragma unroll
                for (int mp = 0; mp < 2; ++mp) { const int hm = head * 2 + mp; const int a = qblk * 256 - (mp ? dm1 : dm0); const int tlo = a > 0 ? (a >> 6) : 0, nseg = hm < 4 ? 1 : (4 * qblk + 4 - tlo + 85) / 86;
                    const bool s1 = nseg > 1, s2 = nseg > 2;
                    const float c0 = lse_r[(size_t)m * 8 + hm]; float c1 = lse_r[(size_t)M * 8 + (size_t)m * 8 + hm], c2 = lse_r[(size_t)2 * M * 8 + (size_t)m * 8 + hm];
                    const u32x4 a0 = *(const u32x4*)(od_r + (size_t)m * 1024 + hm * 128 + sub * 8);
                    u32x4 a1 = *(const u32x4*)(x1_r + (size_t)m * 512 + (hm & 3) * 128 + sub * 8), a2 = *(const u32x4*)(x2_r + (size_t)m * 512 + (hm & 3) * 128 + sub * 8);
                    c1 = s1 ? c1 : -1.0e30f; c2 = s2 ? c2 : -1.0e30f;
                    a1.x = s1 ? a1.x : 0u; a1.y = s1 ? a1.y : 0u; a1.z = s1 ? a1.z : 0u; a1.w = s1 ? a1.w : 0u; a2.x = s2 ? a2.x : 0u; a2.y = s2 ? a2.y : 0u; a2.z = s2 ? a2.z : 0u; a2.w = s2 ? a2.w : 0u;
                    const float cm = fmaxf(c0, fmaxf(c1, c2)); float w0 = fexp2(c0 - cm), w1 = fexp2(c1 - cm), w2 = fexp2(c2 - cm); const float wi = 1.0f / (w0 + w1 + w2); w0 *= wi; w1 *= wi; w2 *= wi;
                    om[mp][0] = w0 * bflo(a0.x) + w1 * bflo(a1.x) + w2 * bflo(a2.x); om[mp][1] = w0 * bfhi(a0.x) + w1 * bfhi(a1.x) + w2 * bfhi(a2.x);
                    om[mp][2] = w0 * bflo(a0.y) + w1 * bflo(a1.y) + w2 * bflo(a2.y); om[mp][3] = w0 * bfhi(a0.y) + w1 * bfhi(a1.y) + w2 * bfhi(a2.y);
                    om[mp][4] = w0 * bflo(a0.z) + w1 * bflo(a1.z) + w2 * bflo(a2.z); om[mp][5] = w0 * bfhi(a0.z) + w1 * bfhi(a1.z) + w2 * bfhi(a2.z);
                    om[mp][6] = w0 * bflo(a0.w) + w1 * bflo(a1.w) + w2 * bflo(a2.w); om[mp][7] = w0 * bfhi(a0.w) + w1 * bfhi(a1.w) + w2 * bfhi(a2.w); }
                float o[8], ss = 0.f;
#pragma unroll
                for (int j = 0; j < 8; ++j) { o[j] = om[0][j] - lam * om[1][j]; ss += o[j] * o[j]; }
                ss += __shfl_xor(ss, 1); ss += __shfl_xor(ss, 2); ss += __shfl_xor(ss, 4); ss += __shfl_xor(ss, 8);
                const float rs = 1.0f / sqrtf(ss * (1.f / 128.f) + GN_EPS);
                u32x4 w; w.x = cvt_pk_bf16(o[0] * rs * gsc[0], o[1] * rs * gsc[1]); w.y = cvt_pk_bf16(o[2] * rs * gsc[2], o[3] * rs * gsc[3]);
                w.z = cvt_pk_bf16(o[4] * rs * gsc[4], o[5] * rs * gsc[5]); w.w = cvt_pk_bf16(o[6] * rs * gsc[6], o[7] * rs * gsc[7]);
                *(u32x4*)(y_r + (size_t)m * YC + 1536 + head * 128 + sub * 8) = w;
            }
        }
        SEAM(pb + 3);
        PR_END(3); PR_BEGIN(4);
        if (EN(4) && IN(pb + 4)) { PH_PTRS;
            pg8::Gemm g{hb, wt_in + (size_t)l * INC * D + (size_t)ZC * D, D, D, D, M, ssb}; pg8::GridOrder S; S.init(M / 256, 4096 / 256, G, bx);
            pg8::EpiBf16<1, true> E{gtb, 4096}; pg8::gemm_phase<pg8::EpiBf16<1, true>, pg8::GridOrder, false>(lds, g, S, E, tid);
        }
        SEAM(pb + 4);
        PR_END(4); PR_BEGIN(5);
        if (EN(5) && IN(pb + 5)) { PH_PTRS;
            pg8::Gemm g{yb, wt_br + (size_t)l * 4 * D * 512, YC, 512, 512, M, nullptr}; pg8::BranchOrder S{G, vcu};
            pg8::EpiGateChain E{gtb, mrg}; pg8::gemm_phase<pg8::EpiGateChain, pg8::BranchOrder, false>(lds, g, S, E, tid);
        }
        SEAM(pb + 5);
        PR_END(5); PR_BEGIN(6);
        if (EN(6) && IN(pb + 6)) { PH_PTRS;
            pg8::Gemm g{mrg, wt_out + (size_t)l * D * D, D, D, D, M, nullptr}; pg8::GridOrder S; S.init(M / 256, D / 256, G, bx);
            pg8::EpiRes16 E{l == 0 ? xin : nullptr, hb, D, ssb}; pg8::gemm_phase<pg8::EpiRes16, pg8::GridOrder, false>(lds, g, S, E, tid);
        }
        SEAM(pb + 6);
        PR_END(6); PR_BEGIN(7);
        if (EN(7) && IN(pb + 7)) { PH_PTRS;
            pg8::Gemm g{hb, wt_mq + (size_t)l * 512 * D, D, D, D, M, ssb}; pg8::GridOrder S; S.init(M / 256, 2, G, bx);
            pg8::EpiBf16<0, true> E{qb, 512}; pg8::gemm_phase<pg8::EpiBf16<0, true>, pg8::GridOrder, false>(lds, g, S, E, tid);
        }
        SEAM(pb + 7);
        PR_END(7); PR_BEGIN(8);
        if (EN(8) && IN(pb + 8)) { PH_PTRS;
            for (int u = vcu; u < 256; u += G) { const int head = u & 3, qblk = u >> 2;
                att::AttnP P{qb + head * 128, kvmem + l * 512 + head * 128, kvmem + 1024 + l * 512 + head * 128, obf + head * 128, 512, 2048, 2048, 512,
                             qblk * 256, 0, 4, 0.f, 0, nullptr, nullptr};
                att::attn_unit<128, 128, 0>((LAS char*)lds, P, tid); }
        }
        SEAM(pb + 8);
        PR_END(8); PR_BEGIN(9);
        if (EN(9) && IN(pb + 9)) { PH_PTRS;
            pg8::Gemm g{obf, wt_mo + (size_t)l * D * 512, 512, 512, 512, M, nullptr}; pg8::GridOrder S; S.init(M / 256, D / 256, G, bx);
            pg8::EpiRes16 E{nullptr, hb, D, ssb}; pg8::gemm_phase<pg8::EpiRes16, pg8::GridOrder, false>(lds, g, S, E, tid);
        }
        SEAM(pb + 9);
        PR_END(9); PR_BEGIN(10);
        if (EN(10) && IN(pb + 10)) { PH_PTRS; unsigned* ecnt = ctl + CW_ECNT + l * 32 * 64;
            LAS float* part = (LAS float*)lds;
            LAS float* lg = (LAS float*)(lds + 81920);
            const int r32 = lane & 31, hi = lane >> 5; const bf16* wl_ = wtr + (size_t)l * 64 * D;
            for (int u = vcu; u < M / 64; u += G) { const int t0 = u * 64;
                f32x16 a00 = (f32x16){}, a01 = (f32x16){}, a10 = (f32x16){}, a11 = (f32x16){};
#pragma unroll
                for (int s8 = 0; s8 < 8; ++s8) { const int s = wid * 8 + s8;
                    const bf16x8 b0_ = *(const bf16x8*)(hb + (size_t)(t0 + r32) * D + 16 * s + 8 * hi), b1_ = *(const bf16x8*)(hb + (size_t)(t0 + 32 + r32) * D + 16 * s + 8 * hi);
                    const bf16x8 w0_ = *(const bf16x8*)(wl_ + (size_t)r32 * D + 16 * s + 8 * hi), w1_ = *(const bf16x8*)(wl_ + (size_t)(32 + r32) * D + 16 * s + 8 * hi);
                    a00 = __builtin_amdgcn_mfma_f32_32x32x16_bf16(w0_, b0_, a00, 0, 0, 0); a01 = __builtin_amdgcn_mfma_f32_32x32x16_bf16(w1_, b0_, a01, 0, 0, 0);
                    a10 = __builtin_amdgcn_mfma_f32_32x32x16_bf16(w0_, b1_, a10, 0, 0, 0); a11 = __builtin_amdgcn_mfma_f32_32x32x16_bf16(w1_, b1_, a11, 0, 0, 0); }
#pragma unroll
                for (int r = 0; r < 16; ++r) { part[(wid * 36 + att::crow(r, hi)) * 65 + r32] = a00[r]; part[(wid * 36 + att::crow(r, hi)) * 65 + 32 + r32] = a10[r]; }
                if (hi == 0) {
#pragma unroll
                    for (int r = 0; r < 4; ++r) { part[(wid * 36 + 32 + r) * 65 + r32] = a01[r]; part[(wid * 36 + 32 + r) * 65 + 32 + r32] = a11[r]; } }
                __syncthreads();
                for (int i = tid; i < 36 * 64; i += NTHREADS) { const int n = i >> 6, tk = i & 63; float sacc = 0.f;
#pragma unroll
                    for (int w = 0; w < 8; ++w) sacc += part[(w * 36 + n) * 65 + tk];
                    lg[tk * 37 + n] = sacc; }
                __syncthreads();
                if (wid < 2) {
                const LAS float* tl = lg + (32 * wid + r32) * 37; const float* bg = KA->in[I_B_GROUP] + l * 4; const float* br = KA->in[I_B_ROUTER] + l * 32;
                float rsn; { const f32x4* p_ = (const f32x4*)(ssb + (size_t)(t0 + 32 * wid + r32) * 16); const f32x4 a_ = p_[0], b_ = p_[1], c_ = p_[2], d_ = p_[3];
                    const float s_ = (((a_[0] + a_[1]) + (a_[2] + a_[3])) + ((b_[0] + b_[1]) + (b_[2] + b_[3]))) + (((c_[0] + c_[1]) + (c_[2] + c_[3])) + ((d_[0] + d_[1]) + (d_[2] + d_[3])));
                    rsn = 1.0f / sqrtf(s_ * (1.0f / 1024.0f) + NORM_EPS); }
                float gl[4];
#pragma unroll
                for (int j = 0; j < 4; ++j) gl[j] = tl[j] * rsn + bg[j];
                int gs = 0; float gmx = gl[0];
#pragma unroll
                for (int j = 1; j < 4; ++j) if (gl[j] > gmx) { gmx = gl[j]; gs = j; }
                float gsum = 0.f;
#pragma unroll
                for (int j = 0; j < 4; ++j) gsum += __expf(gl[j] - gmx);
                const float gprob = 1.0f / gsum;
                float el[8];
#pragma unroll
                for (int j = 0; j < 8; ++j) el[j] = tl[4 + 8 * gs + j] * rsn + br[8 * gs + j];
                int i0 = 0; float m0 = el[0];
#pragma unroll
                for (int j = 1; j < 8; ++j) if (el[j] > m0) { m0 = el[j]; i0 = j; }
                int i1 = -1; float m1 = -3.0e38f;
#pragma unroll
                for (int j = 0; j < 8; ++j) if (j != i0 && el[j] > m1) { m1 = el[j]; i1 = j; }
                const float e1 = __expf(m1 - m0); const float w0 = gprob / (1.0f + e1), w1 = gprob * e1 / (1.0f + e1);
                const int myk = hi; const int e = 8 * gs + (myk ? i1 : i0); const float w = myk ? w1 : w0;
                unsigned long long rem = ~0ull; int leader = 0, rank = 0, cnt = 0;
                while (rem) { const int ld_ = __builtin_ctzll(rem); const int ee = __shfl(e, ld_); const unsigned long long mk = __ballot(e == ee);
                    if (e == ee) { leader = ld_; rank = __builtin_popcountll(mk & ((1ull << lane) - 1ull)); cnt = __builtin_popcountll(mk); } rem &= ~mk; }
                unsigned base = 0u; if (lane == leader) base = __hip_atomic_fetch_add(ecnt + 64 * e, (unsigned)cnt, __ATOMIC_RELAXED, __HIP_MEMORY_SCOPE_AGENT);
                base = __shfl(base, leader); const int pos = (int)base + rank; const int tok = t0 + 32 * wid + r32;
                elist[e * 16384 + pos] = tok; tokE[tok * 2 + myk] = e; tokP[tok * 2 + myk] = pos; tokW[tok * 2 + myk] = w;
                }
                __syncthreads();
            }
        }
        SEAM(pb + 10);
        PR_END(10); PR_BEGIN(11);
#define DEFER_CONVERT(U_LO, U_HI, CTR_OFF) do { if (l == 0 && DEPTH > 1) { WT_CONSTS; WT_DECODE; \
                constexpr int NDEF = NIT - 2 * I_MQ; static_assert((DEPTH - 1) * NDEF / 32 == 224, "deferred units"); \
                LAS int* dqw = (LAS int*)(lds + LDS_MISC + 4096 + 128); unsigned* wctr = ctl + CW_DQ + (CTR_OFF); \
                __syncthreads(); \
                if (tid == 0) dqw[4] = (U_LO) + (int)__hip_atomic_fetch_add(wctr, 1u, __ATOMIC_RELAXED, __HIP_MEMORY_SCOPE_AGENT); \
                for (;;) { \
                    __syncthreads(); \
                    const int u = dqw[4]; if (u >= (U_HI)) break; \
                    unsigned nxc = 0u; if (tid == 0) nxc = (U_LO) + __hip_atomic_fetch_add(wctr, 1u, __ATOMIC_RELAXED, __HIP_MEMORY_SCOPE_AGENT); \
                    auto dit = [&](int q) -> int { const int ll = 1 + q / NDEF, qi = q % NDEF; return ll * NIT + (qi < KV0 ? qi : qi + 2 * I_MQ); }; \
                    const int q0 = u * 32 + wid * 4; LAS float* scr = (LAS float*)(lds + wid * 16384); \
                    const TrIt t0_ = decode(dit(q0)), t1_ = decode(dit(q0 + 1)), t2_ = decode(dit(q0 + 2)), t3_ = decode(dit(q0 + 3)); f32x4 va[8], vb_[8]; \
                    tr_load(t0_, lane, va); tr_load(t1_, lane, vb_); \
                    tr_finish(t0_, va, scr, lane); tr_load(t2_, lane, va); \
                    tr_finish(t1_, vb_, scr, lane); tr_load(t3_, lane, vb_); \
                    tr_finish(t2_, va, scr, lane); tr_finish(t3_, vb_, scr, lane); \
                    if (tid == 0) dqw[4] = (int)nxc; \
                } } } while (0)
        LAS int* mtab = (LAS int*)(lds + LDS_MISC + 1024);
        if ((EN(11) || EN(12)) && (IN(pb + 11) || IN(pb + 12))) { PH_PTRS; unsigned* ecnt = ctl + CW_ECNT + l * 32 * 64;
            if (tid == 0) { int nrt = 0; for (int e = 0; e < NEXP; ++e) { const int c = (int)__hip_atomic_load(ecnt + 64 * e, __ATOMIC_RELAXED, __HIP_MEMORY_SCOPE_AGENT); const int nt_ = (c + 255) >> 8;
                    for (int r = 0; r < nt_; ++r) { mtab[16 + 4 * nrt] = e; mtab[16 + 4 * nrt + 1] = r; mtab[16 + 4 * nrt + 2] = nrt; ++nrt; } }
                mtab[0] = nrt; }
            __syncthreads();
        }
        if (EN(11) && IN(pb + 11)) { PH_PTRS; unsigned* ecnt = ctl + CW_ECNT + l * 32 * 64;
            pg8::Gemm g{hb, w13, D, D, D, M, ssb}; pg8::MoeOrder S{mtab, G, vcu, 4, 1024, elist, ecnt};
            pg8::EpiSwiGlu E{hid}; pg8::gemm_phase<pg8::EpiSwiGlu, pg8::MoeOrder, true>(lds, g, S, E, tid);
            DEFER_CONVERT(0, 128, 192);
        }
        SEAM(pb + 11);
        PR_END(11); PR_BEGIN(12);
        if (EN(12) && IN(pb + 12)) { PH_PTRS; unsigned* ecnt = ctl + CW_ECNT + l * 32 * 64;
            pg8::Gemm g{hid, w2t, DEXP, DEXP, DEXP, M, nullptr}; pg8::MoeOrder S{mtab, G, vcu, 4, 1024, elist, ecnt};
            pg8::EpiBf16<0> E{ymoe, D}; pg8::gemm_phase<pg8::EpiBf16<0>, pg8::MoeOrder, false>(lds, g, S, E, tid);
            DEFER_CONVERT(128, 224, 200);
        }
        SEAM(pb + 12);
        PR_END(12); PR_BEGIN(13);
        if (EN(13) && IN(pb + 13)) { PH_PTRS; unsigned* ecnt = ctl + CW_ECNT + l * 32 * 64;
            int sb = 0; { const int c = lane < NEXP ? (int)__hip_atomic_load(ecnt + 64 * (lane & 31), __ATOMIC_RELAXED, __HIP_MEMORY_SCOPE_AGENT) : 0; const int nt_ = (c + 255) >> 8; int inc = nt_;
#pragma unroll
                for (int o = 1; o < 32; o <<= 1) { const int v = __shfl_up(inc, o); if ((lane & 31) >= o) inc += v; }
                sb = (inc - nt_) * 256; }
            const float* gn = KA->in[I_FINAL_NORM];
            float* __restrict__ xo_r = xout; const bf16* __restrict__ ym_r = ymoe; bf16* __restrict__ hb_r = hb; float* __restrict__ ss_r = ssb;
            const int* __restrict__ te_r = tokE; const int* __restrict__ tp_r = tokP; const float* __restrict__ tw_r = tokW;
#pragma unroll 4
            for (int m = gw; m < M; m += NGW) {
                const int e0 = te_r[m * 2], e1 = te_r[m * 2 + 1]; const float w0 = tw_r[m * 2], w1 = tw_r[m * 2 + 1];
                const size_t s0 = (size_t)(__shfl(sb, e0) + tp_r[m * 2]), s1 = (size_t)(__shfl(sb, e1) + tp_r[m * 2 + 1]);
                float v[2][8]; float ss = 0.f;
#pragma unroll
                for (int j = 0; j < 2; ++j) { const u32x4 xw = ((const u32x4*)(hb_r + (size_t)m * D))[lane + 64 * j], a = ((const u32x4*)(ym_r + s0 * D))[lane + 64 * j], b = ((const u32x4*)(ym_r + s1 * D))[lane + 64 * j];
                    v[j][0] = bflo(xw.x) + w0 * bflo(a.x) + w1 * bflo(b.x); v[j][1] = bfhi(xw.x) + w0 * bfhi(a.x) + w1 * bfhi(b.x); v[j][2] = bflo(xw.y) + w0 * bflo(a.y) + w1 * bflo(b.y); v[j][3] = bfhi(xw.y) + w0 * bfhi(a.y) + w1 * bfhi(b.y);
                    v[j][4] = bflo(xw.z) + w0 * bflo(a.z) + w1 * bflo(b.z); v[j][5] = bfhi(xw.z) + w0 * bfhi(a.z) + w1 * bfhi(b.z); v[j][6] = bflo(xw.w) + w0 * bflo(a.w) + w1 * bflo(b.w); v[j][7] = bfhi(xw.w) + w0 * bfhi(a.w) + w1 * bfhi(b.w);
#pragma unroll
                    for (int q = 0; q < 8; q += 2) ss += v[j][q] * v[j][q] + v[j][q + 1] * v[j][q + 1]; }
                const float sst = wave_sum(ss);
                if (l + 1 < DEPTH) { float sr = 0.f;
#pragma unroll
                    for (int j = 0; j < 2; ++j) { u32x4 w; w.x = pk2(v[j][0], v[j][1]); w.y = pk2(v[j][2], v[j][3]); w.z = pk2(v[j][4], v[j][5]); w.w = pk2(v[j][6], v[j][7]);
                        ((u32x4*)(hb_r + (size_t)m * D))[lane + 64 * j] = w;
                        sr += ((bflo(w.x) * bflo(w.x) + bfhi(w.x) * bfhi(w.x)) + (bflo(w.y) * bflo(w.y) + bfhi(w.y) * bfhi(w.y))) + ((bflo(w.z) * bflo(w.z) + bfhi(w.z) * bfhi(w.z)) + (bflo(w.w) * bflo(w.w) + bfhi(w.w) * bfhi(w.w))); }
                    sr = wave_sum(sr);
                    if (lane < 16) ss_r[(size_t)m * 16 + lane] = lane == 0 ? sr : 0.f;
                } else {
                    const float rstd = 1.f / sqrtf(sst * (1.f / D) + NORM_EPS);
#pragma unroll
                    for (int j = 0; j < 2; ++j) { const f32x4 g0 = ((const f32x4*)gn)[2 * (lane + 64 * j)], g1 = ((const f32x4*)gn)[2 * (lane + 64 * j) + 1];
                        f32x4* op = (f32x4*)(xo_r + (size_t)m * D) + 2 * (lane + 64 * j);
                        op[0] = (f32x4){v[j][0] * rstd * g0.x, v[j][1] * rstd * g0.y, v[j][2] * rstd * g0.z, v[j][3] * rstd * g0.w};
                        op[1] = (f32x4){v[j][4] * rstd * g1.x, v[j][5] * rstd * g1.y, v[j][6] * rstd * g1.z, v[j][7] * rstd * g1.w}; }
                }
            }
        }
        SEAM(pb + 13);
        PR_END(13);
    }
#ifdef PROBE_MASK
    if (blockIdx.x == 0) { const unsigned long long t_end = __builtin_amdgcn_s_memrealtime() + (unsigned long long)(PROBE_MULT) * pr_acc; while (__builtin_amdgcn_s_memrealtime() < t_end) __builtin_amdgcn_s_sleep(8); }
#endif
#undef IN
#undef SEAM
}

extern "C" void kernel_launch(void* const* d_in, const int* in_sizes, int n_in, void* d_out, int out_size, void* d_ws, size_t ws_size, hipStream_t stream) {
    static int grid = 0;
    if (grid == 0) {
        if (n_in != 31 || in_sizes[0] != M * D || out_size != M * D || ws_size < WS_END) { fprintf(stderr, "kernel_launch: unexpected problem (n_in %d, in0 %d, out %d, ws %zu < %zu)\n", n_in, n_in > 0 ? in_sizes[0] : -1, out_size, ws_size, (size_t)WS_END); grid = -1; return; }
        int dev = 0, cus = 0, per_cu = 0;
        if (hipGetDevice(&dev) != hipSuccess || hipDeviceGetAttribute(&cus, hipDeviceAttributeMultiprocessorCount, dev) != hipSuccess) { grid = -1; return; }
        if (hipFuncSetAttribute((const void*)fwd_kernel, hipFuncAttributeMaxDynamicSharedMemorySize, LDS_BYTES) != hipSuccess) { fprintf(stderr, "kernel_launch: hipFuncSetAttribute failed\n"); grid = -1; return; }
        if (hipOccupancyMaxActiveBlocksPerMultiprocessor(&per_cu, (const void*)fwd_kernel, NTHREADS, LDS_BYTES) != hipSuccess || per_cu < 1) { fprintf(stderr, "kernel_launch: occupancy query says %d\n", per_cu); }
        (void)hipGetLastError();
        grid = cus;
    }
    if (grid < 0) return;
    if (hipMemsetAsync((char*)d_ws + WS_CTL, 0, CTL_ZERO_BYTES, stream) != hipSuccess) return;
    Args a{};
    for (int i = 0; i < 31; ++i) a.in[i] = (const float*)d_in[i];
    a.out = (float*)d_out; a.ws = (unsigned char*)d_ws;
#if MK_N_LAUNCHES == 1
    a.ph_lo = 0; a.ph_hi = NPHASE;
    hipLaunchKernelGGL(fwd_kernel, dim3(grid), dim3(NTHREADS), LDS_BYTES, stream, a);
#else
    for (int p = 0; p < NPHASE; ++p) { a.ph_lo = p; a.ph_hi = p + 1; hipLaunchKernelGGL(fwd_kernel, dim3(grid), dim3(NTHREADS), LDS_BYTES, stream, a); }
#endif
}
```

```cpp
#include <hip/hip_runtime.h>
#include <cstdio>
#include <cstdint>
#include <cmath>

#ifndef MK_N_LAUNCHES
#define MK_N_LAUNCHES 1
#endif

#define LAS __attribute__((address_space(3)))
#define GAS __attribute__((address_space(1)))
#define ST16_WT(ptr_, val_) do { const GAS u32x4* sp_ = (const GAS u32x4*)(ptr_); const u32x4 sv_ = (val_); asm volatile("global_store_dwordx4 %0, %1, off sc1\n\ts_nop 3" :: "v"(sp_), "v"(sv_) : "memory"); } while (0)
typedef unsigned short bf16;
typedef short bf16x8 __attribute__((ext_vector_type(8)));
typedef short s16x4 __attribute__((ext_vector_type(4)));
typedef float f32x4 __attribute__((ext_vector_type(4)));
typedef float f32x2 __attribute__((ext_vector_type(2)));
typedef float f32x16 __attribute__((ext_vector_type(16)));
typedef unsigned u32x4 __attribute__((ext_vector_type(4)));
typedef unsigned u32x2 __attribute__((ext_vector_type(2)));

constexpr int M = 16384, D = 1024, DEPTH = 2, CHUNK = 64, NCHUNK = M / CHUNK, MEM_LEN = 256;
constexpr int ZC = 6144, INC = 10240, YC = 2048;
constexpr int Z_AX = 0, Z_AG = 512, Z_BQ = 1024, Z_BK = 1536, Z_BV = 2048, Z_CQ = 2560, Z_CK = 3072, Z_CV = 3584, Z_CG = 4096, Z_DQ = 4608, Z_DK = 5120, Z_DV = 5632;
constexpr int NEXP = 32, DEXP = 512;
constexpr int HROWS = M + 256;
constexpr int MAXSLOT = 41216;
constexpr float NORM_EPS = 1e-6f, GN_EPS = 1e-5f;
constexpr float LOG2E = 1.4426950408889634f;

constexpr size_t MiB = 1u << 20;
constexpr size_t WS_CTL = 0, CTL_ZERO_BYTES = 1 * MiB;
constexpr size_t WS_MEMN = 1 * MiB;
constexpr size_t WS_KMEM = 2 * MiB;
constexpr size_t WS_VMEM = 2 * MiB + 512 * 1024;
constexpr size_t WS_WTR = 3 * MiB;
constexpr size_t WS_LRUW = 3 * MiB + 256 * 1024;
constexpr size_t WS_CARA = 4 * MiB;
constexpr size_t WS_CARH = 4 * MiB + 512 * 1024;
constexpr size_t WS_CARI = 5 * MiB;
constexpr size_t WS_QKN = 5 * MiB + 512 * 1024;
constexpr size_t WS_LSE = 6 * MiB + 512 * 1024;
constexpr size_t WS_TOKE = 6 * MiB;
constexpr size_t WS_TOKP = 6 * MiB + 128 * 1024;
constexpr size_t WS_TOKW = 6 * MiB + 256 * 1024;
constexpr size_t WS_ELIST = 8 * MiB;
constexpr size_t WS_WIN = 10 * MiB;
constexpr size_t WS_WBR = 50 * MiB;
constexpr size_t WS_WOUT = 58 * MiB;
constexpr size_t WS_WMQ = 62 * MiB;
constexpr size_t WS_WMK = 64 * MiB;
constexpr size_t WS_WMV = 66 * MiB;
constexpr size_t WS_WMO = 68 * MiB;
constexpr size_t WS_W13 = 70 * MiB;
constexpr size_t WS_W2 = 134 * MiB;
constexpr size_t WS_H = 166 * MiB;
constexpr size_t WS_Y = 200 * MiB;
constexpr size_t WS_KVT = 264 * MiB;
constexpr size_t WS_RT = 296 * MiB;
constexpr size_t WS_OD = 312 * MiB;
constexpr size_t WS_Z = 344 * MiB;
constexpr size_t WS_G = 344 * MiB;
constexpr size_t WS_MRG = 472 * MiB;
constexpr size_t WS_QB = 504 * MiB;
constexpr size_t WS_OB = 520 * MiB;
constexpr size_t WS_HID = 344 * MiB;
constexpr size_t WS_YMOE = 386 * MiB;
constexpr size_t WS_XS1 = 536 * MiB;
constexpr size_t WS_XS2 = 552 * MiB;
constexpr size_t WS_SS = 568 * MiB;
constexpr size_t WS_END = 569 * MiB;
static_assert(WS_HID + (size_t)MAXSLOT * 512 * 2 <= WS_YMOE && WS_YMOE + (size_t)MAXSLOT * 1024 * 2 <= WS_MRG, "moe overlay");
constexpr int CW_TMO = 0, CW_CODE = 1;
constexpr int CW_BAR = 4096;
constexpr int CW_ECNT = 16384;
constexpr int CW_DQ = 24576;

constexpr int LDS_BYTES = 147456;
constexpr int LDS_MISC = 131072;
constexpr int NWAVES = 8, NTHREADS = 512;

__device__ __forceinline__ unsigned f2bf(float f) { unsigned u = __builtin_bit_cast(unsigned, f); return (u + 0x7fffu + ((u >> 16) & 1u)) >> 16; }
__device__ __forceinline__ unsigned pk2(float lo, float hi) { return f2bf(lo) | (f2bf(hi) << 16); }
__device__ __forceinline__ float bf2f(unsigned short b) { return __builtin_bit_cast(float, ((unsigned)b) << 16); }
__device__ __forceinline__ float bflo(unsigned w) { return __builtin_bit_cast(float, w << 16); }
__device__ __forceinline__ float bfhi(unsigned w) { return __builtin_bit_cast(float, w & 0xffff0000u); }
typedef __bf16 bf16x2_t __attribute__((ext_vector_type(2)));
__device__ __forceinline__ unsigned cvt_pk_bf16(float lo, float hi) { const f32x2 v = {lo, hi}; const bf16x2_t b = __builtin_convertvector(v, bf16x2_t); return __builtin_bit_cast(unsigned, b); }
__device__ __forceinline__ float fexp2(float x) { return __builtin_amdgcn_exp2f(x); }
__device__ __forceinline__ float frcp(float x) { return __builtin_amdgcn_rcpf(x); }
__device__ __forceinline__ float sigmoidf_(float x) { return frcp(1.0f + fexp2(-x * LOG2E)); }
__device__ __forceinline__ float wave_sum(float v) {
#pragma unroll
    for (int o = 1; o < 64; o <<= 1) v += __shfl_xor(v, o);
    return v;
}
#define LDS_WAIT() asm volatile("s_waitcnt lgkmcnt(0)" ::: "memory")
#define VM_WAIT() asm volatile("s_waitcnt vmcnt(0)" ::: "memory")

namespace pg8 {
constexpr int BM = 256, BK = 64, HALF = 128, HTB = HALF * BK * 2, STAGE_BYTES = 8 * HTB, NXCD = 8, WGM = 8;
__host__ __device__ __forceinline__ int lds_byte(int r, int c) { const int st = (r >> 4) * 2 + (c >> 5), rr = r & 15, cc = c & 31, ob = rr * 64 + cc * 2; return st * 1024 + (ob ^ (((ob >> 9) & 1) << 5)); }
__host__ __device__ __forceinline__ void stage_rc(int b, int& R, int& C) { const int st = b / 1024, sb = b % 1024, swz = sb ^ (((sb >> 9) & 1) << 5); R = (st >> 1) * 16 + swz / 64; C = (st & 1) * 32 + (swz % 64) / 2; }
__host__ __device__ __forceinline__ int perm32(int rho) { const int n = rho >> 4, i = rho & 15; return 8 * (i >> 2) + 4 * n + (i & 3); }

struct Unit { int arow, acol, brow, pm, pn, aux, gcnt; const int* gl; };
struct Gemm { const bf16* A; const bf16* Bt; int lda, ldb, K, zrow; const float* ss; };

template <class Epi, class Sched, bool GATHER>
__device__ __forceinline__ void gemm_phase(LAS unsigned char* lds, const Gemm g, const Sched& S, const Epi& E, const int tid) {
    const int wid = __builtin_amdgcn_readfirstlane(tid >> 6), lane = tid & 63, wr = wid >> 2, wc = wid & 3, fr = lane & 15, fq = lane >> 4;
    const int K = g.K, nt = K / BK;
    unsigned voffA[2][2], voffB[2];
#pragma unroll
    for (int i = 0; i < 2; ++i) { int R, C; stage_rc(tid * 16 + i * 8192, R, C); const int Rb = Epi::PERM ? ((R & ~31) + perm32(R & 31)) : R;
        voffA[0][i] = (unsigned)(R * g.lda + C) * 2u; voffA[1][i] = voffA[0][i]; voffB[i] = (unsigned)(Rb * g.ldb + C) * 2u; }
    const size_t kstep = (size_t)(BK * 2);
    const size_t hstepA = GATHER ? (size_t)0 : (size_t)HALF * g.lda * 2;
    const size_t hstepB = (size_t)HALF * g.ldb * 2;
    const unsigned ldsw = (unsigned)wid * 1024u;
    const int aoff = lds_byte(wr * 64 + fr, fq * 8), boff = lds_byte(wc * 32 + fr, fq * 8);
#define PG8_SA(b, h) (((b) * 2 + (h)) * HTB)
#define PG8_SB(b, h) ((4 + (b) * 2 + (h)) * HTB)
#define PG8_STAGE(bufoff, gbase, voff) do { _Pragma("unroll") for (int _i = 0; _i < 2; ++_i) \
        __builtin_amdgcn_global_load_lds((const unsigned*)((const char*)(gbase) + (voff)[_i]), (LAS unsigned*)(lds + (bufoff) + ldsw + _i * 8192), 16, 0, 0); } while (0)
#define PG8_LDA(dst, b, h) do { _Pragma("unroll") for (int m = 0; m < 4; ++m) _Pragma("unroll") for (int k = 0; k < 2; ++k) dst[m][k] = *(const LAS bf16x8*)(lds + PG8_SA(b, h) + aoff + m * 2048 + k * 1024); } while (0)
#define PG8_LDB(dst, b, h) do { _Pragma("unroll") for (int n = 0; n < 2; ++n) _Pragma("unroll") for (int k = 0; k < 2; ++k) dst[n][k] = *(const LAS bf16x8*)(lds + PG8_SB(b, h) + boff + n * 2048 + k * 1024); } while (0)
#define PG8_MMA(ai, bj, At, Bt) do { __builtin_amdgcn_s_setprio(1); _Pragma("unroll") for (int m = 0; m < 4; ++m) _Pragma("unroll") for (int n = 0; n < 2; ++n) _Pragma("unroll") for (int k = 0; k < 2; ++k) \
        acc[ai][bj][m][n] = __builtin_amdgcn_mfma_f32_16x16x32_bf16(Bt[n][k], At[m][k], acc[ai][bj][m][n], 0, 0, 0); __builtin_amdgcn_s_setprio(0); } while (0)
#define PG8_WAIT_V(n) asm volatile("s_waitcnt vmcnt(" #n ")" ::: "memory")
#define PG8_WAIT_L(n) asm volatile("s_waitcnt lgkmcnt(" #n ")" ::: "memory")
#define PG8_BAR __builtin_amdgcn_s_barrier()
#define PG8_SCHED __builtin_amdgcn_sched_barrier(0)
#define PG8_SETA(u) do { if constexpr (GATHER) { _Pragma("unroll") for (int _h = 0; _h < 2; ++_h) _Pragma("unroll") for (int _i = 0; _i < 2; ++_i) { \
        int _R, _C; stage_rc(tid * 16 + _i * 8192, _R, _C); const int _r = _h * HALF + _R; const int _row = (_r < (u).gcnt) ? (u).gl[_r] : g.zrow; \
        voffA[_h][_i] = ((unsigned)_row * (unsigned)g.lda + (unsigned)_C) * 2u; } } } while (0)
#define PG8_ABASE(u) (GATHER ? (const char*)g.A : (const char*)g.A + ((size_t)(u).arow * g.lda + (u).acol) * 2)
    LAS float* rstab = (LAS float*)(lds + STAGE_BYTES + 12288);
#define PG8_RSTAB(u, par) do { if constexpr (Epi::RS) { if (tid < 256) { int _row; if constexpr (GATHER) { _row = (tid < (u).gcnt) ? (u).gl[tid] : -1; } else { _row = (u).arow + tid; } \
        float _v = 0.f; if (_row >= 0) { const f32x4* _p = (const f32x4*)(g.ss + (size_t)_row * 16); const f32x4 _a = _p[0], _b = _p[1], _c = _p[2], _d = _p[3]; \
            const float _s = (((_a[0] + _a[1]) + (_a[2] + _a[3])) + ((_b[0] + _b[1]) + (_b[2] + _b[3]))) + (((_c[0] + _c[1]) + (_c[2] + _c[3])) + ((_d[0] + _d[1]) + (_d[2] + _d[3]))); \
            _v = 1.0f / sqrtf(_s * (1.0f / 1024.0f) + 1e-6f); } \
        rstab[(par) * 256 + tid] = _v; } } } while (0)
    Unit cur, nxt; int ui = 0;
    if (!S.next(0, cur)) return;
    PG8_RSTAB(cur, 0);
    f32x4 acc[2][2][4][2];
#pragma unroll
    for (int a = 0; a < 2; ++a)
#pragma unroll
        for (int b = 0; b < 2; ++b)
#pragma unroll
            for (int m = 0; m < 4; ++m)
#pragma unroll
                for (int n = 0; n < 2; ++n) acc[a][b][m][n] = (f32x4){0.f, 0.f, 0.f, 0.f};
    bf16x8 At[4][2], B0[2][2], B1[2][2];
    PG8_SETA(cur);
    const char* cA = PG8_ABASE(cur);
    const char* cB = (const char*)g.Bt + (size_t)cur.brow * g.ldb * 2;
    PG8_STAGE(PG8_SB(0, 0), cB, voffB); PG8_STAGE(PG8_SB(0, 1), cB + hstepB, voffB); PG8_STAGE(PG8_SA(0, 0), cA, voffA[0]); PG8_STAGE(PG8_SA(0, 1), cA + hstepA, voffA[1]);
    if (wr == 1) PG8_BAR;
    PG8_WAIT_V(2); PG8_BAR;
    PG8_STAGE(PG8_SB(1, 0), cB + kstep, voffB); PG8_STAGE(PG8_SA(1, 0), cA + kstep, voffA[0]); PG8_STAGE(PG8_SB(1, 1), cB + hstepB + kstep, voffB);
    PG8_WAIT_V(6); PG8_BAR;
    for (;;) {
        const bool has_next = S.next(ui + 1, nxt);
        const char* nA = has_next ? PG8_ABASE(nxt) : cA; const char* nB = has_next ? (const char*)g.Bt + (size_t)nxt.brow * g.ldb * 2 : cB;
        for (int t = 0; t < nt; t += 2) {
            const bool last = (t == nt - 2);
            const char* a1 = cA + (size_t)(t + 1) * kstep;
            const char* a2 = last ? nA : cA + (size_t)(t + 2) * kstep; const char* b2 = last ? nB : cB + (size_t)(t + 2) * kstep;
            const char* a3 = a2 + kstep; const char* b3 = b2 + kstep;
            PG8_LDB(B0, 0, 0); PG8_LDB(B1, 0, 1); PG8_SCHED; PG8_LDA(At, 0, 0); PG8_STAGE(PG8_SA(1, 1), a1 + hstepA, voffA[1]);
            if (last && has_next) { PG8_SETA(nxt); }
            PG8_WAIT_V(8); PG8_WAIT_L(0); PG8_BAR; PG8_MMA(0, 0, At, B0); PG8_MMA(0, 1, At, B1); PG8_BAR; PG8_SCHED;
            PG8_LDA(At, 0, 1); PG8_STAGE(PG8_SB(0, 0), b2, voffB); PG8_STAGE(PG8_SB(0, 1), b2 + hstepB, voffB); PG8_STAGE(PG8_SA(0, 0), a2, voffA[0]);
            PG8_WAIT_V(8); PG8_WAIT_L(0); PG8_BAR; PG8_MMA(1, 0, At, B0); PG8_MMA(1, 1, At, B1); PG8_BAR; PG8_SCHED;
            PG8_LDB(B0, 1, 0); PG8_LDB(B1, 1, 1); PG8_SCHED; PG8_LDA(At, 1, 0); PG8_STAGE(PG8_SA(0, 1), a2 + hstepA, voffA[1]);
            PG8_WAIT_V(8); PG8_WAIT_L(0); PG8_BAR; PG8_MMA(0, 0, At, B0); PG8_MMA(0, 1, At, B1); PG8_BAR; PG8_SCHED;
            PG8_LDA(At, 1, 1); PG8_STAGE(PG8_SB(1, 0), b3, voffB); PG8_STAGE(PG8_SB(1, 1), b3 + hstepB, voffB); PG8_STAGE(PG8_SA(1, 0), a3, voffA[0]);
            PG8_WAIT_V(8); PG8_WAIT_L(0); PG8_BAR; PG8_MMA(1, 0, At, B0); PG8_MMA(1, 1, At, B1); PG8_BAR; PG8_SCHED;
        }
        if (wr == 0) PG8_BAR;
        E(acc, cur, wr, wc, fr, fq, rstab + (ui & 1) * 256);
        if (!has_next) break;
        if (!(Epi::CHAIN && nxt.aux != 0)) {
#pragma unroll
        for (int a = 0; a < 2; ++a)
#pragma unroll
            for (int b = 0; b < 2; ++b)
#pragma unroll
                for (int m = 0; m < 4; ++m)
#pragma unroll
                    for (int n = 0; n < 2; ++n) acc[a][b][m][n] = (f32x4){0.f, 0.f, 0.f, 0.f};
        }
        cur = nxt; cA = nA; cB = nB; ++ui;
        PG8_RSTAB(cur, ui & 1);
        if (wr == 1) PG8_BAR;
    }
    PG8_WAIT_V(0);
    PG8_BAR;
#undef PG8_SA
#undef PG8_SB
#undef PG8_STAGE
#undef PG8_LDA
#undef PG8_LDB
#undef PG8_MMA
#undef PG8_WAIT_V
#undef PG8_WAIT_L
#undef PG8_BAR
#undef PG8_SCHED
#undef PG8_SETA
#undef PG8_ABASE
#undef PG8_RSTAB
}

struct GridOrder {
    int nM, nN, nwg, G, c, arow0, acol, brow0;
    __device__ void init(int nM_, int nN_, int G_, int c_, int arow0_ = 0, int acol_ = 0, int brow0_ = 0) { nM = nM_; nN = nN_; nwg = nM * nN; G = G_; c = c_; arow0 = arow0_; acol = acol_; brow0 = brow0_; }
    __device__ __forceinline__ bool next(int i, Unit& u) const {
        const long L = (long)i * G + c; if (L >= nwg) return false;
        int wgid = (int)L; { const int q = nwg / NXCD, r = nwg % NXCD, xcd = wgid % NXCD, off = wgid / NXCD; wgid = (xcd < r ? xcd * (q + 1) : r * (q + 1) + (xcd - r) * q) + off; }
        const int nig = WGM * nN, gid = wgid / nig, fm = gid * WGM, gsz = (nM - fm) < WGM ? (nM - fm) : WGM;
        u.pm = fm + ((wgid % nig) % gsz); u.pn = (wgid % nig) / gsz;
        u.arow = arow0 + u.pm * BM; u.acol = acol; u.brow = brow0 + u.pn * BM; u.aux = 0; u.gcnt = 0; u.gl = nullptr; return true;
    }
};
struct BranchOrder {
    int G, c;
    __device__ __forceinline__ bool next(int i, Unit& u) const {
        const int tile = (i >> 2) * G + c, b = i & 3; if (tile >= 256) return false;
        u.pm = tile >> 2; u.pn = tile & 3; u.arow = u.pm * BM; u.acol = b * 512; u.brow = b * 1024 + u.pn * BM; u.aux = b; u.gcnt = 0; u.gl = nullptr; return true;
    }
};
struct MoeOrder {
    const LAS int* tab; int G, c, nct, brows; const int* elist; const unsigned* ecnt;
    __device__ __forceinline__ bool next(int i, Unit& u) const {
        const int L = i * G + c, nrt = tab[0]; if (L >= nrt * nct) return false;
        const int j = L / nct, ct = L % nct; const int e = tab[16 + 4 * j], rt = tab[16 + 4 * j + 1], st = tab[16 + 4 * j + 2];
        u.pm = st; u.pn = ct; u.arow = st * BM; u.acol = 0; u.brow = e * brows + ct * BM; u.aux = e;
        const int cnt = (int)ecnt[64 * e]; u.gcnt = cnt - rt * BM; u.gl = elist + e * 16384 + rt * BM; return true;
    }
};

template <int ACT  , bool RS_ = false> struct EpiBf16 {
    static constexpr bool PERM = true, RS = RS_, CHAIN = false;
    bf16* O; int ldc;
    __device__ __forceinline__ void operator()(const f32x4 (&acc)[2][2][4][2], const Unit& u, int wr, int wc, int fr, int fq, const LAS float* rst) const {
        const int row0 = u.pm * BM + wr * 64 + fr, col0 = u.pn * BM + wc * 32 + 8 * fq;
#pragma unroll
        for (int ai = 0; ai < 2; ++ai)
#pragma unroll
            for (int m = 0; m < 4; ++m) { bf16* rowp = O + (size_t)(row0 + ai * HALF + m * 16) * ldc + col0;
#pragma unroll
                for (int bj = 0; bj < 2; ++bj) { f32x4 v0 = acc[ai][bj][m][0], v1 = acc[ai][bj][m][1];
                    if (RS_) { const float rs = rst[ai * HALF + wr * 64 + m * 16 + fr]; v0 = v0 * rs; v1 = v1 * rs; }
                    if (ACT == 1) {
#pragma unroll
                        for (int j = 0; j < 4; ++j) { v0[j] = fminf(1.0f + fexp2(-v0[j] * LOG2E), 1.0e30f); v1[j] = fminf(1.0f + fexp2(-v1[j] * LOG2E), 1.0e30f); } }
                    u32x4 w; w.x = cvt_pk_bf16(v0[0], v0[1]); w.y = cvt_pk_bf16(v0[2], v0[3]); w.z = cvt_pk_bf16(v1[0], v1[1]); w.w = cvt_pk_bf16(v1[2], v1[3]);
                    { const GAS u32x4* sp_ = (const GAS u32x4*)(rowp + bj * HALF); asm volatile("global_store_dwordx4 %0, %1, off sc1\n\ts_nop 3" :: "v"(sp_), "v"(w) : "memory"); } } }
    }
};
struct EpiGateChain {
    static constexpr bool PERM = true, RS = false, CHAIN = true;
    const bf16* U; bf16* Mg;
    __device__ __forceinline__ void operator()(f32x4 (&acc)[2][2][4][2], const Unit& u, int wr, int wc, int fr, int fq, const LAS float*) const {
        const int row0 = u.pm * BM + wr * 64 + fr, col0 = u.pn * BM + wc * 32 + 8 * fq, b = u.aux;
        const bf16* __restrict__ up = U + (size_t)row0 * 4096 + b * 1024 + col0;
        if (b < 3) {
            u32x4 ub[2][2][2], un[2][2][2];
#define EGC_LOAD(q, s_) do { _Pragma("unroll") for (int mm = 0; mm < 2; ++mm) _Pragma("unroll") for (int bj = 0; bj < 2; ++bj) { \
                const bf16* p = up + (size_t)(((q) >> 1) * HALF + (2 * ((q) & 1) + mm) * 16) * 4096 + bj * HALF; ub[s_][mm][bj] = *(const u32x4*)p; un[s_][mm][bj] = *(const u32x4*)(p + 1024); } } while (0)
#define EGC_CALC(q, s_) do { _Pragma("unroll") for (int mm = 0; mm < 2; ++mm) _Pragma("unroll") for (int bj = 0; bj < 2; ++bj) { const u32x4 d = ub[s_][mm][bj], n_ = un[s_][mm][bj]; \
                f32x4& v0 = acc[(q) >> 1][bj][2 * ((q) & 1) + mm][0]; f32x4& v1 = acc[(q) >> 1][bj][2 * ((q) & 1) + mm][1]; \
                v0[0] *= bflo(n_.x) * frcp(bflo(d.x)); v0[1] *= bfhi(n_.x) * frcp(bfhi(d.x)); v0[2] *= bflo(n_.y) * frcp(bflo(d.y)); v0[3] *= bfhi(n_.y) * frcp(bfhi(d.y)); \
                v1[0] *= bflo(n_.z) * frcp(bflo(d.z)); v1[1] *= bfhi(n_.z) * frcp(bfhi(d.z)); v1[2] *= bflo(n_.w) * frcp(bflo(d.w)); v1[3] *= bfhi(n_.w) * frcp(bfhi(d.w)); } } while (0)
            EGC_LOAD(0, 0); EGC_LOAD(1, 1); asm volatile("" ::: "memory");
            EGC_CALC(0, 0); asm volatile("" ::: "memory"); EGC_LOAD(2, 0); asm volatile("" ::: "memory");
            EGC_CALC(1, 1); asm volatile("" ::: "memory"); EGC_LOAD(3, 1); asm volatile("" ::: "memory");
            EGC_CALC(2, 0); EGC_CALC(3, 1);
#undef EGC_LOAD
#undef EGC_CALC
        } else {
#pragma unroll
            for (int ai = 0; ai < 2; ++ai) {
                u32x4 ub[4][2];
#pragma unroll
                for (int m = 0; m < 4; ++m)
#pragma unroll
                    for (int bj = 0; bj < 2; ++bj) ub[m][bj] = *(const u32x4*)(up + (size_t)(ai * HALF + m * 16) * 4096 + bj * HALF);
#pragma unroll
                for (int m = 0; m < 4; ++m) { bf16* rowp = Mg + (size_t)(row0 + ai * HALF + m * 16) * 1024 + col0;
#pragma unroll
                    for (int bj = 0; bj < 2; ++bj) { const u32x4 d = ub[m][bj]; const f32x4 v0 = acc[ai][bj][m][0], v1 = acc[ai][bj][m][1]; u32x4 w;
                        w.x = cvt_pk_bf16(v0[0] * frcp(bflo(d.x)), v0[1] * frcp(bfhi(d.x))); w.y = cvt_pk_bf16(v0[2] * frcp(bflo(d.y)), v0[3] * frcp(bfhi(d.y)));
                        w.z = cvt_pk_bf16(v1[0] * frcp(bflo(d.z)), v1[1] * frcp(bfhi(d.z))); w.w = cvt_pk_bf16(v1[2] * frcp(bflo(d.w)), v1[3] * frcp(bfhi(d.w)));
                        ST16_WT(rowp + bj * HALF, w); } } }
        }
    }
};
struct EpiRes16 {
    static constexpr bool PERM = true, RS = false, CHAIN = false;
    const float* base32; bf16* xb; int ldc; float* ss;
    __device__ __forceinline__ void operator()(const f32x4 (&acc)[2][2][4][2], const Unit& u, int wr, int wc, int fr, int fq, const LAS float*) const {
        const int row0 = u.pm * BM + wr * 64 + fr, col0 = u.pn * BM + wc * 32 + 8 * fq;
#pragma unroll
        for (int ai = 0; ai < 2; ++ai) {
            f32x4 b0[4][2], b1[4][2];
#pragma unroll
            for (int m = 0; m < 4; ++m) { const size_t off = (size_t)(row0 + ai * HALF + m * 16) * ldc + col0;
#pragma unroll
                for (int bj = 0; bj < 2; ++bj) {
                    if (base32) { b0[m][bj] = *(const f32x4*)(base32 + off + bj * HALF); b1[m][bj] = *(const f32x4*)(base32 + off + bj * HALF + 4); }
                    else { const u32x4 w = *(const u32x4*)(xb + off + bj * HALF); b0[m][bj] = (f32x4){bflo(w.x), bfhi(w.x), bflo(w.y), bfhi(w.y)}; b1[m][bj] = (f32x4){bflo(w.z), bfhi(w.z), bflo(w.w), bfhi(w.w)}; } } }
#pragma unroll
            for (int m = 0; m < 4; ++m) { const int row = row0 + ai * HALF + m * 16; const size_t off = (size_t)row * ldc + col0; float sq = 0.f;
#pragma unroll
                for (int bj = 0; bj < 2; ++bj) { const f32x4 v0 = b0[m][bj] + acc[ai][bj][m][0], v1 = b1[m][bj] + acc[ai][bj][m][1];
                    u32x4 w; w.x = cvt_pk_bf16(v0[0], v0[1]); w.y = cvt_pk_bf16(v0[2], v0[3]); w.z = cvt_pk_bf16(v1[0], v1[1]); w.w = cvt_pk_bf16(v1[2], v1[3]);
                    ST16_WT(xb + off + bj * HALF, w);
                    const float r0 = bflo(w.x), r1 = bfhi(w.x), r2 = bflo(w.y), r3 = bfhi(w.y), r4 = bflo(w.z), r5 = bfhi(w.z), r6 = bflo(w.w), r7 = bfhi(w.w);
                    sq += ((r0 * r0 + r1 * r1) + (r2 * r2 + r3 * r3)) + ((r4 * r4 + r5 * r5) + (r6 * r6 + r7 * r7)); }
                sq += __shfl_xor(sq, 16); sq += __shfl_xor(sq, 32);
                if (fq == 0) ss[(size_t)row * 16 + u.pn * 4 + wc] = sq; }
            asm volatile("" ::: "memory"); }
    }
};
struct EpiSwiGlu {
    static constexpr bool PERM = true, RS = true, CHAIN = false;
    bf16* Hd;
    __device__ __forceinline__ void operator()(const f32x4 (&acc)[2][2][4][2], const Unit& u, int wr, int wc, int fr, int fq, const LAS float* rst) const {
        const int row0 = u.pm * BM + wr * 64 + fr, col0 = u.pn * HALF + wc * 32 + 8 * fq;
#pragma unroll
        for (int ai = 0; ai < 2; ++ai)
#pragma unroll
            for (int m = 0; m < 4; ++m) { bf16* rowp = Hd + (size_t)(row0 + ai * HALF + m * 16) * DEXP + col0;
                f32x4 o0, o1; const float rs = rst[ai * HALF + wr * 64 + m * 16 + fr];
#pragma unroll
                for (int j = 0; j < 4; ++j) { const float a0 = acc[ai][0][m][0][j] * rs, a1 = acc[ai][0][m][1][j] * rs;
                    o0[j] = a0 * sigmoidf_(a0) * (acc[ai][1][m][0][j] * rs); o1[j] = a1 * sigmoidf_(a1) * (acc[ai][1][m][1][j] * rs); }
                u32x4 w; w.x = cvt_pk_bf16(o0[0], o0[1]); w.y = cvt_pk_bf16(o0[2], o0[3]); w.z = cvt_pk_bf16(o1[0], o1[1]); w.w = cvt_pk_bf16(o1[2], o1[3]);
                ST16_WT(rowp, w); }
    }
};
}

#define XB_TMO      128
#define XB_XCNT(j)  (256  + 64 * (j))
#define XB_XSUB(j)  (1280 + 64 * (j))
#define XB_XGEN(j)  (2304 + 64 * (j))
#define XB_TOP      3328
#define XB_TOPGEN   3392
#define XCD_BAR_WORDS 3456
#define XB_SPIN_CAP (1u << 20)
__device__ __forceinline__ unsigned xb_ld(unsigned* p)              { return __hip_atomic_load(p, __ATOMIC_RELAXED, __HIP_MEMORY_SCOPE_AGENT); }
__device__ __forceinline__ unsigned xb_add(unsigned* p, unsigned v) { return __hip_atomic_fetch_add(p, v, __ATOMIC_RELAXED, __HIP_MEMORY_SCOPE_AGENT); }
__device__ __forceinline__ unsigned xb_xcc_id() { return (unsigned)__builtin_amdgcn_s_getreg((3 << 11) | 20) & 0xFu; }
#define XB_SPIN(cond, bar) do { unsigned _sp = 0; while (cond) { __builtin_amdgcn_s_sleep(1); \
    if ((++_sp & 255u) == 0u) { if (xb_ld(&(bar)[XB_TMO])) break; if (_sp > XB_SPIN_CAP) { atomicAdd(&(bar)[XB_TMO], 1u); break; } } } } while (0)
struct XcdBarrier { unsigned* bar; unsigned x; volatile LAS unsigned* st; };
__device__ __forceinline__ XcdBarrier xcd_barrier_post(unsigned* bar, volatile LAS unsigned* st) {
    XcdBarrier b; b.bar = bar; b.x = xb_xcc_id(); b.st = st;
    if (threadIdx.x == 0) (void)xb_add(&bar[XB_XCNT(b.x)], 1u);
    return b;
}
__device__ __forceinline__ void xcd_barrier_complete(unsigned* bar, unsigned x, unsigned& nloc, unsigned& nx) {
    const unsigned G = gridDim.x * gridDim.y * gridDim.z;
    unsigned sum, cnt, mine, sp = 0u;
    for (;;) {
        sum = 0u; cnt = 0u; mine = 0u;
#pragma unroll
        for (unsigned j = 0; j < 16; ++j) { const unsigned c = xb_ld(&bar[XB_XCNT(j)]); sum += c; cnt += (c > 0u) ? 1u : 0u; mine = (j == x) ? c : mine; }
        if (sum == G) break;
        __builtin_amdgcn_s_sleep(1);
        if ((++sp & 255u) == 0u) { if (xb_ld(&bar[XB_TMO])) break; if (sp > XB_SPIN_CAP) { atomicAdd(&bar[XB_TMO], 1u); break; } }
    }
    nloc = mine > 0u ? mine : 1u; nx = cnt > 0u ? cnt : 1u;
}
__device__ __forceinline__ void xcd_barrier(const XcdBarrier& b) {
    asm volatile("s_waitcnt vmcnt(0)" ::: "memory");
    __syncthreads();
    if (threadIdx.x == 0) {
        unsigned* bar = b.bar;
        __builtin_amdgcn_s_waitcnt(0);
        unsigned nloc = b.st[0], nx = b.st[1];
        if (nloc == 0u) { xcd_barrier_complete(bar, b.x, nloc, nx); b.st[0] = nloc; b.st[1] = nx; }
        const unsigned old = xb_add(&bar[XB_XSUB(b.x)], 1u);
        const unsigned gen = old / nloc;
        if (old + 1u == (gen + 1u) * nloc) {
            __builtin_amdgcn_fence(__ATOMIC_RELEASE, "agent");
            asm volatile("s_waitcnt vmcnt(0)" ::: "memory");
            const unsigned og = xb_add(&bar[XB_TOP], 1u);
            const unsigned tg = og / nx;
            if (og + 1u == (tg + 1u) * nx) xb_add(&bar[XB_TOPGEN], 1u);
            else XB_SPIN(xb_ld(&bar[XB_TOPGEN]) == tg, bar);
            __builtin_amdgcn_fence(__ATOMIC_ACQUIRE, "agent");
            xb_add(&bar[XB_XGEN(b.x)], 1u);
            asm volatile("s_waitcnt vmcnt(0)" ::: "memory");
        } else {
            XB_SPIN(xb_ld(&bar[XB_XGEN(b.x)]) == gen, bar);
            __builtin_amdgcn_fence(__ATOMIC_ACQUIRE, "agent");
            asm volatile("s_waitcnt vmcnt(0)" ::: "memory");
        }
    }
    __syncthreads();
}

struct Args {
    const float* in[31]; float* out; unsigned char* ws; int ph_lo, ph_hi;
};
enum InIdx { I_X = 0, I_MEM, I_NORM_MIX, I_W_IN, I_CONV_W, I_CONV_B, I_LRU_WA, I_LRU_BA, I_LRU_WX, I_LRU_BX, I_LRU_LAMBDA, I_CA_REL, I_DIFF_LAMBDA, I_DIFF_SUBLN,
             I_W_BRANCH, I_W_OUT, I_NORM_MEM, I_MEM_NORM, I_W_MQ, I_W_MK, I_W_MV, I_W_MO, I_NORM_FFN, I_W_GROUP, I_B_GROUP, I_W_ROUTER, I_B_ROUTER, I_W1, I_W3, I_W2, I_FINAL_NORM };

struct TrIt { const float* W; bf16* WT; const float* gk; int K, N, row_off, item; float sc; };
__device__ __forceinline__ void tr_load(const TrIt& t, int lane, f32x4 (&v)[8]) {
    const int nblk = t.N / 32, kb = t.item / nblk, nb = t.item % nblk, k0 = 64 * kb, n0 = 32 * nb, c = lane & 7;
#pragma unroll
    for (int i = 0; i < 8; ++i) v[i] = __builtin_nontemporal_load((const f32x4*)(t.W + (size_t)(k0 + 8 * i + (lane >> 3)) * t.N + n0 + 4 * c));
}
__device__ __forceinline__ void tr_finish(const TrIt& t, const f32x4 (&v)[8], LAS float* scr, int lane) {
    const int nblk = t.N / 32, kb = t.item / nblk, nb = t.item % nblk, k0 = 64 * kb, n0 = 32 * nb, c = lane & 7;
    f32x4 g0 = (f32x4){t.sc, t.sc, t.sc, t.sc}, g1 = g0;
    if (t.gk) { g0 = *(const f32x4*)(t.gk + k0 + 8 * c) * t.sc; g1 = *(const f32x4*)(t.gk + k0 + 8 * c + 4) * t.sc; }
#pragma unroll
    for (int i = 0; i < 8; ++i) { LAS float* d = scr + (8 * i + (lane >> 3)) * 33 + 4 * c; d[0] = v[i].x; d[1] = v[i].y; d[2] = v[i].z; d[3] = v[i].w; }
    LDS_WAIT(); asm volatile("" ::: "memory");
#pragma unroll
    for (int j = 0; j < 4; ++j) { const int n = (lane >> 3) + 8 * j; const LAS float* s = scr + (8 * c) * 33 + n;
        u32x4 o; o.x = pk2(s[0 * 33] * g0[0], s[1 * 33] * g0[1]); o.y = pk2(s[2 * 33] * g0[2], s[3 * 33] * g0[3]); o.z = pk2(s[4 * 33] * g1[0], s[5 * 33] * g1[1]); o.w = pk2(s[6 * 33] * g1[2], s[7 * 33] * g1[3]);
        __builtin_nontemporal_store(o, (u32x4*)(t.WT + (size_t)(t.row_off + n0 + n) * t.K + k0 + 8 * c)); }
    LDS_WAIT(); asm volatile("" ::: "memory");
}
__device__ __forceinline__ void rms_row_to_bf16(const float* xrow, const float* g, bf16* orow, int lane) {
    const f32x4* xr = (const f32x4*)xrow + lane; const f32x4* gr = (const f32x4*)g + lane;
    f32x4 v[4]; float s = 0.f;
#pragma unroll
    for (int j = 0; j < 4; ++j) { v[j] = xr[64 * j]; s += (v[j].x * v[j].x + v[j].y * v[j].y) + (v[j].z * v[j].z + v[j].w * v[j].w); }
    const float rstd = 1.f / sqrtf(wave_sum(s) * (1.f / D) + NORM_EPS);
    unsigned long long* o8 = (unsigned long long*)orow + lane;
#pragma unroll
    for (int j = 0; j < 4; ++j) { const f32x4 gg = gr[64 * j];
        o8[64 * j] = (unsigned long long)pk2(v[j].x * rstd * gg.x, v[j].y * rstd * gg.y) | ((unsigned long long)pk2(v[j].z * rstd * gg.z, v[j].w * rstd * gg.w) << 32); }
}
__device__ __forceinline__ TrIt expert_item(const float* w1, const float* w3, const float* w2, const float* gk, bf16* W13, bf16* W2T, int it) {
    constexpr int I_13 = (D / 64) * (DEXP / 32);
    constexpr int I_2 = (DEXP / 64) * (D / 32);
    const int e = it / (2 * I_13 + I_2); int r = it % (2 * I_13 + I_2);
    if (r < 2 * I_13) { const int which = r / I_13; r %= I_13; const int nb = r % (DEXP / 32), n0 = nb * 32;
        const int row_off = (n0 / 128) * 256 + which * 128 + (n0 % 128) - n0;
        return TrIt{(which ? w3 : w1) + (size_t)e * D * DEXP, W13 + (size_t)e * 1024 * 1024, gk, D, DEXP, row_off, r, 1.0f}; }
    r -= 2 * I_13; return TrIt{w2 + (size_t)e * DEXP * D, W2T + (size_t)e * 1024 * 512, nullptr, DEXP, D, 0, r, 1.0f};
}
constexpr int CVT_ITEMS = NEXP * 768, CVT_PER_UNIT = 24, CVT_UNITS = CVT_ITEMS / CVT_PER_UNIT;

namespace att {
typedef short v4i16_t __attribute__((ext_vector_type(4)));
__device__ __forceinline__ s16x4 vtr(const LAS char* p) { return __builtin_bit_cast(s16x4, __builtin_amdgcn_ds_read_tr16_b64_v4i16((LAS v4i16_t*)p)); }
__device__ __forceinline__ int crow(int r, int hi) { return (r & 3) + 8 * (r >> 2) + 4 * hi; }
__device__ __forceinline__ float xmax(float v) { auto rr = __builtin_amdgcn_permlane32_swap(__float_as_uint(v), __float_as_uint(v), false, false); return fmaxf(__uint_as_float(rr[0]), __uint_as_float(rr[1])); }
__device__ __forceinline__ float xsum(float v) { auto rr = __builtin_amdgcn_permlane32_swap(__float_as_uint(v), __float_as_uint(v), false, false); return __uint_as_float(rr[0]) + __uint_as_float(rr[1]); }
__device__ __forceinline__ void unpair16(const u32x4 v, u32x2& a, u32x2& b) {
    const auto rx = __builtin_amdgcn_permlane32_swap(v.x, v.z, false, false); const auto ry = __builtin_amdgcn_permlane32_swap(v.y, v.w, false, false);
    a = (u32x2){rx[0], ry[0]}; b = (u32x2){rx[1], ry[1]}; }
__device__ __forceinline__ bf16x8 vfrag(const LAS char* p) { const s16x4 lo = vtr(p), hi = vtr(p + 512); return (bf16x8){lo[0], lo[1], lo[2], lo[3], hi[0], hi[1], hi[2], hi[3]}; }
__device__ __forceinline__ int vbase(int lane) { const int hi = lane >> 5; return ((lane >> 4) & 1) * 32 + (lane & 3) * 8 + (4 * hi + ((lane & 15) >> 2)) * 64; }
__device__ __forceinline__ bf16x8 pack8(const f32x16& p, int r0) {
    u32x4 w; w.x = cvt_pk_bf16(p[r0], p[r0 + 1]); w.y = cvt_pk_bf16(p[r0 + 2], p[r0 + 3]); w.z = cvt_pk_bf16(p[r0 + 4], p[r0 + 5]); w.w = cvt_pk_bf16(p[r0 + 6], p[r0 + 7]);
    return __builtin_bit_cast(bf16x8, w);
}

struct AttnP {
    const bf16* Q; const bf16* K; const bf16* V; bf16* O; int ldq, ldk, ldv, ldo;
    int q0;
    int t_begin, t_end;
    float slope2;
    int dmax;
    const LAS float* tab;
    float* lse;
};
template <int DQK, int DV, int MODE> struct Lay { static constexpr int KCH = DQK / 8 + (MODE == 2 ? 1 : 0), KB = KCH * 1024, VB = DV * 128, K0 = 0, V0 = 3 * KB, WSF = V0 + 3 * VB, END = WSF + 8 * 64 * 4; };

template <int DQK, int DV, int MODE>
__device__ __forceinline__ void attn_unit(LAS char* lds, const AttnP& P, const int tid) {
    typedef Lay<DQK, DV, MODE> L;
    constexpr int NKP = DQK / 64, NVP = DV / 64, NQ0 = DQK / 16, ND0 = NQ0 + (MODE == 2 ? 1 : 0), NDB = DV / 32;
    const int lane = tid & 63, r32 = lane & 31, hi = lane >> 5; const int wid = __builtin_amdgcn_readfirstlane(tid >> 6);
    const int qrow0 = P.q0 + 32 * wid;
    const int cq = qrow0 >> 6;
    int wlo = P.t_begin, whi = P.t_end - 1;
    if (MODE == 1) { wlo = cq - 8 < 0 ? 0 : cq - 8; whi = cq; }
    if (MODE == 2) { const int a = qrow0 - P.dmax; wlo = a > 0 ? (a >> 6) : 0; if (wlo < P.t_begin) wlo = P.t_begin; whi = cq; }
    LAS float* wsf = (LAS float*)(lds + L::WSF) + wid * 64;
    bf16x8 qr[ND0];
#pragma unroll
    for (int d0 = 0; d0 < NQ0; ++d0) qr[d0] = *(const bf16x8*)(P.Q + (size_t)(qrow0 + r32) * P.ldq + d0 * 16 + hi * 8);
    if (MODE == 2) { const u32x4 one = (u32x4){hi == 0 ? 0x3f803f80u : 0u, 0u, 0u, 0u}; qr[ND0 - 1] = __builtin_bit_cast(bf16x8, one);
        if (tid < 192) { const int b = tid >> 6, key = tid & 63; const float bv = P.slope2 * (float)key; const unsigned bh = f2bf(bv); const unsigned bl = f2bf(bv - bflo(bh));
            *(LAS u32x4*)(lds + L::K0 + b * L::KB + 8 * 1024 + key * 16) = (u32x4){bh | (bl << 16), 0u, 0u, 0u}; } }
    f32x16 o[NDB];
#pragma unroll
    for (int db = 0; db < NDB; ++db) o[db] = (f32x16){};
    float mrun = 0.f, lrun = 0.f; bool first = true;
    const int qpos = qrow0 + r32;
    constexpr int NP = NKP + NVP;
#define ATT_DMA(t, buf) do { _Pragma("unroll") for (int i_ = 0; i_ < NKP; ++i_) \
            __builtin_amdgcn_global_load_lds((const unsigned*)(P.K + (size_t)(64 * (t) + lane) * P.ldk + (wid + 8 * i_) * 8), (LAS unsigned*)(lds + L::K0 + (buf) * L::KB + (wid + 8 * i_) * 1024), 16, 0, 0); \
        _Pragma("unroll") for (int i_ = 0; i_ < NVP; ++i_) { const int p_ = wid + 8 * i_, db_ = p_ >> 2, rg_ = p_ & 3; \
            __builtin_amdgcn_global_load_lds((const unsigned*)(P.V + (size_t)(64 * (t) + 16 * rg_ + (lane >> 2)) * P.ldv + 32 * db_ + (lane & 3) * 8), (LAS unsigned*)(lds + L::V0 + (buf) * L::VB + p_ * 1024), 16, 0, 0); } } while (0)
    const int NT = P.t_end - P.t_begin;
    constexpr int TS = (MODE == 2) ? -1 : 1;
    const int tfirst = (MODE == 2) ? P.t_end - 1 : P.t_begin;
    ATT_DMA(tfirst, 0);
    if (NT > 1) ATT_DMA(tfirst + TS, 1);
    const int vb = vbase(lane);
    int buf = 0;
    for (int rel = 0; rel < NT; ++rel) {
        const int t = tfirst + TS * rel;
        if (rel + 1 < NT) { if (NP == 2) asm volatile("s_waitcnt vmcnt(2) lgkmcnt(0)\n\ts_barrier" ::: "memory"); else if (NP == 3) asm volatile("s_waitcnt vmcnt(3) lgkmcnt(0)\n\ts_barrier" ::: "memory"); else asm volatile("s_waitcnt vmcnt(4) lgkmcnt(0)\n\ts_barrier" ::: "memory"); }
        else asm volatile("s_waitcnt vmcnt(0) lgkmcnt(0)\n\ts_barrier" ::: "memory");
        if (rel + 2 < NT) { const int nb = buf == 0 ? 2 : buf - 1; ATT_DMA(t + 2 * TS, nb); }
        if (t >= wlo && t <= whi) {
            const LAS char* kp = lds + L::K0 + buf * L::KB + hi * 1024 + r32 * 16;
            const LAS char* vp = lds + L::V0 + buf * L::VB + vb;
            const int jrel = t - (cq - 8);
            float cin = -mrun;
            if (MODE == 1) { if (jrel <= 5) cin += P.tab[256]; }
            if (MODE == 2) cin += P.slope2 * (float)(64 * t - qpos);
            f32x16 p0, p1;
#pragma unroll
            for (int r = 0; r < 16; ++r) { p0[r] = cin; p1[r] = cin; }
#pragma unroll
            for (int d0 = 0; d0 < ND0; ++d0) {
                const LAS char* kq = (MODE == 2 && d0 == ND0 - 1) ? kp - hi * 1024 : kp;
                const bf16x8 b0 = *(const LAS bf16x8*)(kq + d0 * 2048), b1 = *(const LAS bf16x8*)(kq + d0 * 2048 + 512);
                p0 = __builtin_amdgcn_mfma_f32_32x32x16_bf16(b0, qr[d0], p0, 0, 0, 0);
                p1 = __builtin_amdgcn_mfma_f32_32x32x16_bf16(b1, qr[d0], p1, 0, 0, 0);
            }
            if (MODE == 1) { if (jrel > 5) {
                    const int dbase = qpos - 64 * t - 4 * hi;
#pragma unroll
                    for (int r = 0; r < 16; ++r) { const int d0_ = dbase - ((r & 3) + 8 * (r >> 2)), d1_ = d0_ - 32;
                        const int i0 = (d0_ < -128 ? -128 : (d0_ > 128 ? 128 : d0_)) + 128, i1 = (d1_ < -128 ? -128 : (d1_ > 128 ? 128 : d1_)) + 128;
                        p0[r] += P.tab[i0]; p1[r] += P.tab[i1]; } } }
            if (MODE == 2) { if (t == cq) {
                    const float xb = (float)(64 * t + 4 * hi - qpos), s2 = -2.0f * P.slope2;
#pragma unroll
                    for (int r = 0; r < 16; ++r) { const float x0 = xb + (float)((r & 3) + 8 * (r >> 2)), x1 = x0 + 32.f;
                        p0[r] = fmaf(s2, fmaxf(x0, 0.f), p0[r]); p1[r] = fmaf(s2, fmaxf(x1, 0.f), p1[r]); } } }
            float rm = fmaxf(p0[0], p1[0]);
#pragma unroll
            for (int r = 1; r < 16; ++r) rm = fmaxf(rm, fmaxf(p0[r], p1[r]));
            rm = xmax(rm);
            if (first || __any(rm > 8.f)) {
                const float dl = first ? rm : fmaxf(rm, 0.f), al = first ? 0.f : fexp2(-dl); mrun += dl; lrun *= al; first = false;
#pragma unroll
                for (int r = 0; r < 16; ++r) { p0[r] -= dl; p1[r] -= dl; }
#pragma unroll
                for (int r = 0; r < 16; ++r) {
#pragma unroll
                    for (int db = 0; db < NDB; ++db) o[db][r] *= al; }
            }
            float ls = 0.f;
#pragma unroll
            for (int r = 0; r < 16; ++r) { p0[r] = fexp2(p0[r]); p1[r] = fexp2(p1[r]); ls += p0[r] + p1[r]; }
            lrun += ls;
            const bf16x8 pw0 = pack8(p0, 0), pw1 = pack8(p0, 8), pw2 = pack8(p1, 0), pw3 = pack8(p1, 8);
            bf16x8 fa0, fa1, fa2, fa3, fb0, fb1, fb2, fb3;
#define ATT_VLD(f, db_) do { f##0 = vfrag(vp + (db_) * 4096 + 0 * 1024); f##1 = vfrag(vp + (db_) * 4096 + 1 * 1024); f##2 = vfrag(vp + (db_) * 4096 + 2 * 1024); f##3 = vfrag(vp + (db_) * 4096 + 3 * 1024); } while (0)
#define ATT_PV(f, db_) do { o[db_] = __builtin_amdgcn_mfma_f32_32x32x16_bf16(f##0, pw0, o[db_], 0, 0, 0); o[db_] = __builtin_amdgcn_mfma_f32_32x32x16_bf16(f##1, pw1, o[db_], 0, 0, 0); \
                o[db_] = __builtin_amdgcn_mfma_f32_32x32x16_bf16(f##2, pw2, o[db_], 0, 0, 0); o[db_] = __builtin_amdgcn_mfma_f32_32x32x16_bf16(f##3, pw3, o[db_], 0, 0, 0); } while (0)
            ATT_VLD(fa, 0); __builtin_amdgcn_sched_barrier(0);
            if (NDB > 1) { ATT_VLD(fb, 1); } ATT_PV(fa, 0); __builtin_amdgcn_sched_barrier(0);
            if (NDB > 2) { ATT_VLD(fa, 2); } if (NDB > 1) { ATT_PV(fb, 1); } __builtin_amdgcn_sched_barrier(0);
            if (NDB > 3) { ATT_VLD(fb, 3); } if (NDB > 2) { ATT_PV(fa, 2); } __builtin_amdgcn_sched_barrier(0);
            if (NDB > 3) { ATT_PV(fb, 3); }
#undef ATT_VLD
#undef ATT_PV
        }
        buf = buf == 2 ? 0 : buf + 1;
    }
    asm volatile("s_waitcnt lgkmcnt(0)\n\ts_barrier" ::: "memory");
#undef ATT_DMA
    const float lt = xsum(lrun); const float inv = lt > 0.f ? 1.0f / lt : 0.f;
    if (MODE == 2) { if (hi == 0) P.lse[(size_t)(qrow0 + r32) * 8] = lt > 0.f ? mrun + log2f(lt) : -1.0e30f; }
    bf16* orow = P.O + (size_t)(qrow0 + r32) * P.ldo + hi * 8;
#pragma unroll
    for (int db = 0; db < NDB; ++db)
#pragma unroll
        for (int gp = 0; gp < 2; ++gp) {
            unsigned ax = cvt_pk_bf16(o[db][8 * gp + 0] * inv, o[db][8 * gp + 1] * inv), ay = cvt_pk_bf16(o[db][8 * gp + 2] * inv, o[db][8 * gp + 3] * inv);
            unsigned bx = cvt_pk_bf16(o[db][8 * gp + 4] * inv, o[db][8 * gp + 5] * inv), by = cvt_pk_bf16(o[db][8 * gp + 6] * inv, o[db][8 * gp + 7] * inv);
            { const auto r_ = __builtin_amdgcn_permlane32_swap(ax, bx, false, false); ax = r_[0]; bx = r_[1]; }
            { const auto r_ = __builtin_amdgcn_permlane32_swap(ay, by, false, false); ay = r_[0]; by = r_[1]; }
            *(u32x4*)(orow + 32 * db + 16 * gp) = (u32x4){ax, ay, bx, by}; }
}
}

namespace ret {
using att::crow; using att::vfrag; using att::vbase; using att::pack8; using att::xsum;
__device__ __forceinline__ float gamma_log2(int h) { return log2f(1.0f - exp2f(-5.0f - (float)h)); }
template <bool SCALE>
__device__ __forceinline__ void stage_tile(LAS char* dst, const bf16* src, int ld, int lane, float lg2, float mul) {
#pragma unroll
    for (int p = 0; p < 8; ++p) { const int db = p >> 2, rg = p & 3, row = 16 * rg + (lane >> 2), col = 32 * db + (lane & 3) * 8;
        u32x4 v = *(const u32x4*)(src + (size_t)row * ld + col);
        if (SCALE) { const float s = fexp2(lg2 * (float)(63 - row)) * mul;
            v.x = cvt_pk_bf16(bflo(v.x) * s, bfhi(v.x) * s); v.y = cvt_pk_bf16(bflo(v.y) * s, bfhi(v.y) * s); v.z = cvt_pk_bf16(bflo(v.z) * s, bfhi(v.z) * s); v.w = cvt_pk_bf16(bflo(v.w) * s, bfhi(v.w) * s); }
        *(LAS u32x4*)(dst + p * 1024 + lane * 16) = v; }
}
__device__ __forceinline__ void kv_unit(LAS char* wl, const bf16* z, float* kvT, int c, int h, int lane) {
    const int hi = lane >> 5, r32 = lane & 31;
    const bf16* kp = z + (size_t)(c * CHUNK) * ZC + Z_CK + h * 64; const bf16* vp = z + (size_t)(c * CHUNK) * ZC + Z_CV + h * 64;
    stage_tile<true>(wl, kp, ZC, lane, gamma_log2(h), 0.125f);
    stage_tile<false>(wl + 8192, vp, ZC, lane, 0.f, 1.f);
    LDS_WAIT();
    const int vb = vbase(lane);
    f32x16 acc[2][2];
#pragma unroll
    for (int dt = 0; dt < 2; ++dt)
#pragma unroll
        for (int et = 0; et < 2; ++et) { acc[dt][et] = (f32x16){};
#pragma unroll
            for (int ks = 0; ks < 4; ++ks) acc[dt][et] = __builtin_amdgcn_mfma_f32_32x32x16_bf16(vfrag(wl + vb + dt * 4096 + ks * 1024), vfrag(wl + 8192 + vb + et * 4096 + ks * 1024), acc[dt][et], 0, 0, 0); }
    float* ob = kvT + ((size_t)(c * 8 + h) * 64) * 64;
#pragma unroll
    for (int dt = 0; dt < 2; ++dt)
#pragma unroll
        for (int et = 0; et < 2; ++et)
#pragma unroll
            for (int g4 = 0; g4 < 4; ++g4)
                *(f32x4*)(ob + (size_t)(32 * et + r32) * 64 + 32 * dt + 8 * g4 + 4 * hi) = (f32x4){acc[dt][et][4 * g4], acc[dt][et][4 * g4 + 1], acc[dt][et][4 * g4 + 2], acc[dt][et][4 * g4 + 3]};
    LDS_WAIT();
}
__device__ __forceinline__ void out_unit(LAS char* wl, const bf16* __restrict__ z, const bf16* __restrict__ rT, bf16* __restrict__ y, int c, int h, int lane) {
    const int hi = lane >> 5, r32 = lane & 31;
    const size_t row0 = (size_t)c * CHUNK;
    const bf16* qp = z + row0 * ZC + Z_CQ + h * 64; const bf16* kp = z + row0 * ZC + Z_CK + h * 64; const bf16* vp = z + row0 * ZC + Z_CV + h * 64; const bf16* gp_ = z + row0 * ZC + Z_CG + h * 64;
    const bf16* rp = rT + ((size_t)(c * 8 + h) * 64) * 64;
    bf16x8 kf[2][4], rf[2][4], qf[2][4];
#pragma unroll
    for (int nt = 0; nt < 2; ++nt)
#pragma unroll
        for (int s = 0; s < 4; ++s) qf[nt][s] = *(const bf16x8*)(qp + (size_t)(32 * nt + r32) * ZC + 16 * s + 8 * hi);
#pragma unroll
    for (int et = 0; et < 2; ++et)
#pragma unroll
        for (int s = 0; s < 4; ++s) rf[et][s] = *(const bf16x8*)(rp + (size_t)(32 * et + r32) * 64 + 16 * s + 8 * hi);
#pragma unroll
    for (int mt = 0; mt < 2; ++mt)
#pragma unroll
        for (int s = 0; s < 4; ++s) kf[mt][s] = *(const bf16x8*)(kp + (size_t)(32 * mt + r32) * ZC + 16 * s + 8 * hi);
    stage_tile<false>(wl, vp, ZC, lane, 0.f, 1.f);
    const float lg2 = gamma_log2(h);
    LDS_WAIT();
    const int vb = vbase(lane);
    bf16* yo = y + row0 * YC + 1024 + h * 64;
#pragma unroll
    for (int nt = 0; nt < 2; ++nt) {
        int i = 32 * nt + r32; asm volatile("" : "+v"(i));
        u32x4 gvr[2][2];
#pragma unroll
        for (int et = 0; et < 2; ++et)
#pragma unroll
            for (int gp = 0; gp < 2; ++gp) gvr[et][gp] = *(const u32x4*)(gp_ + (size_t)i * ZC + 32 * et + 16 * gp + 8 * hi);
        f32x16 oT[2], cr[2];
#pragma unroll
        for (int et = 0; et < 2; ++et) { oT[et] = (f32x16){}; cr[et] = (f32x16){};
#pragma unroll
            for (int s = 0; s < 4; ++s) cr[et] = __builtin_amdgcn_mfma_f32_32x32x16_bf16(rf[et][s], qf[nt][s], cr[et], 0, 0, 0); }
#pragma unroll
        for (int mt = 0; mt < 2; ++mt) {
            f32x16 st = (f32x16){};
#pragma unroll
            for (int s = 0; s < 4; ++s) st = __builtin_amdgcn_mfma_f32_32x32x16_bf16(kf[mt][s], qf[nt][s], st, 0, 0, 0);
            { int i2 = i; asm volatile("" : "+v"(i2));
#pragma unroll
            for (int r = 0; r < 16; ++r) { const int j = 32 * mt + crow(r, hi); const float w = (i2 >= j) ? fexp2(lg2 * (float)(i2 - j)) * 0.125f : 0.f; st[r] *= w; } }
            const bf16x8 pA = pack8(st, 0), pB = pack8(st, 8);
#pragma unroll
            for (int et = 0; et < 2; ++et) {
                oT[et] = __builtin_amdgcn_mfma_f32_32x32x16_bf16(vfrag(wl + vb + et * 4096 + (2 * mt) * 1024), pA, oT[et], 0, 0, 0);
                oT[et] = __builtin_amdgcn_mfma_f32_32x32x16_bf16(vfrag(wl + vb + et * 4096 + (2 * mt + 1) * 1024), pB, oT[et], 0, 0, 0); }
        }
        const float xi = fexp2(lg2 * (float)(i + 1));
        float s1 = 0.f;
#pragma unroll
        for (int et = 0; et < 2; ++et)
#pragma unroll
            for (int r = 0; r < 16; ++r) { oT[et][r] = fmaf(xi, cr[et][r], oT[et][r]); s1 += oT[et][r]; }
        const float mean = xsum(s1) * (1.f / 64.f);
        float s2 = 0.f;
#pragma unroll
        for (int et = 0; et < 2; ++et)
#pragma unroll
            for (int r = 0; r < 16; ++r) { oT[et][r] -= mean; s2 += oT[et][r] * oT[et][r]; }
        const float rstd = 1.0f / sqrtf(xsum(s2) * (1.f / 64.f) + GN_EPS);
#pragma unroll
        for (int et = 0; et < 2; ++et)
#pragma unroll
            for (int gp = 0; gp < 2; ++gp) {
                u32x2 wp[2], gq_[2]; att::unpair16(gvr[et][gp], gq_[0], gq_[1]);
#pragma unroll
                for (int q = 0; q < 2; ++q) { const int g4 = 2 * gp + q; const u32x2 gw = gq_[q];
                    const float g0 = bflo(gw.x), g1 = bfhi(gw.x), g2 = bflo(gw.y), g3 = bfhi(gw.y);
                    wp[q].x = cvt_pk_bf16(g0 * sigmoidf_(g0) * oT[et][4 * g4] * rstd, g1 * sigmoidf_(g1) * oT[et][4 * g4 + 1] * rstd);
                    wp[q].y = cvt_pk_bf16(g2 * sigmoidf_(g2) * oT[et][4 * g4 + 2] * rstd, g3 * sigmoidf_(g3) * oT[et][4 * g4 + 3] * rstd); }
                { const auto r_ = __builtin_amdgcn_permlane32_swap(wp[0].x, wp[1].x, false, false); wp[0].x = r_[0]; wp[1].x = r_[1]; }
                { const auto r_ = __builtin_amdgcn_permlane32_swap(wp[0].y, wp[1].y, false, false); wp[0].y = r_[0]; wp[1].y = r_[1]; }
                *(u32x4*)(yo + (size_t)i * YC + 32 * et + 16 * gp + 8 * hi) = (u32x4){wp[0].x, wp[0].y, wp[1].x, wp[1].y}; }
    }
    LDS_WAIT();
}
}

namespace lru {
struct LruP { const bf16* z; const float *conv_w, *conv_b; const bf16* wfrag; const float *ba, *bx, *lam; float *carA, *carH; const float* carI; bf16* y; unsigned* au; };
constexpr int XS = 144;
template <bool FINAL>
__device__ __forceinline__ void unit(LAS char* wl, const LruP& P, int seg, int k, int lane) {
    const int r32 = lane & 31, hi = lane >> 5;
    LAS float* tb = (LAS float*)(wl + 10240);
    { const int ch = k * 64 + lane;
      tb[0 * 64 + lane] = P.conv_w[ch]; tb[1 * 64 + lane] = P.conv_w[512 + ch]; tb[2 * 64 + lane] = P.conv_w[1024 + ch]; tb[3 * 64 + lane] = P.conv_w[1536 + ch];
      tb[4 * 64 + lane] = P.conv_b[ch]; tb[5 * 64 + lane] = P.ba[ch]; tb[6 * 64 + lane] = P.bx[ch]; tb[7 * 64 + lane] = 8.0f * log1pf(expf(-P.lam[ch])); }
    { u32x4 xv[9];
#pragma unroll
      for (int i = 0; i < 9; ++i) { const int rr = i * 8 + (lane >> 3); const int t = seg * 64 - 3 + rr; xv[i] = (u32x4){0u, 0u, 0u, 0u};
          if (rr < 67 && t >= 0) xv[i] = *(const u32x4*)(P.z + (size_t)t * ZC + Z_AX + k * 64 + (lane & 7) * 8); }
#pragma unroll
      for (int i = 0; i < 9; ++i) { const int rr = i * 8 + (lane >> 3); if (rr < 67) *(LAS u32x4*)(wl + rr * XS + (lane & 7) * 16) = xv[i]; } }
    LDS_WAIT();
#pragma unroll 1
    for (int mt = 0; mt < 2; ++mt) {
        bf16x8 WA[4], WX[4];
#pragma unroll
        for (int s = 0; s < 4; ++s) { const bf16* fp = P.wfrag + ((size_t)(((k * 2 + mt) * 4 + s) * 2) * 64 + lane) * 8; WA[s] = *(const bf16x8*)fp; WX[s] = *(const bf16x8*)(fp + 512); }
        f32x16 hin, apr;
#pragma unroll
        for (int g4 = 0; g4 < 4; ++g4) { f32x4 c4 = (f32x4){0.f, 0.f, 0.f, 0.f};
            if (FINAL) c4 = *(const f32x4*)(P.carI + (size_t)seg * 512 + k * 64 + 32 * mt + 8 * g4 + 4 * hi);
#pragma unroll
            for (int j = 0; j < 4; ++j) { hin[4 * g4 + j] = c4[j]; apr[4 * g4 + j] = 1.f; } }
#pragma unroll 1
        for (int half = 0; half < 2; ++half) {
            const int t0 = seg * 64 + half * 32;
            f32x16 aA = (f32x16){}, aX = (f32x16){}, aI = (f32x16){};
#pragma unroll
            for (int s = 0; s < 4; ++s) {
                const int c0 = 16 * s + 8 * hi; float xc[8];
                { const f32x4 b0 = *(const LAS f32x4*)(tb + 4 * 64 + c0), b1 = *(const LAS f32x4*)(tb + 4 * 64 + c0 + 4);
                  xc[0] = b0[0]; xc[1] = b0[1]; xc[2] = b0[2]; xc[3] = b0[3]; xc[4] = b1[0]; xc[5] = b1[1]; xc[6] = b1[2]; xc[7] = b1[3]; }
#pragma unroll
                for (int jr = 0; jr < 4; ++jr) { const u32x4 xv = *(const LAS u32x4*)(wl + (half * 32 + r32 + jr) * XS + (2 * s + hi) * 16);
                    const f32x4 w0 = *(const LAS f32x4*)(tb + jr * 64 + c0), w1 = *(const LAS f32x4*)(tb + jr * 64 + c0 + 4);
                    xc[0] = fmaf(w0[0], bflo(xv.x), xc[0]); xc[1] = fmaf(w0[1], bfhi(xv.x), xc[1]); xc[2] = fmaf(w0[2], bflo(xv.y), xc[2]); xc[3] = fmaf(w0[3], bfhi(xv.y), xc[3]);
                    xc[4] = fmaf(w1[0], bflo(xv.z), xc[4]); xc[5] = fmaf(w1[1], bfhi(xv.z), xc[5]); xc[6] = fmaf(w1[2], bflo(xv.w), xc[6]); xc[7] = fmaf(w1[3], bfhi(xv.w), xc[7]); }
                u32x4 pw; pw.x = pk2(xc[0], xc[1]); pw.y = pk2(xc[2], xc[3]); pw.z = pk2(xc[4], xc[5]); pw.w = pk2(xc[6], xc[7]);
                const bf16x8 xb = __builtin_bit_cast(bf16x8, pw);
                aA = __builtin_amdgcn_mfma_f32_32x32x16_bf16(WA[s], xb, aA, 0, 0, 0);
                aX = __builtin_amdgcn_mfma_f32_32x32x16_bf16(WX[s], xb, aX, 0, 0, 0);
                u32x4 idw;
                { const int d = 32 * mt + r32 - 16 * s - 8 * hi;
                  idw.x = (d == 0 ? 0x3f80u : 0u) | (d == 1 ? 0x3f800000u : 0u); idw.y = (d == 2 ? 0x3f80u : 0u) | (d == 3 ? 0x3f800000u : 0u);
                  idw.z = (d == 4 ? 0x3f80u : 0u) | (d == 5 ? 0x3f800000u : 0u); idw.w = (d == 6 ? 0x3f80u : 0u) | (d == 7 ? 0x3f800000u : 0u); }
                aI = __builtin_amdgcn_mfma_f32_32x32x16_bf16(__builtin_bit_cast(bf16x8, idw), xb, aI, 0, 0, 0);
            }
#pragma unroll
            for (int g4 = 0; g4 < 4; ++g4) { const int cb_ = 32 * mt + 8 * g4 + 4 * hi;
                const f32x4 vba = *(const LAS f32x4*)(tb + 5 * 64 + cb_), vbx = *(const LAS f32x4*)(tb + 6 * 64 + cb_), vsp = *(const LAS f32x4*)(tb + 7 * 64 + cb_);
#pragma unroll
                for (int j = 0; j < 4; ++j) { const int r = 4 * g4 + j;
                    const float rg = sigmoidf_(aA[r] + vba[j]), ig = sigmoidf_(aX[r] + vbx[j]);
                    const float la = -rg * vsp[j];
                    aA[r] = fexp2(la * LOG2E);
                    const float a_ = aA[r]; aX[r] = __builtin_amdgcn_sqrtf(fmaxf(fmaf(-a_, a_, 1.0f), 0.f)) * (ig * aI[r]); } }
#pragma unroll
            for (int r = 0; r < 16; ++r) { float a = aA[r], u = aX[r];
#pragma unroll
                for (int d = 1; d < 32; d <<= 1) { const float a2 = __shfl_up(a, d, 32), u2 = __shfl_up(u, d, 32); if (r32 >= d) { u = fmaf(a, u2, u); a *= a2; } }
                aA[r] = a; aX[r] = u; }
            if (FINAL) {
#pragma unroll
                for (int r = 0; r < 16; ++r) { const float h = fmaf(aA[r], hin[r], aX[r]); aX[r] = h; hin[r] = __shfl(h, 31, 32); }
#pragma unroll
                for (int g4 = 0; g4 < 4; ++g4) { const int cb_ = k * 64 + 32 * mt + 8 * g4 + 4 * hi;
                    const u32x2 gw = *(const u32x2*)(P.z + (size_t)(t0 + r32) * ZC + Z_AG + cb_);
                    float gv[4] = {bflo(gw.x), bfhi(gw.x), bflo(gw.y), bfhi(gw.y)}, o4[4];
#pragma unroll
                    for (int j = 0; j < 4; ++j) { const float g = gv[j]; o4[j] = aX[4 * g4 + j] * g * frcp(1.0f + fexp2(-1.5957691216f * LOG2E * (g + 0.044715f * g * g * g))); }
                    u32x2 w; w.x = pk2(o4[0], o4[1]); w.y = pk2(o4[2], o4[3]);
                    *(u32x2*)(P.y + (size_t)(t0 + r32) * YC + cb_) = w; }
            } else {
                u32x4* aup = (u32x4*)(P.au + ((size_t)((((seg * 8 + k) * 2 + mt) * 2 + half) * 64 + lane)) * 16);
#pragma unroll
                for (int g4 = 0; g4 < 4; ++g4) aup[g4] = (u32x4){pk2(aA[4 * g4], aX[4 * g4]), pk2(aA[4 * g4 + 1], aX[4 * g4 + 1]), pk2(aA[4 * g4 + 2], aX[4 * g4 + 2]), pk2(aA[4 * g4 + 3], aX[4 * g4 + 3])};
#pragma unroll
                for (int r = 0; r < 16; ++r) { const float a31 = __shfl(aA[r], 31, 32), u31 = __shfl(aX[r], 31, 32); hin[r] = fmaf(a31, hin[r], u31); apr[r] *= a31; }
            }
            LDS_WAIT();
        }
        if (!FINAL) { if (r32 == 0) {
#pragma unroll
            for (int g4 = 0; g4 < 4; ++g4) { const size_t o = (size_t)seg * 512 + k * 64 + 32 * mt + 8 * g4 + 4 * hi;
                *(f32x4*)(P.carA + o) = (f32x4){apr[4 * g4], apr[4 * g4 + 1], apr[4 * g4 + 2], apr[4 * g4 + 3]};
                *(f32x4*)(P.carH + o) = (f32x4){hin[4 * g4], hin[4 * g4 + 1], hin[4 * g4 + 2], hin[4 * g4 + 3]}; } } }
    }
}
__device__ __forceinline__ void unit1(LAS char* wl, const LruP& P, int seg, int k, int lane) {
    const int r32 = lane & 31, hi = lane >> 5;
    LAS float* tb = (LAS float*)(wl + 9728);
    LAS unsigned* tt = (LAS unsigned*)(wl + 11776);
    { const int ch = k * 64 + lane;
      tb[0 * 64 + lane] = P.conv_w[ch]; tb[1 * 64 + lane] = P.conv_w[512 + ch]; tb[2 * 64 + lane] = P.conv_w[1024 + ch]; tb[3 * 64 + lane] = P.conv_w[1536 + ch];
      tb[4 * 64 + lane] = P.conv_b[ch]; tb[5 * 64 + lane] = P.ba[ch]; tb[6 * 64 + lane] = P.bx[ch]; tb[7 * 64 + lane] = 8.0f * log1pf(expf(-P.lam[ch])); }
    { u32x4 xv[9];
#pragma unroll
      for (int i = 0; i < 9; ++i) { const int rr = i * 8 + (lane >> 3); const int t = seg * 64 - 3 + rr; xv[i] = (u32x4){0u, 0u, 0u, 0u};
          if (rr < 67 && t >= 0) xv[i] = *(const u32x4*)(P.z + (size_t)t * ZC + Z_AX + k * 64 + (lane & 7) * 8); }
#pragma unroll
      for (int i = 0; i < 9; ++i) { const int rr = i * 8 + (lane >> 3); if (rr < 67) *(LAS u32x4*)(wl + rr * XS + (lane & 7) * 16) = xv[i]; } }
    LDS_WAIT();
#pragma unroll 1
    for (int mt = 0; mt < 2; ++mt) {
        bf16x8 WA[4], WX[4];
#pragma unroll
        for (int s = 0; s < 4; ++s) { const bf16* fp = P.wfrag + ((size_t)(((k * 2 + mt) * 4 + s) * 2) * 64 + lane) * 8; WA[s] = *(const bf16x8*)fp; WX[s] = *(const bf16x8*)(fp + 512); }
        const float vba = tb[5 * 64 + 32 * mt + r32], vbx = tb[6 * 64 + 32 * mt + r32], vsp = tb[7 * 64 + 32 * mt + r32];
        float hin = 0.f, apr = 1.f;
#pragma unroll 1
        for (int half = 0; half < 2; ++half) {
            f32x16 aA = (f32x16){}, aX = (f32x16){}, aI = (f32x16){};
#pragma unroll
            for (int s = 0; s < 4; ++s) {
                const int c0 = 16 * s + 8 * hi; float xc[8];
                { const f32x4 b0 = *(const LAS f32x4*)(tb + 4 * 64 + c0), b1 = *(const LAS f32x4*)(tb + 4 * 64 + c0 + 4);
                  xc[0] = b0[0]; xc[1] = b0[1]; xc[2] = b0[2]; xc[3] = b0[3]; xc[4] = b1[0]; xc[5] = b1[1]; xc[6] = b1[2]; xc[7] = b1[3]; }
#pragma unroll
                for (int jr = 0; jr < 4; ++jr) { const u32x4 xv = *(const LAS u32x4*)(wl + (half * 32 + r32 + jr) * XS + (2 * s + hi) * 16);
                    const f32x4 w0 = *(const LAS f32x4*)(tb + jr * 64 + c0), w1 = *(const LAS f32x4*)(tb + jr * 64 + c0 + 4);
                    xc[0] = fmaf(w0[0], bflo(xv.x), xc[0]); xc[1] = fmaf(w0[1], bfhi(xv.x), xc[1]); xc[2] = fmaf(w0[2], bflo(xv.y), xc[2]); xc[3] = fmaf(w0[3], bfhi(xv.y), xc[3]);
                    xc[4] = fmaf(w1[0], bflo(xv.z), xc[4]); xc[5] = fmaf(w1[1], bfhi(xv.z), xc[5]); xc[6] = fmaf(w1[2], bflo(xv.w), xc[6]); xc[7] = fmaf(w1[3], bfhi(xv.w), xc[7]); }
                u32x4 pw; pw.x = pk2(xc[0], xc[1]); pw.y = pk2(xc[2], xc[3]); pw.z = pk2(xc[4], xc[5]); pw.w = pk2(xc[6], xc[7]);
                const bf16x8 xb = __builtin_bit_cast(bf16x8, pw);
                aA = __builtin_amdgcn_mfma_f32_32x32x16_bf16(xb, WA[s], aA, 0, 0, 0);
                aX = __builtin_amdgcn_mfma_f32_32x32x16_bf16(xb, WX[s], aX, 0, 0, 0);
                u32x4 idw;
                { const int d = 32 * mt + r32 - 16 * s - 8 * hi;
                  idw.x = (d == 0 ? 0x3f80u : 0u) | (d == 1 ? 0x3f800000u : 0u); idw.y = (d == 2 ? 0x3f80u : 0u) | (d == 3 ? 0x3f800000u : 0u);
                  idw.z = (d == 4 ? 0x3f80u : 0u) | (d == 5 ? 0x3f800000u : 0u); idw.w = (d == 6 ? 0x3f80u : 0u) | (d == 7 ? 0x3f800000u : 0u); }
                aI = __builtin_amdgcn_mfma_f32_32x32x16_bf16(xb, __builtin_bit_cast(bf16x8, idw), aI, 0, 0, 0);
            }
#pragma unroll
            for (int r = 0; r < 16; ++r) {
                const float rg = sigmoidf_(aA[r] + vba), ig = sigmoidf_(aX[r] + vbx);
                const float la = -rg * vsp;
                aA[r] = fexp2(la * LOG2E);
                const float a_ = aA[r]; aX[r] = __builtin_amdgcn_sqrtf(fmaxf(fmaf(-a_, a_, 1.0f), 0.f)) * (ig * aI[r]); }
#pragma unroll
            for (int g = 0; g < 4; ++g)
#pragma unroll
                for (int j = 1; j < 4; ++j) { aX[4 * g + j] = fmaf(aA[4 * g + j], aX[4 * g + j - 1], aX[4 * g + j]); aA[4 * g + j] *= aA[4 * g + j - 1]; }
            float cA[4], cU[4], ca = 1.f, cu = 0.f;
#pragma unroll
            for (int g = 0; g < 4; ++g) {
                const auto ta = __builtin_amdgcn_permlane32_swap(__float_as_uint(aA[4 * g + 3]), __float_as_uint(aA[4 * g + 3]), false, false);
                const auto tu = __builtin_amdgcn_permlane32_swap(__float_as_uint(aX[4 * g + 3]), __float_as_uint(aX[4 * g + 3]), false, false);
                const float a_lo = __uint_as_float(ta[0]), a_hi = __uint_as_float(ta[1]), u_lo = __uint_as_float(tu[0]), u_hi = __uint_as_float(tu[1]);
                const float ca1 = a_lo * ca, cu1 = fmaf(a_lo, cu, u_lo);
                cA[g] = hi ? ca1 : ca; cU[g] = hi ? cu1 : cu;
                ca = a_hi * ca1; cu = fmaf(a_hi, cu1, u_hi); }
#pragma unroll
            for (int r = 0; r < 16; ++r) { aX[r] = fmaf(aA[r], cU[r >> 2], aX[r]); aA[r] *= cA[r >> 2]; }
            hin = fmaf(ca, hin, cu); apr *= ca;
#pragma unroll
            for (int r = 0; r < 16; ++r) tt[att::crow(r, hi) * 36 + r32] = pk2(aA[r], aX[r]);
            LDS_WAIT();
            u32x4* aup = (u32x4*)(P.au + ((size_t)((((seg * 8 + k) * 2 + mt) * 2 + half) * 64 + lane)) * 16);
#pragma unroll
            for (int g4 = 0; g4 < 4; ++g4) aup[g4] = *(const LAS u32x4*)(tt + r32 * 36 + 8 * g4 + 4 * hi);
            LDS_WAIT();
        }
        if (hi == 0) { const size_t o = (size_t)seg * 512 + k * 64 + 32 * mt + r32; P.carA[o] = apr; P.carH[o] = hin; }
    }
}
__device__ __forceinline__ void fin_unit(const LruP& P, int seg, int k, int lane) {
    const int r32 = lane & 31, hi = lane >> 5;
    u32x4 w[2][2][4], gwr[2][2][2]; f32x4 c4[2][4];
#pragma unroll
    for (int mt = 0; mt < 2; ++mt)
#pragma unroll
        for (int half = 0; half < 2; ++half) { const u32x4* aup = (const u32x4*)(P.au + ((size_t)((((seg * 8 + k) * 2 + mt) * 2 + half) * 64 + lane)) * 16);
#pragma unroll
            for (int g4 = 0; g4 < 4; ++g4) w[mt][half][g4] = aup[g4];
#pragma unroll
            for (int gp = 0; gp < 2; ++gp) gwr[mt][half][gp] = *(const u32x4*)(P.z + (size_t)(seg * 64 + half * 32 + r32) * ZC + Z_AG + k * 64 + 32 * mt + 16 * gp + 8 * hi); }
#pragma unroll
    for (int mt = 0; mt < 2; ++mt)
#pragma unroll
        for (int g4 = 0; g4 < 4; ++g4) c4[mt][g4] = *(const f32x4*)(P.carI + (size_t)seg * 512 + k * 64 + 32 * mt + 8 * g4 + 4 * hi);
#pragma unroll
    for (int mt = 0; mt < 2; ++mt) {
        float hin[16];
#pragma unroll
        for (int g4 = 0; g4 < 4; ++g4)
#pragma unroll
            for (int j = 0; j < 4; ++j) hin[4 * g4 + j] = c4[mt][g4][j];
#pragma unroll
        for (int half = 0; half < 2; ++half) {
            const int t0 = seg * 64 + half * 32;
#pragma unroll
            for (int gp = 0; gp < 2; ++gp) {
                u32x2 wp[2], gq_[2]; att::unpair16(gwr[mt][half][gp], gq_[0], gq_[1]);
#pragma unroll
                for (int q = 0; q < 2; ++q) { const int g4 = 2 * gp + q; const u32x4 wv = w[mt][half][g4];
                    const unsigned wr_[4] = {wv.x, wv.y, wv.z, wv.w};
                    float gv[4] = {bflo(gq_[q].x), bfhi(gq_[q].x), bflo(gq_[q].y), bfhi(gq_[q].y)}, o4[4];
#pragma unroll
                    for (int j = 0; j < 4; ++j) { const int r = 4 * g4 + j; const float h = fmaf(bflo(wr_[j]), hin[r], bfhi(wr_[j])); hin[r] = __shfl(h, 31, 32);
                        const float g = gv[j]; o4[j] = h * g * frcp(1.0f + fexp2(-1.5957691216f * LOG2E * (g + 0.044715f * g * g * g))); }
                    wp[q].x = pk2(o4[0], o4[1]); wp[q].y = pk2(o4[2], o4[3]); }
                { const auto r_ = __builtin_amdgcn_permlane32_swap(wp[0].x, wp[1].x, false, false); wp[0].x = r_[0]; wp[1].x = r_[1]; }
                { const auto r_ = __builtin_amdgcn_permlane32_swap(wp[0].y, wp[1].y, false, false); wp[0].y = r_[0]; wp[1].y = r_[1]; }
                *(u32x4*)(P.y + (size_t)(t0 + r32) * YC + k * 64 + 32 * mt + 16 * gp + 8 * hi) = (u32x4){wp[0].x, wp[0].y, wp[1].x, wp[1].y}; }
        }
    }
}
}

constexpr int NPH_LAYER = 14, NPHASE = 1 + DEPTH * NPH_LAYER;

__global__ void __launch_bounds__(NTHREADS, 2) fwd_kernel(Args args) {
    extern __shared__ __attribute__((aligned(16))) unsigned char lds_raw[];
    LAS unsigned char* lds = (LAS unsigned char*)lds_raw;
    const int G = gridDim.x; const int bx = blockIdx.x;
    const int vcu = (G % 8 == 0) ? (bx % 8) * (G / 8) + bx / 8 : bx;
    const int NGW = G * NWAVES;
    typedef const __attribute__((address_space(4))) Args* KArgs;
#define PH_PTRS KArgs KA = (KArgs)__builtin_amdgcn_kernarg_segment_ptr(); asm volatile("" : "+s"(KA)); unsigned char* const ws = KA->ws; (void)ws; \
    int tid = threadIdx.x; asm volatile("" : "+v"(tid)); const int lane = tid & 63; const int wid = __builtin_amdgcn_readfirstlane(tid >> 6); const int gw = vcu * NWAVES + wid; (void)lane; (void)gw
#define ctl ((unsigned*)(ws + WS_CTL))
#define memn ((bf16*)(ws + WS_MEMN))
#define kvmem ((bf16*)(ws + WS_KMEM))
#define wtr ((bf16*)(ws + WS_WTR))
#define lruw ((bf16*)(ws + WS_LRUW))
#define carA ((float*)(ws + WS_CARA))
#define carH ((float*)(ws + WS_CARH))
#define carI ((float*)(ws + WS_CARI))
#define qknrm ((float*)(ws + WS_QKN))
#define lseb ((float*)(ws + WS_LSE))
#define tokE ((int*)(ws + WS_TOKE))
#define tokP ((int*)(ws + WS_TOKP))
#define tokW ((float*)(ws + WS_TOKW))
#define elist ((int*)(ws + WS_ELIST))
#define wt_in ((bf16*)(ws + WS_WIN))
#define wt_br ((bf16*)(ws + WS_WBR))
#define wt_out ((bf16*)(ws + WS_WOUT))
#define wt_mq ((bf16*)(ws + WS_WMQ))
#define wt_mk ((bf16*)(ws + WS_WMK))
#define wt_mv ((bf16*)(ws + WS_WMV))
#define wt_mo ((bf16*)(ws + WS_WMO))
#define w13 ((bf16*)(ws + WS_W13))
#define w2t ((bf16*)(ws + WS_W2))
#define hb ((bf16*)(ws + WS_H))
#define yb ((bf16*)(ws + WS_Y))
#define kvT ((float*)(ws + WS_KVT))
#define rT ((bf16*)(ws + WS_RT))
#define odb ((bf16*)(ws + WS_OD))
#define zb ((bf16*)(ws + WS_Z))
#define gtb ((bf16*)(ws + WS_G))
#define mrg ((bf16*)(ws + WS_MRG))
#define qb ((bf16*)(ws + WS_QB))
#define obf ((bf16*)(ws + WS_OB))
#define hid ((bf16*)(ws + WS_HID))
#define ymoe ((bf16*)(ws + WS_YMOE))
#define ssb ((float*)(ws + WS_SS))
#define xs1 ((bf16*)(ws + WS_XS1))
#define xs2 ((bf16*)(ws + WS_XS2))
#define xin (KA->in[I_X])
#define xout (KA->out)
    volatile LAS unsigned* MISC = (volatile LAS unsigned*)(lds + LDS_MISC);
    if (threadIdx.x < 64) MISC[threadIdx.x] = 0u;
    __syncthreads();
    const int lo = args.ph_lo, hi_ph = args.ph_hi;
    XcdBarrier bar; bar.x = 0; bar.st = nullptr; bar.bar = nullptr;
    { PH_PTRS; bar.bar = ctl + CW_BAR; if (hi_ph - lo > 1) bar = xcd_barrier_post(ctl + CW_BAR, MISC + 8); }
#ifndef PH_EN
#define PH_EN 0xFFFFFFFFu
#endif
#define EN(p) (((PH_EN) >> (p)) & 1u)
#define IN(k) (lo <= (k) && (k) < hi_ph)
#ifdef PROBE_MASK
    unsigned long long pr_acc = 0ull, pr_t0 = 0ull;
#define PR_BEGIN(p) do { if (((PROBE_MASK) >> (p)) & 1ull) pr_t0 = __builtin_amdgcn_s_memrealtime(); } while (0)
#define PR_END(p) do { if (((PROBE_MASK) >> (p)) & 1ull) pr_acc += __builtin_amdgcn_s_memrealtime() - pr_t0; } while (0)
#else
#define PR_BEGIN(p) do { } while (0)
#define PR_END(p) do { } while (0)
#endif
#define SEAM(k) do { if (IN(k) && IN((k) + 1)) xcd_barrier(bar); } while (0)

    PR_BEGIN(16);
    if (EN(19) && IN(0)) { PH_PTRS;
        LAS float* scr = (LAS float*)(lds + wid * 16384);
#define WT_CONSTS constexpr int I_IN = (D / 64) * (INC / 32), I_BR = (512 / 64) * (D / 32), I_OUT = (D / 64) * (D / 32), I_MQ = (D / 64) * (512 / 32), I_MO = (512 / 64) * (D / 32); \
          constexpr int NIT = I_IN + 4 * I_BR + I_OUT + 3 * I_MQ + I_MO, KV0 = I_IN + 4 * I_BR + I_OUT + I_MQ; (void)KV0
#define WT_DECODE auto decode = [&](int it) -> TrIt { const int l = it / NIT; int r = it % NIT; \
              if (r < I_IN) { const int n0_ = (r % (INC / 32)) * 32; const float sc_ = ((n0_ >= Z_BQ && n0_ < Z_BK) || (n0_ >= Z_DQ && n0_ < Z_DK)) ? 0.125f * LOG2E : 1.0f;     \
                  return TrIt{KA->in[I_W_IN] + (size_t)l * D * INC, wt_in + (size_t)l * INC * D, KA->in[I_NORM_MIX] + l * D, D, INC, 0, r, sc_}; } r -= I_IN; \
              if (r < 4 * I_BR) { const int b = r / I_BR; return TrIt{KA->in[I_W_BRANCH] + (size_t)(l * 4 + b) * 512 * D, wt_br + (size_t)(l * 4 + b) * D * 512, nullptr, 512, D, 0, r % I_BR, 1.0f}; } r -= 4 * I_BR; \
              if (r < I_OUT) return TrIt{KA->in[I_W_OUT] + (size_t)l * D * D, wt_out + (size_t)l * D * D, nullptr, D, D, 0, r, 1.0f}; r -= I_OUT; \
              if (r < I_MQ) return TrIt{KA->in[I_W_MQ] + (size_t)l * D * 512, wt_mq + (size_t)l * 512 * D, KA->in[I_NORM_MEM] + l * D, D, 512, 0, r, 0.08838834764831845f * LOG2E}; r -= I_MQ; \
              if (r < I_MQ) return TrIt{KA->in[I_W_MK] + (size_t)l * D * 512, wt_mk + (size_t)l * 512 * D, nullptr, D, 512, 0, r, 1.0f}; r -= I_MQ; \
              if (r < I_MQ) return TrIt{KA->in[I_W_MV] + (size_t)l * D * 512, wt_mv + (size_t)l * 512 * D, nullptr, D, 512, 0, r, 1.0f}; r -= I_MQ; \
              return TrIt{KA->in[I_W_MO] + (size_t)l * 512 * D, wt_mo + (size_t)l * D * 512, nullptr, 512, D, 0, r, 1.0f}; }
        { WT_CONSTS; WT_DECODE;
          constexpr int NPRO = NIT + (DEPTH - 1) * 2 * I_MQ;
          auto pro = [&](int j) -> int { return j < NIT ? j : NIT * (1 + (j - NIT) / (2 * I_MQ)) + KV0 + (j - NIT) % (2 * I_MQ); };
          TrIt cur = decode(pro(gw < NPRO ? gw : 0)); f32x4 v[8]; tr_load(cur, lane, v);
          for (int j = gw; j < NPRO; j += NGW) { const bool hn = j + NGW < NPRO; const TrIt nx = decode(pro(hn ? j + NGW : j)); f32x4 vn[8]; tr_load(nx, lane, vn);
              tr_finish(cur, v, scr, lane); cur = nx;
#pragma unroll
              for (int i = 0; i < 8; ++i) v[i] = vn[i]; } }
        for (int i = gw * 64 + lane; i < DEPTH * 8 * 2 * 4 * 2 * 64; i += NGW * 64) { const int ln = i & 63, mat = (i >> 6) & 1, s_ = (i >> 7) & 3, mt = (i >> 9) & 1, k = (i >> 10) & 7, l = i >> 13;
            const float* w = KA->in[mat ? I_LRU_WX : I_LRU_WA] + (size_t)l * 32768 + (size_t)(k * 64 + 16 * s_ + 8 * (ln >> 5)) * 64 + 32 * mt + (ln & 31);
            u32x4 o; o.x = pk2(w[0], w[64]); o.y = pk2(w[128], w[192]); o.z = pk2(w[256], w[320]); o.w = pk2(w[384], w[448]);
            *(u32x4*)(lruw + (size_t)i * 8) = o; }
        for (int i = gw * 64 + lane; i < DEPTH * 64 * D; i += NGW * 64) { const int l = i / (64 * D), n = (i / D) % 64, k = i % D; float v = 0.f;
            if (n < 4) v = KA->in[I_W_GROUP][(size_t)(l * D + k) * 4 + n]; else if (n < 36) v = KA->in[I_W_ROUTER][(size_t)(l * D + k) * 32 + (n - 4)];
            wtr[i] = (bf16)f2bf(v * KA->in[I_NORM_FFN][l * D + k]); }
        for (int m = gw; m < MEM_LEN; m += NGW) rms_row_to_bf16(KA->in[I_MEM] + (size_t)m * D, KA->in[I_MEM_NORM], memn + (size_t)m * D, lane);
        for (int i = gw * 64 + lane; i < 256 * D / 8; i += NGW * 64) ((u32x4*)(hb + (size_t)M * D))[i] = (u32x4){0u, 0u, 0u, 0u};
        { const float* __restrict__ xi_r = xin; bf16* __restrict__ hb_r = hb; float* __restrict__ ss_r = ssb;
          for (int m0 = gw; m0 < M; m0 += 4 * NGW) { f32x4 v[4][4];
#pragma unroll
              for (int q = 0; q < 4; ++q)
#pragma unroll
                  for (int j = 0; j < 2; ++j) { const int mq = (m0 + q * NGW < M) ? m0 + q * NGW : m0; const f32x4* p = (const f32x4*)(xi_r + (size_t)mq * D) + 2 * (lane + 64 * j); v[q][2 * j] = p[0]; v[q][2 * j + 1] = p[1]; }
#pragma unroll
              for (int q = 0; q < 4; ++q) { const int m = m0 + q * NGW; float ssq = 0.f; if (m >= M) break;
#pragma unroll
                  for (int j = 0; j < 2; ++j) { const f32x4 a = v[q][2 * j], c = v[q][2 * j + 1]; ssq += ((a.x * a.x + a.y * a.y) + (a.z * a.z + a.w * a.w)) + ((c.x * c.x + c.y * c.y) + (c.z * c.z + c.w * c.w));
                      ((u32x4*)(hb_r + (size_t)m * D))[lane + 64 * j] = (u32x4){pk2(a.x, a.y), pk2(a.z, a.w), pk2(c.x, c.y), pk2(c.z, c.w)}; }
                  ssq = wave_sum(ssq); if (lane < 16) ss_r[(size_t)m * 16 + lane] = lane == 0 ? ssq : 0.f; } } }
    }
    SEAM(0);
    PR_END(16);

    for (int l = 0; l < DEPTH; ++l) {
        const int pb = 1 + l * NPH_LAYER;
        PR_BEGIN(0);
        if (EN(0) && IN(pb + 0)) { PH_PTRS;
            { pg8::Gemm g{hb, wt_in + (size_t)l * INC * D, D, D, D, M, ssb}; pg8::GridOrder S; S.init(M / 256, ZC / 256, G, bx);
              pg8::EpiBf16<0, true> E{zb, ZC}; pg8::gemm_phase<pg8::EpiBf16<0, true>, pg8::GridOrder, false>(lds, g, S, E, tid); }
        }
        SEAM(pb + 0);
        PR_END(0); PR_BEGIN(1);
#define LRU_P lru::LruP LP{zb, KA->in[I_CONV_W] + l * 2048, KA->in[I_CONV_B] + l * 512, lruw + (size_t)l * 65536, KA->in[I_LRU_BA] + l * 512, \
                     KA->in[I_LRU_BX] + l * 512, KA->in[I_LRU_LAMBDA] + l * 512, carA, carH, carI, yb, (unsigned*)xout}
        if (EN(1) && IN(pb + 1)) { PH_PTRS; LRU_P;
            for (int u = gw; u < 2048; u += NGW) lru::unit1((LAS char*)lds + wid * 16384, LP, u >> 3, u & 7, lane);
            for (int u = gw; u < 2048; u += NGW) ret::kv_unit((LAS char*)lds + wid * 16384, zb, kvT, u >> 3, u & 7, lane);
            { float mx = 0.f;
#pragma unroll 4
              for (int m = gw; m < M; m += NGW) { const u32x4 v0 = *(const u32x4*)(zb + (size_t)m * ZC + Z_DQ + lane * 16), v1 = *(const u32x4*)(zb + (size_t)m * ZC + Z_DQ + lane * 16 + 8);
                  float ss = bflo(v0.x) * bflo(v0.x) + bfhi(v0.x) * bfhi(v0.x) + bflo(v0.y) * bflo(v0.y) + bfhi(v0.y) * bfhi(v0.y) + bflo(v0.z) * bflo(v0.z) + bfhi(v0.z) * bfhi(v0.z) + bflo(v0.w) * bflo(v0.w) + bfhi(v0.w) * bfhi(v0.w)
                           + bflo(v1.x) * bflo(v1.x) + bfhi(v1.x) * bfhi(v1.x) + bflo(v1.y) * bflo(v1.y) + bfhi(v1.y) * bfhi(v1.y) + bflo(v1.z) * bflo(v1.z) + bfhi(v1.z) * bfhi(v1.z) + bflo(v1.w) * bflo(v1.w) + bfhi(v1.w) * bfhi(v1.w);
                  ss += __shfl_xor(ss, 1); ss += __shfl_xor(ss, 2); mx = fmaxf(mx, ss); }
              LAS float* wm = (LAS float*)(lds + LDS_MISC + 4096);
              __syncthreads();
              if ((lane & 3) == 0) wm[wid * 16 + (lane >> 2)] = mx;
              __syncthreads();
              if (tid < 16) { float v = wm[tid]; for (int w = 1; w < 8; ++w) v = fmaxf(v, wm[w * 16 + tid]); qknrm[vcu * 16 + tid] = sqrtf(v); } }
        }
        SEAM(pb + 1);
        PR_END(1); PR_BEGIN(2);
#define DQ_SETUP LAS float* qkm = (LAS float*)(lds + LDS_MISC + 4096);   \
            { float v = 0.f; const int idx = wid * 2 + (lane >> 5); for (int j = (lane & 31); j < G; j += 32) v = fmaxf(v, qknrm[j * 16 + idx]); \
              for (int o_ = 1; o_ < 32; o_ <<= 1) v = fmaxf(v, __shfl_xor(v, o_)); if ((lane & 31) == 0) qkm[idx] = v; } \
            __syncthreads()
#define DQ_DMAX(hm_) ((int)((70.0f + 2.02f * qkm[(hm_)] * qkm[8 + (hm_)]) / (exp2f(-2.0f * (float)(((hm_) >> 1) + 1)) * LOG2E)) + 2)
        if (EN(2) && IN(pb + 2)) { PH_PTRS;
            if (l == 0) { pg8::Gemm g{memn, wt_mk, D, D, D, 0, nullptr}; pg8::GridOrder S; S.init(1, 8, G, bx);
                pg8::EpiBf16<0> E{kvmem, 2048}; pg8::gemm_phase<pg8::EpiBf16<0>, pg8::GridOrder, false>(lds, g, S, E, tid); __syncthreads(); }
            DQ_SETUP;
            LAS unsigned short* dord = (LAS unsigned short*)(lds + LDS_MISC + 8192);
            LAS int* dq = (LAS int*)(lds + LDS_MISC + 4096 + 128);
            {
              const int hdesc = tid >> 7, j = tid & 127, qblk = 63 - (j >> 1), hm = (3 - hdesc) * 2 + (j & 1);
              const int a = qblk * 256 - DQ_DMAX(hm); const int tlo = a > 0 ? (a >> 6) : 0, ntile = 4 * qblk + 4 - tlo, nseg = hm < 4 ? 1 : (ntile + 85) / 86;
              int inc = nseg;
#pragma unroll
              for (int o_ = 1; o_ < 64; o_ <<= 1) { const int v = __shfl_up(inc, o_); if (lane >= o_) inc += v; }
              if (lane == 63) dq[8 + wid] = inc;
              __syncthreads();
              int base = 0; for (int w = 0; w < wid; ++w) base += dq[8 + w];
              if (tid == NTHREADS - 1) dq[0] = base + inc;
              for (int sg = 0; sg < nseg; ++sg) dord[base + inc - nseg + sg] = (unsigned short)(((hm * 64 + qblk) << 2) | sg);
              __syncthreads(); }
            { const int gt = vcu * NTHREADS + tid;
              if (gt < 32768) { const int hh = gt >> 12; const float gch = exp2f(64.0f * ret::gamma_log2(hh)); float S = 0.f;
                  const float* __restrict__ kv_r = kvT; bf16* __restrict__ rt_r = rT;
                  for (int c0 = 0; c0 < NCHUNK; c0 += 32) { float kv[32];
#pragma unroll
                      for (int c = 0; c < 32; ++c) kv[c] = kv_r[(size_t)(c0 + c) * 32768 + gt];
#pragma unroll
                      for (int c = 0; c < 32; ++c) { rt_r[(size_t)(c0 + c) * 32768 + gt] = (bf16)f2bf(S); S = fmaf(gch, S, kv[c]); } }
              } else if (gt < 32768 + 512) { const int ch = gt - 32768; float hc = 0.f;
                  const float* __restrict__ ca_r = carA; const float* __restrict__ ch_r = carH; float* __restrict__ ci_r = carI;
                  for (int s0 = 0; s0 < 256; s0 += 16) { float ca[16], chh[16];
#pragma unroll
                      for (int sg2 = 0; sg2 < 16; ++sg2) { ca[sg2] = ca_r[(s0 + sg2) * 512 + ch]; chh[sg2] = ch_r[(s0 + sg2) * 512 + ch]; }
#pragma unroll
                      for (int sg2 = 0; sg2 < 16; ++sg2) { ci_r[(s0 + sg2) * 512 + ch] = hc; hc = fmaf(ca[sg2], hc, chh[sg2]); } } } }
#ifndef NO_DQ
            const int nd = dq[0];
            unsigned* qctr = ctl + CW_DQ + l * 256;
            __syncthreads();
            if (tid == 0) dq[1] = (int)__hip_atomic_fetch_add(qctr, 1u, __ATOMIC_RELAXED, __HIP_MEMORY_SCOPE_AGENT);
            for (;;) {
                __syncthreads();
                const int n = dq[1]; if (n >= nd) break;
                unsigned nxc = 0u; if (tid == 0) nxc = __hip_atomic_fetch_add(qctr, 1u, __ATOMIC_RELAXED, __HIP_MEMORY_SCOPE_AGENT);
                const int id = dord[n], sg = id & 3, qblk = (id >> 2) & 63, hm = id >> 8, head = hm >> 1, mp = hm & 1;
                const int dmx = DQ_DMAX(hm); const int a = qblk * 256 - dmx; const int tlo = a > 0 ? (a >> 6) : 0, thi = 4 * qblk + 4, ntile = thi - tlo, nseg = hm < 4 ? 1 : (ntile + 85) / 86, len = (ntile + nseg - 1) / nseg;
                const int t0 = tlo + sg * len, t1 = (t0 + len < thi) ? t0 + len : thi;
                bf16* ob_ = sg == 0 ? odb + hm * 128 : (sg == 1 ? xs1 : xs2) + (hm - 4) * 128;
                att::AttnP P{zb + Z_DQ + head * 128 + mp * 64, zb + Z_DK + head * 128 + mp * 64, zb + Z_DV + head * 128, ob_, ZC, ZC, ZC, sg == 0 ? 1024 : 512,
                             qblk * 256, t0, t1, exp2f(-2.0f * (float)(head + 1)) * LOG2E, dmx, nullptr, lseb + (size_t)sg * M * 8 + hm};
                int tid_u = tid; asm volatile("" : "+v"(tid_u));
                att::attn_unit<64, 128, 2>((LAS char*)lds, P, tid_u);
                if (tid == 0) dq[1] = (int)nxc;
            }
#endif
#ifndef NO_BQ
            LAS float* tab = (LAS float*)(lds + 65536);
            unsigned* bctr = ctl + CW_DQ + l * 256 + 64;
            __syncthreads();
            if (tid == 0) dq[2] = (int)__hip_atomic_fetch_add(bctr, 1u, __ATOMIC_RELAXED, __HIP_MEMORY_SCOPE_AGENT);
            for (;;) {
                __syncthreads();
                const int u = dq[2]; if (u >= 512) break;
                unsigned nxc = 0u; if (tid == 0) nxc = __hip_atomic_fetch_add(bctr, 1u, __ATOMIC_RELAXED, __HIP_MEMORY_SCOPE_AGENT);
                const int head = u & 7, qblk = u >> 3;
                if (tid < 257) tab[tid] = KA->in[I_CA_REL][(size_t)(l * 8 + head) * 257 + tid] * LOG2E;
                __syncthreads();
                att::AttnP P{zb + Z_BQ + head * 64, zb + Z_BK + head * 64, zb + Z_BV + head * 64, yb + 512 + head * 64, ZC, ZC, ZC, YC,
                             qblk * 256, (4 * qblk - 8 < 0 ? 0 : 4 * qblk - 8), 4 * qblk + 4, 0.f, 0, tab, nullptr};
                int tid_u = tid; asm volatile("" : "+v"(tid_u));
                att::attn_unit<64, 64, 1>((LAS char*)lds, P, tid_u);
                if (tid == 0) dq[2] = (int)nxc;
            }
#endif
            unsigned* cctr = ctl + CW_DQ + l * 256 + 128;
            __syncthreads();
            if (tid == 0) dq[3] = (int)__hip_atomic_fetch_add(cctr, 1u, __ATOMIC_RELAXED, __HIP_MEMORY_SCOPE_AGENT);
            for (;;) {
                __syncthreads();
                const int u = dq[3]; if (u >= CVT_UNITS) break;
                unsigned nxc = 0u; if (tid == 0) nxc = __hip_atomic_fetch_add(cctr, 1u, __ATOMIC_RELAXED, __HIP_MEMORY_SCOPE_AGENT);
                { const int it0 = u * CVT_PER_UNIT + wid * (CVT_PER_UNIT / NWAVES);
#define EX_IT(j_) expert_item(KA->in[I_W1] + (size_t)l * NEXP * D * DEXP, KA->in[I_W3] + (size_t)l * NEXP * D * DEXP, KA->in[I_W2] + (size_t)l * NEXP * DEXP * D, KA->in[I_NORM_FFN] + l * D, w13, w2t, it0 + (j_))
                  const TrIt t0_ = EX_IT(0), t1_ = EX_IT(1), t2_ = EX_IT(2); f32x4 va[8], vb_[8];
                  tr_load(t0_, lane, va); tr_load(t1_, lane, vb_);
                  tr_finish(t0_, va, (LAS float*)(lds + wid * 16384), lane); tr_load(t2_, lane, va);
                  tr_finish(t1_, vb_, (LAS float*)(lds + wid * 16384), lane);
                  tr_finish(t2_, va, (LAS float*)(lds + wid * 16384), lane);
#undef EX_IT
                }
                if (tid == 0) dq[3] = (int)nxc;
            }
        }
        SEAM(pb + 2);
        PR_END(2); PR_BEGIN(3);
        if (EN(3) && IN(pb + 3)) { PH_PTRS; LRU_P;
            for (int u = gw; u < 2048; u += NGW) lru::fin_unit(LP, u >> 3, u & 7, lane);
            for (int u = gw; u < 2048; u += NGW) ret::out_unit((LAS char*)lds + wid * 16384, zb, rT, yb, u >> 3, u & 7, lane);
        }
        if (EN(3) && IN(pb + 3)) { PH_PTRS; const float lam_init = 0.8f - 0.6f * expf(-0.3f * (float)l);
            asm volatile("" ::: "memory");
            DQ_SETUP;
            const int lane_m = lane;
            const float* dl = KA->in[I_DIFF_LAMBDA] + l * 256;
            const float lam = expf(wave_sum(dl[lane_m] * dl[64 + lane_m])) - expf(wave_sum(dl[128 + lane_m] * dl[192 + lane_m])) + lam_init;
            const int head = lane_m >> 4, sub = lane_m & 15; const float* sg_ = KA->in[I_DIFF_SUBLN] + l * 128 + sub * 8;
            float gsc[8];
#pragma unroll
            for (int j = 0; j < 8; ++j) gsc[j] = sg_[j] * (1.0f - lam_init);
            const int dm0 = DQ_DMAX(head * 2), dm1 = DQ_DMAX(head * 2 + 1);
            const float* __restrict__ lse_r = lseb; const bf16* __restrict__ od_r = odb; const bf16* __restrict__ x1_r = xs1; const bf16* __restrict__ x2_r = xs2; bf16* __restrict__ y_r = yb;
#pragma unroll 4
            for (int m = gw; m < M; m += NGW) {
                const int qblk = m >> 8; float om[2][8];
#pragma unroll
                for (int mp = 0; mp < 2; ++mp) { const int hm = head * 2 + mp; const int a = qblk * 256 - (mp ? dm1 : dm0); const int tlo = a > 0 ? (a >> 6) : 0, nseg = hm < 4 ? 1 : (4 * qblk + 4 - tlo + 85) / 86;
                    const bool s1 = nseg > 1, s2 = nseg > 2;
                    const float c0 = lse_r[(size_t)m * 8 + hm]; float c1 = lse_r[(size_t)M * 8 + (size_t)m * 8 + hm], c2 = lse_r[(size_t)2 * M * 8 + (size_t)m * 8 + hm];
                    const u32x4 a0 = *(const u32x4*)(od_r + (size_t)m * 1024 + hm * 128 + sub * 8);
                    u32x4 a1 = *(const u32x4*)(x1_r + (size_t)m * 512 + (hm & 3) * 128 + sub * 8), a2 = *(const u32x4*)(x2_r + (size_t)m * 512 + (hm & 3) * 128 + sub * 8);
                    c1 = s1 ? c1 : -1.0e30f; c2 = s2 ? c2 : -1.0e30f;
                    a1.x = s1 ? a1.x : 0u; a1.y = s1 ? a1.y : 0u; a1.z = s1 ? a1.z : 0u; a1.w = s1 ? a1.w : 0u; a2.x = s2 ? a2.x : 0u; a2.y = s2 ? a2.y : 0u; a2.z = s2 ? a2.z : 0u; a2.w = s2 ? a2.w : 0u;
                    const float cm = fmaxf(c0, fmaxf(c1, c2)); float w0 = fexp2(c0 - cm), w1 = fexp2(c1 - cm), w2 = fexp2(c2 - cm); const float wi = 1.0f / (w0 + w1 + w2); w0 *= wi; w1 *= wi; w2 *= wi;
                    om[mp][0] = w0 * bflo(a0.x) + w1 * bflo(a1.x) + w2 * bflo(a2.x); om[mp][1] = w0 * bfhi(a0.x) + w1 * bfhi(a1.x) + w2 * bfhi(a2.x);
                    om[mp][2] = w0 * bflo(a0.y) + w1 * bflo(a1.y) + w2 * bflo(a2.y); om[mp][3] = w0 * bfhi(a0.y) + w1 * bfhi(a1.y) + w2 * bfhi(a2.y);
                    om[mp][4] = w0 * bflo(a0.z) + w1 * bflo(a1.z) + w2 * bflo(a2.z); om[mp][5] = w0 * bfhi(a0.z) + w1 * bfhi(a1.z) + w2 * bfhi(a2.z);
                    om[mp][6] = w0 * bflo(a0.w) + w1 * bflo(a1.w) + w2 * bflo(a2.w); om[mp][7] = w0 * bfhi(a0.w) + w1 * bfhi(a1.w) + w2 * bfhi(a2.w); }
                float o[8], ss = 0.f;
#pragma unroll
                for (int j = 0; j < 8; ++j) { o[j] = om[0][j] - lam * om[1][j]; ss += o[j] * o[j]; }
                ss += __shfl_xor(ss, 1); ss += __shfl_xor(ss, 2); ss += __shfl_xor(ss, 4); ss += __shfl_xor(ss, 8);
                const float rs = 1.0f / sqrtf(ss * (1.f / 128.f) + GN_EPS);
                u32x4 w; w.x = cvt_pk_bf16(o[0] * rs * gsc[0], o[1] * rs * gsc[1]); w.y = cvt_pk_bf16(o[2] * rs * gsc[2], o[3] * rs * gsc[3]);
                w.z = cvt_pk_bf16(o[4] * rs * gsc[4], o[5] * rs * gsc[5]); w.w = cvt_pk_bf16(o[6] * rs * gsc[6], o[7] * rs * gsc[7]);
                *(u32x4*)(y_r + (size_t)m * YC + 1536 + head * 128 + sub * 8) = w;
            }
        }
        SEAM(pb + 3);
        PR_END(3); PR_BEGIN(4);
        if (EN(4) && IN(pb + 4)) { PH_PTRS;
            pg8::Gemm g{hb, wt_in + (size_t)l * INC * D + (size_t)ZC * D, D, D, D, M, ssb}; pg8::GridOrder S; S.init(M / 256, 4096 / 256, G, bx);
            pg8::EpiBf16<1, true> E{gtb, 4096}; pg8::gemm_phase<pg8::EpiBf16<1, true>, pg8::GridOrder, false>(lds, g, S, E, tid);
        }
        SEAM(pb + 4);
        PR_END(4); PR_BEGIN(5);
        if (EN(5) && IN(pb + 5)) { PH_PTRS;
            pg8::Gemm g{yb, wt_br + (size_t)l * 4 * D * 512, YC, 512, 512, M, nullptr}; pg8::BranchOrder S{G, vcu};
            pg8::EpiGateChain E{gtb, mrg}; pg8::gemm_phase<pg8::EpiGateChain, pg8::BranchOrder, false>(lds, g, S, E, tid);
        }
        SEAM(pb + 5);
        PR_END(5); PR_BEGIN(6);
        if (EN(6) && IN(pb + 6)) { PH_PTRS;
            pg8::Gemm g{mrg, wt_out + (size_t)l * D * D, D, D, D, M, nullptr}; pg8::GridOrder S; S.init(M / 256, D / 256, G, bx);
            pg8::EpiRes16 E{l == 0 ? xin : nullptr, hb, D, ssb}; pg8::gemm_phase<pg8::EpiRes16, pg8::GridOrder, false>(lds, g, S, E, tid);
        }
        SEAM(pb + 6);
        PR_END(6); PR_BEGIN(7);
        if (EN(7) && IN(pb + 7)) { PH_PTRS;
            pg8::Gemm g{hb, wt_mq + (size_t)l * 512 * D, D, D, D, M, ssb}; pg8::GridOrder S; S.init(M / 256, 2, G, bx);
            pg8::EpiBf16<0, true> E{qb, 512}; pg8::gemm_phase<pg8::EpiBf16<0, true>, pg8::GridOrder, false>(lds, g, S, E, tid);
        }
        SEAM(pb + 7);
        PR_END(7); PR_BEGIN(8);
        if (EN(8) && IN(pb + 8)) { PH_PTRS;
            for (int u = vcu; u < 256; u += G) { const int head = u & 3, qblk = u >> 2;
                att::AttnP P{qb + head * 128, kvmem + l * 512 + head * 128, kvmem + 1024 + l * 512 + head * 128, obf + head * 128, 512, 2048, 2048, 512,
                             qblk * 256, 0, 4, 0.f, 0, nullptr, nullptr};
                att::attn_unit<128, 128, 0>((LAS char*)lds, P, tid); }
        }
        SEAM(pb + 8);
        PR_END(8); PR_BEGIN(9);
        if (EN(9) && IN(pb + 9)) { PH_PTRS;
            pg8::Gemm g{obf, wt_mo + (size_t)l * D * 512, 512, 512, 512, M, nullptr}; pg8::GridOrder S; S.init(M / 256, D / 256, G, bx);
            pg8::EpiRes16 E{nullptr, hb, D, ssb}; pg8::gemm_phase<pg8::EpiRes16, pg8::GridOrder, false>(lds, g, S, E, tid);
        }
        SEAM(pb + 9);
        PR_END(9); PR_BEGIN(10);
        if (EN(10) && IN(pb + 10)) { PH_PTRS; unsigned* ecnt = ctl + CW_ECNT + l * 32 * 64;
            LAS float* part = (LAS float*)lds;
            LAS float* lg = (LAS float*)(lds + 81920);
            const int r32 = lane & 31, hi = lane >> 5; const bf16* wl_ = wtr + (size_t)l * 64 * D;
            for (int u = vcu; u < M / 64; u += G) { const int t0 = u * 64;
                f32x16 a00 = (f32x16){}, a01 = (f32x16){}, a10 = (f32x16){}, a11 = (f32x16){};
#pragma unroll
                for (int s8 = 0; s8 < 8; ++s8) { const int s = wid * 8 + s8;
                    const bf16x8 b0_ = *(const bf16x8*)(hb + (size_t)(t0 + r32) * D + 16 * s + 8 * hi), b1_ = *(const bf16x8*)(hb + (size_t)(t0 + 32 + r32) * D + 16 * s + 8 * hi);
                    const bf16x8 w0_ = *(const bf16x8*)(wl_ + (size_t)r32 * D + 16 * s + 8 * hi), w1_ = *(const bf16x8*)(wl_ + (size_t)(32 + r32) * D + 16 * s + 8 * hi);
                    a00 = __builtin_amdgcn_mfma_f32_32x32x16_bf16(w0_, b0_, a00, 0, 0, 0); a01 = __builtin_amdgcn_mfma_f32_32x32x16_bf16(w1_, b0_, a01, 0, 0, 0);
                    a10 = __builtin_amdgcn_mfma_f32_32x32x16_bf16(w0_, b1_, a10, 0, 0, 0); a11 = __builtin_amdgcn_mfma_f32_32x32x16_bf16(w1_, b1_, a11, 0, 0, 0); }
#pragma unroll
                for (int r = 0; r < 16; ++r) { part[(wid * 36 + att::crow(r, hi)) * 65 + r32] = a00[r]; part[(wid * 36 + att::crow(r, hi)) * 65 + 32 + r32] = a10[r]; }
                if (hi == 0) {
#pragma unroll
                    for (int r = 0; r < 4; ++r) { part[(wid * 36 + 32 + r) * 65 + r32] = a01[r]; part[(wid * 36 + 32 + r) * 65 + 32 + r32] = a11[r]; } }
                __syncthreads();
                for (int i = tid; i < 36 * 64; i += NTHREADS) { const int n = i >> 6, tk = i & 63; float sacc = 0.f;
#pragma unroll
                    for (int w = 0; w < 8; ++w) sacc += part[(w * 36 + n) * 65 + tk];
                    lg[tk * 37 + n] = sacc; }
                __syncthreads();
                if (wid < 2) {
                const LAS float* tl = lg + (32 * wid + r32) * 37; const float* bg = KA->in[I_B_GROUP] + l * 4; const float* br = KA->in[I_B_ROUTER] + l * 32;
                float rsn; { const f32x4* p_ = (const f32x4*)(ssb + (size_t)(t0 + 32 * wid + r32) * 16); const f32x4 a_ = p_[0], b_ = p_[1], c_ = p_[2], d_ = p_[3];
                    const float s_ = (((a_[0] + a_[1]) + (a_[2] + a_[3])) + ((b_[0] + b_[1]) + (b_[2] + b_[3]))) + (((c_[0] + c_[1]) + (c_[2] + c_[3])) + ((d_[0] + d_[1]) + (d_[2] + d_[3])));
                    rsn = 1.0f / sqrtf(s_ * (1.0f / 1024.0f) + NORM_EPS); }
                float gl[4];
#pragma unroll
                for (int j = 0; j < 4; ++j) gl[j] = tl[j] * rsn + bg[j];
                int gs = 0; float gmx = gl[0];
#pragma unroll
                for (int j = 1; j < 4; ++j) if (gl[j] > gmx) { gmx = gl[j]; gs = j; }
                float gsum = 0.f;
#pragma unroll
                for (int j = 0; j < 4; ++j) gsum += __expf(gl[j] - gmx);
                const float gprob = 1.0f / gsum;
                float el[8];
#pragma unroll
                for (int j = 0; j < 8; ++j) el[j] = tl[4 + 8 * gs + j] * rsn + br[8 * gs + j];
                int i0 = 0; float m0 = el[0];
#pragma unroll
                for (int j = 1; j < 8; ++j) if (el[j] > m0) { m0 = el[j]; i0 = j; }
                int i1 = -1; float m1 = -3.0e38f;
#pragma unroll
                for (int j = 0; j < 8; ++j) if (j != i0 && el[j] > m1) { m1 = el[j]; i1 = j; }
                const float e1 = __expf(m1 - m0); const float w0 = gprob / (1.0f + e1), w1 = gprob * e1 / (1.0f + e1);
                const int myk = hi; const int e = 8 * gs + (myk ? i1 : i0); const float w = myk ? w1 : w0;
                unsigned long long rem = ~0ull; int leader = 0, rank = 0, cnt = 0;
                while (rem) { const int ld_ = __builtin_ctzll(rem); const int ee = __shfl(e, ld_); const unsigned long long mk = __ballot(e == ee);
                    if (e == ee) { leader = ld_; rank = __builtin_popcountll(mk & ((1ull << lane) - 1ull)); cnt = __builtin_popcountll(mk); } rem &= ~mk; }
                unsigned base = 0u; if (lane == leader) base = __hip_atomic_fetch_add(ecnt + 64 * e, (unsigned)cnt, __ATOMIC_RELAXED, __HIP_MEMORY_SCOPE_AGENT);
                base = __shfl(base, leader); const int pos = (int)base + rank; const int tok = t0 + 32 * wid + r32;
                elist[e * 16384 + pos] = tok; tokE[tok * 2 + myk] = e; tokP[tok * 2 + myk] = pos; tokW[tok * 2 + myk] = w;
                }
                __syncthreads();
            }
        }
        SEAM(pb + 10);
        PR_END(10); PR_BEGIN(11);
#define DEFER_CONVERT(U_LO, U_HI, CTR_OFF) do { if (l == 0 && DEPTH > 1) { WT_CONSTS; WT_DECODE; \
                constexpr int NDEF = NIT - 2 * I_MQ; static_assert((DEPTH - 1) * NDEF / 32 == 224, "deferred units"); \
                LAS int* dqw = (LAS int*)(lds + LDS_MISC + 4096 + 128); unsigned* wctr = ctl + CW_DQ + (CTR_OFF); \
                __syncthreads(); \
                if (tid == 0) dqw[4] = (U_LO) + (int)__hip_atomic_fetch_add(wctr, 1u, __ATOMIC_RELAXED, __HIP_MEMORY_SCOPE_AGENT); \
                for (;;) { \
                    __syncthreads(); \
                    const int u = dqw[4]; if (u >= (U_HI)) break; \
                    unsigned nxc = 0u; if (tid == 0) nxc = (U_LO) + __hip_atomic_fetch_add(wctr, 1u, __ATOMIC_RELAXED, __HIP_MEMORY_SCOPE_AGENT); \
                    auto dit = [&](int q) -> int { const int ll = 1 + q / NDEF, qi = q % NDEF; return ll * NIT + (qi < KV0 ? qi : qi + 2 * I_MQ); }; \
                    const int q0 = u * 32 + wid * 4; LAS float* scr = (LAS float*)(lds + wid * 16384); \
                    const TrIt t0_ = decode(dit(q0)), t1_ = decode(dit(q0 + 1)), t2_ = decode(dit(q0 + 2)), t3_ = decode(dit(q0 + 3)); f32x4 va[8], vb_[8]; \
                    tr_load(t0_, lane, va); tr_load(t1_, lane, vb_); \
                    tr_finish(t0_, va, scr, lane); tr_load(t2_, lane, va); \
                    tr_finish(t1_, vb_, scr, lane); tr_load(t3_, lane, vb_); \
                    tr_finish(t2_, va, scr, lane); tr_finish(t3_, vb_, scr, lane); \
                    if (tid == 0) dqw[4] = (int)nxc; \
                } } } while (0)
        LAS int* mtab = (LAS int*)(lds + LDS_MISC + 1024);
        if ((EN(11) || EN(12)) && (IN(pb + 11) || IN(pb + 12))) { PH_PTRS; unsigned* ecnt = ctl + CW_ECNT + l * 32 * 64;
            if (wid == 0) {
                const int c = lane < NEXP ? (int)__hip_atomic_load(ecnt + 64 * (lane & 31), __ATOMIC_RELAXED, __HIP_MEMORY_SCOPE_AGENT) : 0; const int nt_ = (c + 255) >> 8; int inc = nt_;
#pragma unroll
                for (int o_ = 1; o_ < 32; o_ <<= 1) { const int v = __shfl_up(inc, o_); if ((lane & 31) >= o_ && lane < 32) inc += v; }
                const int base = inc - nt_;
                if (lane < NEXP) for (int r = 0; r < nt_; ++r) { mtab[16 + 4 * (base + r)] = lane; mtab[16 + 4 * (base + r) + 1] = r; mtab[16 + 4 * (base + r) + 2] = base + r; }
                if (lane == NEXP - 1) mtab[0] = inc; }
            __syncthreads();
        }
        if (EN(11) && IN(pb + 11)) { PH_PTRS; unsigned* ecnt = ctl + CW_ECNT + l * 32 * 64;
            pg8::Gemm g{hb, w13, D, D, D, M, ssb}; pg8::MoeOrder S{mtab, G, vcu, 4, 1024, elist, ecnt};
            pg8::EpiSwiGlu E{hid}; pg8::gemm_phase<pg8::EpiSwiGlu, pg8::MoeOrder, true>(lds, g, S, E, tid);
            DEFER_CONVERT(0, 128, 192);
        }
        SEAM(pb + 11);
        PR_END(11); PR_BEGIN(12);
        if (EN(12) && IN(pb + 12)) { PH_PTRS; unsigned* ecnt = ctl + CW_ECNT + l * 32 * 64;
            pg8::Gemm g{hid, w2t, DEXP, DEXP, DEXP, M, nullptr}; pg8::MoeOrder S{mtab, G, vcu, 4, 1024, elist, ecnt};
            pg8::EpiBf16<0> E{ymoe, D}; pg8::gemm_phase<pg8::EpiBf16<0>, pg8::MoeOrder, false>(lds, g, S, E, tid);
            DEFER_CONVERT(128, 224, 200);
        }
        SEAM(pb + 12);
        PR_END(12); PR_BEGIN(13);
        if (EN(13) && IN(pb + 13)) { PH_PTRS; unsigned* ecnt = ctl + CW_ECNT + l * 32 * 64;
            int sb = 0; { const int c = lane < NEXP ? (int)__hip_atomic_load(ecnt + 64 * (lane & 31), __ATOMIC_RELAXED, __HIP_MEMORY_SCOPE_AGENT) : 0; const int nt_ = (c + 255) >> 8; int inc = nt_;
#pragma unroll
                for (int o = 1; o < 32; o <<= 1) { const int v = __shfl_up(inc, o); if ((lane & 31) >= o) inc += v; }
                sb = (inc - nt_) * 256; }
            const float* gn = KA->in[I_FINAL_NORM];
            float* __restrict__ xo_r = xout; const bf16* __restrict__ ym_r = ymoe; bf16* __restrict__ hb_r = hb; float* __restrict__ ss_r = ssb;
            const int* __restrict__ te_r = tokE; const int* __restrict__ tp_r = tokP; const float* __restrict__ tw_r = tokW;
#pragma unroll 4
            for (int m = gw; m < M; m += NGW) {
                const int e0 = te_r[m * 2], e1 = te_r[m * 2 + 1]; const float w0 = tw_r[m * 2], w1 = tw_r[m * 2 + 1];
                const size_t s0 = (size_t)(__shfl(sb, e0) + tp_r[m * 2]), s1 = (size_t)(__shfl(sb, e1) + tp_r[m * 2 + 1]);
                float v[2][8]; float ss = 0.f;
#pragma unroll
                for (int j = 0; j < 2; ++j) { const u32x4 xw = ((const u32x4*)(hb_r + (size_t)m * D))[lane + 64 * j], a = ((const u32x4*)(ym_r + s0 * D))[lane + 64 * j], b = ((const u32x4*)(ym_r + s1 * D))[lane + 64 * j];
                    v[j][0] = bflo(xw.x) + w0 * bflo(a.x) + w1 * bflo(b.x); v[j][1] = bfhi(xw.x) + w0 * bfhi(a.x) + w1 * bfhi(b.x); v[j][2] = bflo(xw.y) + w0 * bflo(a.y) + w1 * bflo(b.y); v[j][3] = bfhi(xw.y) + w0 * bfhi(a.y) + w1 * bfhi(b.y);
                    v[j][4] = bflo(xw.z) + w0 * bflo(a.z) + w1 * bflo(b.z); v[j][5] = bfhi(xw.z) + w0 * bfhi(a.z) + w1 * bfhi(b.z); v[j][6] = bflo(xw.w) + w0 * bflo(a.w) + w1 * bflo(b.w); v[j][7] = bfhi(xw.w) + w0 * bfhi(a.w) + w1 * bfhi(b.w);
#pragma unroll
                    for (int q = 0; q < 8; q += 2) ss += v[j][q] * v[j][q] + v[j][q + 1] * v[j][q + 1]; }
                const float sst = wave_sum(ss);
                if (l + 1 < DEPTH) { float sr = 0.f;
#pragma unroll
                    for (int j = 0; j < 2; ++j) { u32x4 w; w.x = pk2(v[j][0], v[j][1]); w.y = pk2(v[j][2], v[j][3]); w.z = pk2(v[j][4], v[j][5]); w.w = pk2(v[j][6], v[j][7]);
                        ((u32x4*)(hb_r + (size_t)m * D))[lane + 64 * j] = w;
                        sr += ((bflo(w.x) * bflo(w.x) + bfhi(w.x) * bfhi(w.x)) + (bflo(w.y) * bflo(w.y) + bfhi(w.y) * bfhi(w.y))) + ((bflo(w.z) * bflo(w.z) + bfhi(w.z) * bfhi(w.z)) + (bflo(w.w) * bflo(w.w) + bfhi(w.w) * bfhi(w.w))); }
                    sr = wave_sum(sr);
                    if (lane < 16) ss_r[(size_t)m * 16 + lane] = lane == 0 ? sr : 0.f;
                } else {
                    const float rstd = 1.f / sqrtf(sst * (1.f / D) + NORM_EPS);
#pragma unroll
                    for (int j = 0; j < 2; ++j) { const f32x4 g0 = ((const f32x4*)gn)[2 * (lane + 64 * j)], g1 = ((const f32x4*)gn)[2 * (lane + 64 * j) + 1];
                        f32x4* op = (f32x4*)(xo_r + (size_t)m * D) + 2 * (lane + 64 * j);
                        op[0] = (f32x4){v[j][0] * rstd * g0.x, v[j][1] * rstd * g0.y, v[j][2] * rstd * g0.z, v[j][3] * rstd * g0.w};
                        op[1] = (f32x4){v[j][4] * rstd * g1.x, v[j][5] * rstd * g1.y, v[j][6] * rstd * g1.z, v[j][7] * rstd * g1.w}; }
                }
            }
        }
        SEAM(pb + 13);
        PR_END(13);
    }
#ifdef PROBE_MASK
    if (blockIdx.x == 0) { const unsigned long long t_end = __builtin_amdgcn_s_memrealtime() + (unsigned long long)(PROBE_MULT) * pr_acc; while (__builtin_amdgcn_s_memrealtime() < t_end) __builtin_amdgcn_s_sleep(8); }
#endif
#undef IN
#undef SEAM
}

extern "C" void kernel_launch(void* const* d_in, const int* in_sizes, int n_in, void* d_out, int out_size, void* d_ws, size_t ws_size, hipStream_t stream) {
    static int grid = 0;
    if (grid == 0) {
        if (n_in != 31 || in_sizes[0] != M * D || out_size != M * D || ws_size < WS_END) { fprintf(stderr, "kernel_launch: unexpected problem (n_in %d, in0 %d, out %d, ws %zu < %zu)\n", n_in, n_in > 0 ? in_sizes[0] : -1, out_size, ws_size, (size_t)WS_END); grid = -1; return; }
        int dev = 0, cus = 0, per_cu = 0;
        if (hipGetDevice(&dev) != hipSuccess || hipDeviceGetAttribute(&cus, hipDeviceAttributeMultiprocessorCount, dev) != hipSuccess) { grid = -1; return; }
        if (hipFuncSetAttribute((const void*)fwd_kernel, hipFuncAttributeMaxDynamicSharedMemorySize, LDS_BYTES) != hipSuccess) { fprintf(stderr, "kernel_launch: hipFuncSetAttribute failed\n"); grid = -1; return; }
        if (hipOccupancyMaxActiveBlocksPerMultiprocessor(&per_cu, (const void*)fwd_kernel, NTHREADS, LDS_BYTES) != hipSuccess || per_cu < 1) { fprintf(stderr, "kernel_launch: occupancy query says %d\n", per_cu); }
        (void)hipGetLastError();
        grid = cus;
    }
    if (grid < 0) return;
    if (hipMemsetAsync((char*)d_ws + WS_CTL, 0, CTL_ZERO_BYTES, stream) != hipSuccess) return;
    Args a{};
    for (int i = 0; i < 31; ++i) a.in[i] = (const float*)d_in[i];
    a.out = (float*)d_out; a.ws = (unsigned char*)d_ws;
#if MK_N_LAUNCHES == 1
    a.ph_lo = 0; a.ph_hi = NPHASE;
    hipLaunchKernelGGL(fwd_kernel, dim3(grid), dim3(NTHREADS), LDS_BYTES, stream, a);
#else
    for (int p = 0; p < NPHASE; ++p) { a.ph_lo = p; a.ph_hi = p + 1; hipLaunchKernelGGL(fwd_kernel, dim3(grid), dim3(NTHREADS), LDS_BYTES, stream, a); }
#endif
}
```
